# Optimizing an MI355X kernel written in HIP

```python
import math
import jax
import jax.numpy as jnp
from jax import lax
import numpy as np

D_MODEL = 1024
BATCH = 16
SEQ = 2048
DEPTH = 2

GRID_W = 64
CTX_LEN = 256
N_MOD = 9
FFN_HIDDEN = 2816
NORM_EPS = 1e-6
ROPE_THETA = 10000.0
Q_BLOCK = 128

DIFF_HEADS = 4
DIFF_HD = 64
MLA_HEADS = 4
MLA_Q_RANK = 256
MLA_KV_RANK = 128
MLA_NOPE = 128
MLA_ROPE = 64
MLA_V = 128
MLA_SCALE = (MLA_NOPE + MLA_ROPE) ** -0.5

SSD_HEADS = 16
SSD_HD = 64
SSD_INNER = SSD_HEADS * SSD_HD
SSD_GROUPS = 4
SSD_STATE = 128
SSD_CONV = 5
SSD_CHUNK = 128

NA_HEADS = 8
NA_HD = 64
NA_WIN_R = 8
NA_WIN_C = 16

DIFF_W = DIFF_HEADS * 2 * DIFF_HD
MLA_OUT = MLA_HEADS * MLA_V
AB_SIZES = (DIFF_W, DIFF_W, DIFF_W, MLA_Q_RANK, MLA_KV_RANK, MLA_ROPE)
IN_AB = DIFF_W * 3 + MLA_Q_RANK + MLA_KV_RANK + MLA_ROPE
MIX_AB = DIFF_W + MLA_OUT
SSD_CONV_CH = SSD_INNER + 2 * SSD_GROUPS * SSD_STATE
NA_W = NA_HEADS * NA_HD
CD_SIZES = (SSD_INNER, SSD_CONV_CH, 2 * SSD_HEADS, NA_W, NA_W, NA_W)
IN_CD = SSD_INNER + SSD_CONV_CH + 2 * SSD_HEADS + 3 * NA_W
MIX_CD = SSD_INNER + NA_W

kernel_name = 'hybrid_diffattn_mla_ssd_natten_dit'


def _split(p, sizes):
    return jnp.split(p, [int(s) for s in np.cumsum(sizes)[:-1]], axis=-1)


def rms_norm(x, g):
    xf = x.astype(jnp.float32)
    y = xf * lax.rsqrt(jnp.mean(xf * xf, axis=-1, keepdims=True) + NORM_EPS)
    return (y * g.astype(jnp.float32)).astype(x.dtype)


def ada_norm(x, g, shift, scale):
    return rms_norm(x, g) * (1.0 + scale) + shift


def swiglu(h, w_in, w_out):
    gate, up = jnp.split(h @ w_in, 2, axis=-1)
    return (jax.nn.silu(gate) * up) @ w_out


def axial_rope_table(n_tok, dim, dtype):
    t = jnp.arange(n_tok)
    row = (t // GRID_W).astype(jnp.float32)
    col = (t % GRID_W).astype(jnp.float32)
    nf = dim // 4
    freqs = ROPE_THETA ** (-jnp.arange(nf, dtype=jnp.float32) / nf)
    ang_r = row[:, None] * freqs
    ang_c = col[:, None] * freqs
    ang = jnp.concatenate([ang_r, ang_r, ang_c, ang_c], axis=-1)
    return jnp.cos(ang).astype(dtype), jnp.sin(ang).astype(dtype)


def apply_rope(x, cos, sin):
    nf = x.shape[-1] // 4
    xs = x.reshape(x.shape[:-1] + (2, 2, nf))
    rot = jnp.stack([-xs[..., 1, :], xs[..., 0, :]], axis=-2).reshape(x.shape)
    bshape = (x.shape[1],) + (1,) * (x.ndim - 3) + (x.shape[-1],)
    return x * cos.reshape(bshape) + rot * sin.reshape(bshape)


def plain_attend(q, k, v, scale):
    s = jnp.einsum('bqhd,bkhd->bhqk', q, k).astype(jnp.float32) * scale
    p = jax.nn.softmax(s, axis=-1).astype(v.dtype)
    return jnp.einsum('bhqk,bkhe->bqhe', p, v)


def diff_attend(q, k, v, lam):
    s = jnp.einsum('bqhcd,bkhcd->bhcqk', q, k).astype(jnp.float32) * (DIFF_HD ** -0.5)
    p = jax.nn.softmax(s, axis=-1)
    a = (p[:, :, 0] - lam * p[:, :, 1]).astype(v.dtype)
    return jnp.einsum('bhqk,bkhe->bqhe', a, v)


def over_query_blocks(attend, q):
    b, s = q.shape[:2]
    qb = q.reshape((b, s // Q_BLOCK, Q_BLOCK) + q.shape[2:]).swapaxes(0, 1)
    ob = lax.map(attend, qb).swapaxes(0, 1)
    return ob.reshape((b, s) + ob.shape[3:])


def mla_heads(c_q, c_kv, k_rope, g_q, w_uq, g_kv, w_ukv, cos, sin):
    lead = c_q.shape[:-1]
    q = (rms_norm(c_q, g_q) @ w_uq).reshape(lead + (MLA_HEADS, MLA_NOPE + MLA_ROPE))
    kv = (rms_norm(c_kv, g_kv) @ w_ukv).reshape(lead + (MLA_HEADS, MLA_NOPE + MLA_V))
    q_nope, q_rope = jnp.split(q, [MLA_NOPE], axis=-1)
    k_nope, v = jnp.split(kv, [MLA_NOPE], axis=-1)
    if cos is not None:
        q_rope = apply_rope(q_rope, cos, sin)
        k_rope = apply_rope(k_rope, cos, sin)
    k_rope = jnp.broadcast_to(k_rope[..., None, :], lead + (MLA_HEADS, MLA_ROPE))
    q = jnp.concatenate([q_nope, q_rope], axis=-1)
    k = jnp.concatenate([k_nope, k_rope], axis=-1)
    return q, k, v


def mixer_ab(hx, hc, w_in, lam_q1, lam_k1, lam_q2, lam_k2, g_sub, g_q, w_uq, g_kv, w_ukv, w_out,
             lambda_init, with_ctx):
    f32 = jnp.float32
    n_lat = hx.shape[1]
    cos_d, sin_d = axial_rope_table(n_lat, DIFF_HD, hx.dtype)
    cos_m, sin_m = axial_rope_table(n_lat, MLA_ROPE, hx.dtype)
    lam = (jnp.exp(jnp.sum(lam_q1.astype(f32) * lam_k1.astype(f32)))
           - jnp.exp(jnp.sum(lam_q2.astype(f32) * lam_k2.astype(f32))) + lambda_init)

    def project(h, cd, sd, cm, sm):
        qd, kd, vd, cq, ckv, kr = _split(h @ w_in, AB_SIZES)
        lead = h.shape[:-1]
        qd = qd.reshape(lead + (DIFF_HEADS, 2, DIFF_HD))
        kd = kd.reshape(lead + (DIFF_HEADS, 2, DIFF_HD))
        vd = vd.reshape(lead + (DIFF_HEADS, 2 * DIFF_HD))
        if cd is not None:
            qd = apply_rope(qd, cd, sd)
            kd = apply_rope(kd, cd, sd)
        qm, km, vm = mla_heads(cq, ckv, kr, g_q, w_uq, g_kv, w_ukv, cm, sm)
        return qd, kd, vd, qm, km, vm

    qd_x, kd_x, vd_x, qm_x, km_x, vm_x = project(hx, cos_d, sin_d, cos_m, sin_m)
    qd_c, kd_c, vd_c, qm_c, km_c, vm_c = project(hc, None, None, None, None)

    def merge(od, om):
        od = rms_norm(od, g_sub) * (1.0 - lambda_init)
        lead = od.shape[:2]
        cat = jnp.concatenate([od.reshape(lead + (DIFF_W,)), om.reshape(lead + (MLA_OUT,))], axis=-1)
        return cat @ w_out

    kd_all = jnp.concatenate([kd_x, kd_c], axis=1)
    vd_all = jnp.concatenate([vd_x, vd_c], axis=1)
    km_all = jnp.concatenate([km_x, km_c], axis=1)
    vm_all = jnp.concatenate([vm_x, vm_c], axis=1)
    od_x = over_query_blocks(lambda qb: diff_attend(qb, kd_all, vd_all, lam), qd_x)
    om_x = over_query_blocks(lambda qb: plain_attend(qb, km_all, vm_all, MLA_SCALE), qm_x)
    out_x = merge(od_x, om_x)
    out_c = None
    if with_ctx:
        out_c = merge(diff_attend(qd_c, kd_c, vd_c, lam), plain_attend(qm_c, km_c, vm_c, MLA_SCALE))
    return out_x, out_c


def dwconv_centred(x, w, b):
    y = lax.conv_general_dilated(
        x, w[:, None, :].astype(x.dtype), window_strides=(1,),
        padding=[(SSD_CONV // 2, SSD_CONV // 2)],
        dimension_numbers=('NWC', 'WIO', 'NWC'), feature_group_count=x.shape[-1])
    return y + b.astype(x.dtype)


def ssd_scan(x, dt, a, bm, cm, d_skip, h0):
    f32 = jnp.float32
    bsz, n, nh, hd = x.shape
    ng, ns = bm.shape[-2:]
    nr = nh // ng
    nc = n // SSD_CHUNK
    cl = SSD_CHUNK
    xf = x.astype(f32)
    xd = (xf * dt[..., None]).reshape(bsz, nc, cl, ng, nr, hd)
    bb = bm.astype(f32).reshape(bsz, nc, cl, ng, ns)
    cc = cm.astype(f32).reshape(bsz, nc, cl, ng, ns)
    a_dt = (dt * a).reshape(bsz, nc, cl, ng, nr).transpose(0, 3, 4, 1, 2)
    a_cs = jnp.cumsum(a_dt, axis=-1)
    tril = jnp.tril(jnp.ones((cl, cl), dtype=bool))
    decay = jnp.exp(jnp.where(tril, a_cs[..., :, None] - a_cs[..., None, :], -jnp.inf))
    cb = jnp.einsum('bclgn,bcsgn->bgcls', cc, bb)
    y_diag = jnp.einsum('bgcls,bgrcls,bcsgrp->bclgrp', cb, decay, xd)
    decay_states = jnp.exp(a_cs[..., -1:] - a_cs)
    states = jnp.einsum('bclgn,bgrcl,bclgrp->bcgrpn', bb, decay_states, xd)
    states = jnp.concatenate([h0.reshape(bsz, 1, ng, nr, hd, ns), states], axis=1)
    tot = jnp.cumsum(jnp.pad(a_cs[..., -1], ((0, 0), (0, 0), (0, 0), (1, 0))), axis=-1)
    tril_c = jnp.tril(jnp.ones((nc + 1, nc + 1), dtype=bool))
    decay_chunk = jnp.exp(jnp.where(tril_c, tot[..., :, None] - tot[..., None, :], -jnp.inf))
    states = jnp.einsum('bgrzc,bcgrpn->bzgrpn', decay_chunk, states)
    y_off = jnp.einsum('bclgn,bcgrpn,bgrcl->bclgrp', cc, states[:, :-1], jnp.exp(a_cs))
    y = (y_diag + y_off).reshape(bsz, n, nh, hd) + d_skip.astype(f32)[:, None] * xf
    return y.astype(x.dtype), states[:, -1].reshape(bsz, nh, hd, ns)


def bidir_ssd(xs, bm, cm, dt, a, d_skip, h0_f, h0_b):
    flip = lambda t: jnp.flip(t, axis=1)
    y_f, h_f = ssd_scan(xs, dt[..., 0, :], a[0], bm, cm, d_skip[0], h0_f)
    y_b, h_b = ssd_scan(flip(xs), flip(dt[..., 1, :]), a[1], flip(bm), flip(cm), d_skip[1], h0_b)
    return y_f + flip(y_b), h_f, h_b


def gated_rms_norm(y, z, g):
    yz = y * jax.nn.silu(z)
    shp = yz.shape[:-1] + (SSD_GROUPS, SSD_INNER // SSD_GROUPS)
    return rms_norm(yz.reshape(shp), g.reshape(SSD_GROUPS, SSD_INNER // SSD_GROUPS)).reshape(yz.shape)


def na_attention(q, k, v, k_ctx, v_ctx, rpb):
    b, s, h, d = q.shape
    rows = s // GRID_W
    kr = min(NA_WIN_R, rows)
    kc = min(NA_WIN_C, GRID_W)
    scale = d ** -0.5
    qcol = jnp.arange(GRID_W)
    key_cols = jnp.clip(qcol - kc // 2, 0, GRID_W - kc)[:, None] + jnp.arange(kc)
    dc = key_cols - qcol[:, None] + (NA_WIN_C - 1)
    k_grid = k.reshape(b, rows, GRID_W, h, d)
    v_grid = v.reshape(b, rows, GRID_W, h, d)
    q_rows = q.reshape(b, rows, GRID_W, h, d).swapaxes(0, 1)
    bias_tab = rpb.astype(jnp.float32)

    def one_row(args):
        r, q_r = args
        r0 = jnp.clip(r - kr // 2, 0, rows - kr)
        dr = r0 + jnp.arange(kr) - r + (NA_WIN_R - 1)
        k_win = lax.dynamic_slice_in_dim(k_grid, r0, kr, axis=1)[:, :, key_cols]
        v_win = lax.dynamic_slice_in_dim(v_grid, r0, kr, axis=1)[:, :, key_cols]
        bias = bias_tab[:, dr[:, None, None], dc[None]].transpose(0, 2, 1, 3)
        s_lat = jnp.einsum('bqhd,bjqmhd->bhqjm', q_r, k_win).astype(jnp.float32) * scale + bias
        s_lat = s_lat.reshape(b, h, GRID_W, kr * kc)
        s_ctx = jnp.einsum('bqhd,bkhd->bhqk', q_r, k_ctx).astype(jnp.float32) * scale
        p = jax.nn.softmax(jnp.concatenate([s_lat, s_ctx], axis=-1), axis=-1).astype(v.dtype)
        p_lat = p[..., :kr * kc].reshape(b, h, GRID_W, kr, kc)
        p_ctx = p[..., kr * kc:]
        return (jnp.einsum('bhqjm,bjqmhd->bqhd', p_lat, v_win)
                + jnp.einsum('bhqk,bkhd->bqhd', p_ctx, v_ctx))

    o = lax.map(one_row, (jnp.arange(rows), q_rows))
    return o.swapaxes(0, 1).reshape(b, s, h, d)


def mixer_cd(hx, hc, w_in, conv_w, conv_b, dt_bias, a_log, d_skip, g_norm, rpb, w_out, with_ctx):
    a = -jnp.exp(a_log.astype(jnp.float32))

    def project(h):
        z, xbc, dt_raw, q, k, v = _split(h @ w_in, CD_SIZES)
        lead = h.shape[:-1]
        xbc = jax.nn.silu(dwconv_centred(xbc, conv_w, conv_b))
        xs, bm, cm = _split(xbc, (SSD_INNER, SSD_GROUPS * SSD_STATE, SSD_GROUPS * SSD_STATE))
        dt = jax.nn.softplus(dt_raw.astype(jnp.float32).reshape(lead + (2, SSD_HEADS))
                             + dt_bias.astype(jnp.float32))
        heads = lambda t: t.reshape(lead + (NA_HEADS, NA_HD))
        return (z, xs.reshape(lead + (SSD_HEADS, SSD_HD)),
                bm.reshape(lead + (SSD_GROUPS, SSD_STATE)), cm.reshape(lead + (SSD_GROUPS, SSD_STATE)),
                dt, heads(q), heads(k), heads(v))

    z_x, xs_x, b_x, c_x, dt_x, q_x, k_x, v_x = project(hx)
    z_c, xs_c, b_c, c_c, dt_c, q_c, k_c, v_c = project(hc)
    h0 = jnp.zeros((hc.shape[0], SSD_HEADS, SSD_HD, SSD_STATE), jnp.float32)
    y_c, hf_c, hb_c = bidir_ssd(xs_c, b_c, c_c, dt_c, a, d_skip, h0, h0)
    y_x, _, _ = bidir_ssd(xs_x, b_x, c_x, dt_x, a, d_skip, hf_c, hb_c)

    def merge(y, z, o):
        lead = y.shape[:2]
        ys = gated_rms_norm(y.reshape(lead + (SSD_INNER,)), z, g_norm)
        return jnp.concatenate([ys, o.reshape(lead + (NA_W,))], axis=-1) @ w_out

    out_x = merge(y_x, z_x, na_attention(q_x, k_x, v_x, k_c, v_c, rpb))
    out_c = None
    if with_ctx:
        out_c = merge(y_c, z_c, plain_attend(q_c, k_c, v_c, NA_HD ** -0.5))
    return out_x, out_c


def setup_inputs(seed: int = 0) -> dict:
    key = jax.random.key(seed)
    ks = iter(jax.random.split(key, 48))
    f32 = jnp.float32
    n_even = (DEPTH + 1) // 2
    n_odd = DEPTH // 2

    def normal(shape):
        return jax.random.normal(next(ks), shape, f32)

    def dense(shape, fan_in, gain=1.0):
        return gain * fan_in ** -0.5 * normal(shape)

    def norm_gain(shape):
        return 1.0 + 0.02 * normal(shape)

    x = normal((BATCH, SEQ, D_MODEL))
    c = normal((BATCH, D_MODEL))
    ctx = normal((BATCH, CTX_LEN, D_MODEL))
    c_ctx = normal((D_MODEL,))
    w_mod = dense((DEPTH, D_MODEL, N_MOD * D_MODEL), D_MODEL, 0.5)
    b_mod = 0.02 * normal((DEPTH, N_MOD * D_MODEL))
    g_ffn1 = norm_gain((DEPTH, D_MODEL))
    w_ffn1_in = dense((DEPTH, D_MODEL, 2 * FFN_HIDDEN), D_MODEL)
    w_ffn1_out = dense((DEPTH, FFN_HIDDEN, D_MODEL), FFN_HIDDEN)
    g_mix = norm_gain((DEPTH, D_MODEL))
    g_ffn2 = norm_gain((DEPTH, D_MODEL))
    w_ffn2_in = dense((DEPTH, D_MODEL, 2 * FFN_HIDDEN), D_MODEL)
    w_ffn2_out = dense((DEPTH, FFN_HIDDEN, D_MODEL), FFN_HIDDEN)
    ab_w_in = dense((n_even, D_MODEL, IN_AB), D_MODEL)
    ab_lam_q1 = 0.1 * normal((n_even, DIFF_HD))
    ab_lam_k1 = 0.1 * normal((n_even, DIFF_HD))
    ab_lam_q2 = 0.1 * normal((n_even, DIFF_HD))
    ab_lam_k2 = 0.1 * normal((n_even, DIFF_HD))
    ab_g_subln = norm_gain((n_even, 2 * DIFF_HD))
    ab_g_q = norm_gain((n_even, MLA_Q_RANK))
    ab_w_uq = dense((n_even, MLA_Q_RANK, MLA_HEADS * (MLA_NOPE + MLA_ROPE)), MLA_Q_RANK)
    ab_g_kv = norm_gain((n_even, MLA_KV_RANK))
    ab_w_ukv = dense((n_even, MLA_KV_RANK, MLA_HEADS * (MLA_NOPE + MLA_V)), MLA_KV_RANK)
    ab_w_out = dense((n_even, MIX_AB, D_MODEL), MIX_AB)
    cd_w_in = dense((n_odd, D_MODEL, IN_CD), D_MODEL)
    cd_conv_w = dense((n_odd, SSD_CONV, SSD_CONV_CH), SSD_CONV)
    cd_conv_b = 0.02 * normal((n_odd, SSD_CONV_CH))
    dt0 = jnp.exp(jax.random.uniform(next(ks), (n_odd, 2, SSD_HEADS), f32,
                                     minval=math.log(1e-3), maxval=math.log(1e-1)))
    cd_dt_bias = dt0 + jnp.log(-jnp.expm1(-dt0))
    cd_a_log = jnp.log(jax.random.uniform(next(ks), (n_odd, 2, SSD_HEADS), f32, minval=1.0, maxval=16.0))
    cd_d_skip = 1.0 + 0.1 * normal((n_odd, 2, SSD_HEADS))
    cd_g_norm = norm_gain((n_odd, SSD_INNER))
    cd_rpb = 0.05 * normal((n_odd, NA_HEADS, 2 * NA_WIN_R - 1, 2 * NA_WIN_C - 1))
    cd_w_out = dense((n_odd, MIX_CD, D_MODEL), MIX_CD)
    g_final = norm_gain((D_MODEL,))
    return {'x': x, 'c': c, 'ctx': ctx, 'c_ctx': c_ctx, 'w_mod': w_mod, 'b_mod': b_mod,
            'g_ffn1': g_ffn1, 'w_ffn1_in': w_ffn1_in, 'w_ffn1_out': w_ffn1_out, 'g_mix': g_mix,
            'g_ffn2': g_ffn2, 'w_ffn2_in': w_ffn2_in, 'w_ffn2_out': w_ffn2_out,
            'ab_w_in': ab_w_in, 'ab_lam_q1': ab_lam_q1, 'ab_lam_k1': ab_lam_k1,
            'ab_lam_q2': ab_lam_q2, 'ab_lam_k2': ab_lam_k2, 'ab_g_subln': ab_g_subln,
            'ab_g_q': ab_g_q, 'ab_w_uq': ab_w_uq, 'ab_g_kv': ab_g_kv, 'ab_w_ukv': ab_w_ukv,
            'ab_w_out': ab_w_out, 'cd_w_in': cd_w_in, 'cd_conv_w': cd_conv_w, 'cd_conv_b': cd_conv_b,
            'cd_dt_bias': cd_dt_bias, 'cd_a_log': cd_a_log, 'cd_d_skip': cd_d_skip,
            'cd_g_norm': cd_g_norm, 'cd_rpb': cd_rpb, 'cd_w_out': cd_w_out, 'g_final': g_final}


def reference(x, c, ctx, c_ctx, w_mod, b_mod, g_ffn1, w_ffn1_in, w_ffn1_out, g_mix, g_ffn2,
              w_ffn2_in, w_ffn2_out, ab_w_in, ab_lam_q1, ab_lam_k1, ab_lam_q2, ab_lam_k2,
              ab_g_subln, ab_g_q, ab_w_uq, ab_g_kv, ab_w_ukv, ab_w_out, cd_w_in, cd_conv_w,
              cd_conv_b, cd_dt_bias, cd_a_log, cd_d_skip, cd_g_norm, cd_rpb, cd_w_out, g_final):
    silu_c = jax.nn.silu(c)
    silu_cc = jax.nn.silu(c_ctx)
    for i in range(DEPTH):
        last = i == DEPTH - 1
        mod_x = (silu_c @ w_mod[i] + b_mod[i]).reshape(c.shape[0], 1, N_MOD, D_MODEL)
        mod_c = (silu_cc @ w_mod[i] + b_mod[i]).reshape(N_MOD, D_MODEL)
        mx = [mod_x[:, :, j] for j in range(N_MOD)]
        mc = [mod_c[j] for j in range(N_MOD)]
        x = x + 0.5 * mx[2] * swiglu(ada_norm(x, g_ffn1[i], mx[0], mx[1]), w_ffn1_in[i], w_ffn1_out[i])
        ctx = ctx + 0.5 * mc[2] * swiglu(ada_norm(ctx, g_ffn1[i], mc[0], mc[1]), w_ffn1_in[i], w_ffn1_out[i])
        hx = ada_norm(x, g_mix[i], mx[3], mx[4])
        hc = ada_norm(ctx, g_mix[i], mc[3], mc[4])
        j = i // 2
        if i % 2 == 0:
            ox, oc = mixer_ab(hx, hc, ab_w_in[j], ab_lam_q1[j], ab_lam_k1[j], ab_lam_q2[j], ab_lam_k2[j],
                              ab_g_subln[j], ab_g_q[j], ab_w_uq[j], ab_g_kv[j], ab_w_ukv[j], ab_w_out[j],
                              0.8 - 0.6 * math.exp(-0.3 * i), not last)
        else:
            ox, oc = mixer_cd(hx, hc, cd_w_in[j], cd_conv_w[j], cd_conv_b[j], cd_dt_bias[j], cd_a_log[j],
                              cd_d_skip[j], cd_g_norm[j], cd_rpb[j], cd_w_out[j], not last)
        x = x + mx[5] * ox
        x = x + 0.5 * mx[8] * swiglu(ada_norm(x, g_ffn2[i], mx[6], mx[7]), w_ffn2_in[i], w_ffn2_out[i])
        if not last:
            ctx = ctx + mc[5] * oc
            ctx = ctx + 0.5 * mc[8] * swiglu(ada_norm(ctx, g_ffn2[i], mc[6], mc[7]), w_ffn2_in[i], w_ffn2_out[i])
    return rms_norm(x, g_final)
```

```cpp
#include <hip/hip_runtime.h>
#include <hip/hip_cooperative_groups.h>
#include <cstdio>
#include <cstdint>
namespace cg = cooperative_groups;

#define DI __device__ __forceinline__
#define LAS __attribute__((address_space(3)))
typedef short bf16x8 __attribute__((ext_vector_type(8)));
typedef short s16x4 __attribute__((ext_vector_type(4)));
typedef float f32x2 __attribute__((ext_vector_type(2)));
typedef float f32x4 __attribute__((ext_vector_type(4)));
typedef float f32x16 __attribute__((ext_vector_type(16)));
typedef unsigned u32x2 __attribute__((ext_vector_type(2)));
typedef unsigned u32x4 __attribute__((ext_vector_type(4)));
typedef __bf16 bf16x2_t __attribute__((ext_vector_type(2)));
typedef unsigned short bf16_t;

constexpr int DM = 1024, NB = 16, SEQ = 2048, CTXL = 256, FF = 2816;
constexpr int TX = NB * SEQ;
constexpr int TC = NB * CTXL;
constexpr int TT = TX + TC;
constexpr float EPS = 1e-6f;
constexpr float LOG2E = 1.4426950408889634f;
constexpr int P0W = 2048;
constexpr int QKW = 1792;
constexpr int P1W = 4640;
constexpr int C1_Q = 1024, C1_K = 1536, C1_V = 2048, C1_XBC = 2560, C1_DT = 4608;

constexpr size_t MiB = 1u << 20;
constexpr size_t WS_MOD = 0;
constexpr size_t WS_ROPE = 2 * MiB;
constexpr size_t WS_SSQ = 2 * MiB + 65536;
constexpr size_t WS_W0 = 3 * MiB;
constexpr size_t W_FFN_IN = (size_t)2 * FF * DM * 2;
constexpr size_t W_FFN_OUT = (size_t)DM * FF * 2;
constexpr size_t W0_F1I = WS_W0, W0_F1O = W0_F1I + W_FFN_IN, W0_F2I = W0_F1O + W_FFN_OUT, W0_F2O = W0_F2I + W_FFN_IN;
constexpr size_t W0_ABI = W0_F2O + W_FFN_OUT;
constexpr size_t W0_UP = W0_ABI + (size_t)2048 * 1024 * 2;
constexpr size_t W0_ABO = W0_UP + (size_t)1536 * 1024;
constexpr size_t WS_W1 = 44 * MiB;
constexpr size_t W1_F1I = WS_W1, W1_F1O = W1_F1I + W_FFN_IN, W1_F2I = W1_F1O + W_FFN_OUT, W1_F2O = W1_F2I + W_FFN_IN;
constexpr size_t W1_CDI = W1_F2O + W_FFN_OUT;
constexpr size_t W1_CDO = W1_CDI + (size_t)4864 * 1024 * 2;
constexpr size_t WS_CTXRES = 90 * MiB;
constexpr size_t WS_H = 106 * MiB;
constexpr size_t WS_BIG = 178 * MiB;
constexpr size_t WS_ACT = WS_BIG;
constexpr size_t WS_P0 = WS_BIG;
constexpr size_t WS_QKV = WS_BIG + 144 * MiB;
constexpr size_t WS_ODS = WS_BIG + 270 * MiB;
constexpr size_t WS_P1 = WS_BIG;
constexpr size_t WS_END = WS_BIG + 327 * MiB;

constexpr int LDS_BYTES = 147456;

DI float bf2f(unsigned short b) { return __uint_as_float((unsigned)b << 16); }
DI float bflo(unsigned w) { return __uint_as_float(w << 16); }
DI float bfhi(unsigned w) { return __uint_as_float(w & 0xffff0000u); }
DI unsigned cvtpk(float lo, float hi) { f32x2 v = {lo, hi}; bf16x2_t b = __builtin_convertvector(v, bf16x2_t); return __builtin_bit_cast(unsigned, b); }
DI float ex2(float x) { return __builtin_amdgcn_exp2f(x); }
DI float fexp(float x) { return __builtin_amdgcn_exp2f(x * LOG2E); }
DI float frcp(float x) { return __builtin_amdgcn_rcpf(x); }
DI float siluf(float x) { return x * frcp(1.f + fexp(-x)); }
DI float wave_sum(float v) {
#pragma unroll
    for (int o = 1; o < 64; o <<= 1) v += __shfl_xor(v, o);
    return v;
}
DI int crow(int reg, int h) { return (reg & 3) + 8 * (reg >> 2) + 4 * h; }
#define MFMA32(a, b, c) __builtin_amdgcn_mfma_f32_32x32x16_bf16((a), (b), (c), 0, 0, 0)
typedef short v4i16_t __attribute__((ext_vector_type(4)));
DI s16x4 trread(const LAS unsigned char* p) { return __builtin_bit_cast(s16x4, __builtin_amdgcn_ds_read_tr16_b64_v4i16((LAS v4i16_t*)p)); }
DI bf16x8 cat8(s16x4 lo, s16x4 hi) { return __builtin_shufflevector(lo, hi, 0, 1, 2, 3, 4, 5, 6, 7); }
DI bf16x8 pack8(float a0, float a1, float a2, float a3, float a4, float a5, float a6, float a7) {
    u32x4 p; p.x = cvtpk(a0, a1); p.y = cvtpk(a2, a3); p.z = cvtpk(a4, a5); p.w = cvtpk(a6, a7); return __builtin_bit_cast(bf16x8, p);
}
DI f32x16 zero16() { f32x16 z;
#pragma unroll
    for (int i = 0; i < 16; ++i) z[i] = 0.f;
    return z; }


namespace pg8 {
#define PG8_LAS __attribute__((address_space(3)))

typedef unsigned short bf16_t;
typedef short bf16x8 __attribute__((ext_vector_type(8)));
typedef float f32x4 __attribute__((ext_vector_type(4)));
typedef unsigned u32x4 __attribute__((ext_vector_type(4)));
constexpr int BM = 256, BK = 64, HALF = 128, HTB = HALF * BK * 2  , STAGE_BYTES = 8 * HTB, NXCD = 8, WGM = 8;

__host__ __device__ __forceinline__ int lds_byte(int r, int c) { const int st = (r >> 4) * 2 + (c >> 5), rr = r & 15, cc = c & 31, ob = rr * 64 + cc * 2; return st * 1024 + (ob ^ (((ob >> 9) & 1) << 5)); }
__host__ __device__ __forceinline__ void stage_rc(int b, int& R, int& C) { const int st = b / 1024, sb = b % 1024, swz = sb ^ (((sb >> 9) & 1) << 5); R = (st >> 1) * 16 + swz / 64; C = (st & 1) * 32 + (swz % 64) / 2; }
__host__ __device__ __forceinline__ int perm32(int rho) { const int n = rho >> 4, i = rho & 15; return 8 * (i >> 2) + 4 * n + (i & 3); }

struct Unit { int pm, pn; };
struct Gemm { const bf16_t* A; const bf16_t* Bt; int M, N, K, lda; };

struct StaticOrder {
    int nM, nN, nwg, G, c;
    __host__ __device__ void init(int M, int N, int G_, int c_) { nM = M / BM; nN = N / BM; nwg = nM * nN; G = G_; c = c_; }
    __host__ __device__ bool next(int i, Unit& u) const {
        const long L = (long)i * G + c; if (L >= nwg) return false;
        int wgid = (int)L; { const int q = nwg / NXCD, r = nwg % NXCD, xcd = wgid % NXCD, off = wgid / NXCD; wgid = (xcd < r ? xcd * (q + 1) : r * (q + 1) + (xcd - r) * q) + off; }
        const int nig = WGM * nN, gid = wgid / nig, fm = gid * WGM, gsz = (nM - fm) < WGM ? (nM - fm) : WGM;
        u.pm = fm + ((wgid % nig) % gsz); u.pn = (wgid % nig) / gsz; return true;
    }
    __device__ __forceinline__ void a_ready(const Unit&) const {}
    __device__ __forceinline__ void done(const Unit&) const {}
};


template <class Epi, class Sched, bool ALIGN_EPI = false, bool SP2 = false>
__device__ __forceinline__ void gemm_phase(PG8_LAS unsigned char* lds, const Gemm g, const Sched& S, const Epi& E) {
    int tid_ = threadIdx.x; asm volatile("" : "+v"(tid_));
    const int tid = tid_, wid = __builtin_amdgcn_readfirstlane(tid >> 6), lane = tid & 63, wr = wid >> 2, wc = wid & 3, fr = lane & 15, fq = lane >> 4;
    const int K = g.K, nt = K / BK;
    unsigned voffA[2], voffB[2];
#pragma unroll
    for (int i = 0; i < 2; ++i) { int R, C; stage_rc(tid * 16 + i * 8192, R, C); const int Rb = Epi::PERM ? ((R & ~31) + perm32(R & 31)) : R;
        voffA[i] = (unsigned)(R * g.lda + C) * 2u; voffB[i] = (unsigned)(Rb * K + C) * 2u; }
    const size_t kstep = (size_t)(BK * 2);
    const size_t hstepB = (size_t)HALF * K * 2, hstepA = (size_t)HALF * g.lda * 2;
    const size_t tstepA = 2 * hstepA, tstepB = 2 * hstepB;
    const unsigned ldsw = (unsigned)wid * 1024u;
    const int aoff = lds_byte(wr * 64 + fr, fq * 8), boff = lds_byte(wc * 32 + fr, fq * 8);
#define PG8_SA(b, h) (((b) * 2 + (h)) * HTB)
#define PG8_SB(b, h) ((4 + (b) * 2 + (h)) * HTB)
#define PG8_STAGE(bufoff, gbase, voff) do { _Pragma("unroll") for (int _i = 0; _i < 2; ++_i) \
        __builtin_amdgcn_global_load_lds((const unsigned*)((const char*)(gbase) + (voff)[_i]), (PG8_LAS unsigned*)(lds + (bufoff) + ldsw + _i * 8192), 16, 0, 0); } while (0)
#define PG8_LDA(dst, b, h) do { _Pragma("unroll") for (int m = 0; m < 4; ++m) _Pragma("unroll") for (int k = 0; k < 2; ++k) dst[m][k] = *(const PG8_LAS bf16x8*)(lds + PG8_SA(b, h) + aoff + m * 2048 + k * 1024); } while (0)
#define PG8_LDB(dst, b, h) do { _Pragma("unroll") for (int n = 0; n < 2; ++n) _Pragma("unroll") for (int k = 0; k < 2; ++k) dst[n][k] = *(const PG8_LAS bf16x8*)(lds + PG8_SB(b, h) + boff + n * 2048 + k * 1024); } while (0)
#define PG8_MMA(ai, bj, At, Bt) do { __builtin_amdgcn_s_setprio(1); _Pragma("unroll") for (int m = 0; m < 4; ++m) _Pragma("unroll") for (int n = 0; n < 2; ++n) _Pragma("unroll") for (int k = 0; k < 2; ++k) \
        acc[ai][bj][m][n] = __builtin_amdgcn_mfma_f32_16x16x32_bf16(Bt[n][k], At[m][k], acc[ai][bj][m][n], 0, 0, 0); __builtin_amdgcn_s_setprio(0); } while (0)
#define PG8_WAIT_V(n) asm volatile("s_waitcnt vmcnt(" #n ")" ::: "memory")
#define PG8_WAIT_L(n) asm volatile("s_waitcnt lgkmcnt(" #n ")" ::: "memory")
#define PG8_BAR __builtin_amdgcn_s_barrier()
#define PG8_SCHED __builtin_amdgcn_sched_barrier(0)
    Unit cur, nxt; int ui = 0;
    if (!S.next(0, cur)) return;
    f32x4 acc[2][2][4][2];
#pragma unroll
    for (int a = 0; a < 2; ++a)
#pragma unroll
        for (int b = 0; b < 2; ++b)
#pragma unroll
            for (int m = 0; m < 4; ++m)
#pragma unroll
                for (int n = 0; n < 2; ++n) acc[a][b][m][n] = (f32x4){0.f, 0.f, 0.f, 0.f};
    bf16x8 At[4][2], B0[2][2], B1[2][2];
    const char* cA = (const char*)g.A + (size_t)cur.pm * tstepA; const char* cB = (const char*)g.Bt + (size_t)cur.pn * tstepB;
    S.a_ready(cur);
    if constexpr (SP2) {
        PG8_STAGE(PG8_SB(0, 0), cB, voffB); PG8_STAGE(PG8_SB(0, 1), cB + hstepB, voffB); PG8_STAGE(PG8_SA(0, 0), cA, voffA); PG8_STAGE(PG8_SA(0, 1), cA + hstepA, voffA);
        if (wr == 1) PG8_BAR;
        PG8_WAIT_V(2); PG8_BAR;
        PG8_STAGE(PG8_SB(1, 0), cB + kstep, voffB); PG8_STAGE(PG8_SA(1, 0), cA + kstep, voffA); PG8_STAGE(PG8_SB(1, 1), cB + hstepB + kstep, voffB);
        PG8_WAIT_V(6); PG8_BAR;
    } else {
        PG8_STAGE(PG8_SB(0, 0), cB, voffB); PG8_STAGE(PG8_SA(0, 0), cA, voffA); PG8_STAGE(PG8_SB(0, 1), cB + hstepB, voffB); PG8_STAGE(PG8_SA(0, 1), cA + hstepA, voffA);
        if (wr == 1) PG8_BAR;
        PG8_WAIT_V(4); PG8_BAR;
        PG8_STAGE(PG8_SB(1, 0), cB + kstep, voffB); PG8_STAGE(PG8_SA(1, 0), cA + kstep, voffA); PG8_STAGE(PG8_SB(1, 1), cB + hstepB + kstep, voffB);
        PG8_WAIT_V(6); PG8_BAR;
    }
    for (;;) {
        const bool has_next = S.next(ui + 1, nxt);
        const char* nA = has_next ? (const char*)g.A + (size_t)nxt.pm * tstepA : cA; const char* nB = has_next ? (const char*)g.Bt + (size_t)nxt.pn * tstepB : cB;
        for (int t = 0; t < nt; t += 2) {
            const bool last = (t == nt - 2);
            const char* a1 = cA + (size_t)(t + 1) * kstep;
            const char* a2 = last ? nA : cA + (size_t)(t + 2) * kstep; const char* b2 = last ? nB : cB + (size_t)(t + 2) * kstep;
            const char* a3 = a2 + kstep; const char* b3 = b2 + kstep;
            if (last && has_next) S.a_ready(nxt);
            if constexpr (SP2) {
            PG8_LDB(B0, 0, 0); PG8_LDB(B1, 0, 1); PG8_SCHED; PG8_LDA(At, 0, 0); PG8_STAGE(PG8_SA(1, 1), a1 + hstepA, voffA);
            PG8_WAIT_V(8); PG8_WAIT_L(0); PG8_BAR; PG8_MMA(0, 0, At, B0); PG8_MMA(0, 1, At, B1); PG8_BAR; PG8_SCHED;
            PG8_LDA(At, 0, 1); PG8_STAGE(PG8_SB(0, 0), b2, voffB); PG8_STAGE(PG8_SB(0, 1), b2 + hstepB, voffB); PG8_STAGE(PG8_SA(0, 0), a2, voffA);
            PG8_WAIT_V(8); PG8_WAIT_L(0); PG8_BAR; PG8_MMA(1, 0, At, B0); PG8_MMA(1, 1, At, B1); PG8_BAR; PG8_SCHED;
            PG8_LDB(B0, 1, 0); PG8_LDB(B1, 1, 1); PG8_SCHED; PG8_LDA(At, 1, 0); PG8_STAGE(PG8_SA(0, 1), a2 + hstepA, voffA);
            PG8_WAIT_V(8); PG8_WAIT_L(0); PG8_BAR; PG8_MMA(0, 0, At, B0); PG8_MMA(0, 1, At, B1); PG8_BAR; PG8_SCHED;
            PG8_LDA(At, 1, 1); PG8_STAGE(PG8_SB(1, 0), b3, voffB); PG8_STAGE(PG8_SB(1, 1), b3 + hstepB, voffB); PG8_STAGE(PG8_SA(1, 0), a3, voffA);
            PG8_WAIT_V(8); PG8_WAIT_L(0); PG8_BAR; PG8_MMA(1, 0, At, B0); PG8_MMA(1, 1, At, B1); PG8_BAR; PG8_SCHED;
            } else {
            PG8_LDB(B0, 0, 0); PG8_SCHED; PG8_LDA(At, 0, 0); PG8_STAGE(PG8_SA(1, 1), a1 + hstepA, voffA);
            PG8_WAIT_L(8); PG8_BAR; PG8_WAIT_L(0); PG8_MMA(0, 0, At, B0); PG8_BAR; PG8_SCHED;
            PG8_LDB(B1, 0, 1); PG8_STAGE(PG8_SB(0, 0), b2, voffB);
            PG8_BAR; PG8_WAIT_L(0); PG8_MMA(0, 1, At, B1); PG8_BAR;
            PG8_LDA(At, 0, 1); PG8_STAGE(PG8_SA(0, 0), a2, voffA);
            PG8_BAR; PG8_WAIT_L(0); PG8_MMA(1, 0, At, B0); PG8_BAR; PG8_SCHED;
            PG8_STAGE(PG8_SB(0, 1), b2 + hstepB, voffB);
            PG8_WAIT_V(6); PG8_BAR; PG8_MMA(1, 1, At, B1); PG8_BAR;
            PG8_LDB(B0, 1, 0); PG8_SCHED; PG8_LDA(At, 1, 0); PG8_STAGE(PG8_SA(0, 1), a2 + hstepA, voffA);
            PG8_WAIT_L(8); PG8_BAR; PG8_WAIT_L(0); PG8_MMA(0, 0, At, B0); PG8_BAR; PG8_SCHED;
            PG8_LDB(B1, 1, 1); PG8_STAGE(PG8_SB(1, 0), b3, voffB);
            PG8_BAR; PG8_WAIT_L(0); PG8_MMA(0, 1, At, B1); PG8_BAR;
            PG8_LDA(At, 1, 1); PG8_STAGE(PG8_SA(1, 0), a3, voffA);
            PG8_BAR; PG8_WAIT_L(0); PG8_MMA(1, 0, At, B0); PG8_BAR; PG8_SCHED;
            PG8_STAGE(PG8_SB(1, 1), b3 + hstepB, voffB);
            PG8_WAIT_V(6); PG8_BAR; PG8_MMA(1, 1, At, B1); PG8_BAR;
            }
        }
        if constexpr (ALIGN_EPI) { if (wr == 0) PG8_BAR; }
        if constexpr (!Epi::AFTER_DRAIN) { E(acc, cur, wr, wc, fr, fq); S.done(cur); }
        if (!has_next) break;
#pragma unroll
        for (int a = 0; a < 2; ++a)
#pragma unroll
            for (int b = 0; b < 2; ++b)
#pragma unroll
                for (int m = 0; m < 4; ++m)
#pragma unroll
                    for (int n = 0; n < 2; ++n) acc[a][b][m][n] = (f32x4){0.f, 0.f, 0.f, 0.f};
        cur = nxt; cA = nA; cB = nB; ++ui;
        if constexpr (ALIGN_EPI) { if (wr == 1) PG8_BAR; }
    }
    PG8_WAIT_V(0);
    if constexpr (!ALIGN_EPI) { if (wr == 0) PG8_BAR; }
    PG8_BAR;
    if constexpr (Epi::AFTER_DRAIN) { E.fused(acc, cur, wr, wc, fr, fq, lds, wid, lane); S.done(cur); }
#undef PG8_SA
#undef PG8_SB
#undef PG8_STAGE
#undef PG8_LDA
#undef PG8_LDB
#undef PG8_MMA
#undef PG8_WAIT_V
#undef PG8_WAIT_L
#undef PG8_BAR
#undef PG8_SCHED
}
}


namespace pg8 {
struct EpiSwiglu {
    static constexpr bool PERM = true, AFTER_DRAIN = false;
    bf16_t* O;
    __device__ __forceinline__ void operator()(const f32x4 (&acc)[2][2][4][2], const Unit& u, int wr, int wc, int fr, int fq) const {
        const int row0 = u.pm * BM + wr * 64 + fr, col0 = u.pn * 128 + wc * 32 + 8 * fq;
#pragma unroll
        for (int ai = 0; ai < 2; ++ai)
#pragma unroll
            for (int m = 0; m < 4; ++m) {
                const f32x4 g0 = acc[ai][0][m][0], g1 = acc[ai][0][m][1], u0 = acc[ai][1][m][0], u1 = acc[ai][1][m][1];
                u32x4 w;
                w.x = cvtpk(siluf(g0[0]) * u0[0], siluf(g0[1]) * u0[1]); w.y = cvtpk(siluf(g0[2]) * u0[2], siluf(g0[3]) * u0[3]);
                w.z = cvtpk(siluf(g1[0]) * u1[0], siluf(g1[1]) * u1[1]); w.w = cvtpk(siluf(g1[2]) * u1[2], siluf(g1[3]) * u1[3]);
                *(u32x4*)(O + (size_t)(row0 + ai * HALF + m * 16) * FF + col0) = w;
            }
    }
};
struct EpiRes {
    static constexpr bool PERM = false, AFTER_DRAIN = false;
    const float* rin_x; const float* rin_c; float* rout_x; float* rout_c; const float* gate  ; float gs;
    __device__ __forceinline__ void operator()(const f32x4 (&acc)[2][2][4][2], const Unit& u, int wr, int wc, int fr, int fq) const {
#pragma unroll
        for (int ai = 0; ai < 2; ++ai)
#pragma unroll
            for (int m = 0; m < 4; ++m) {
                const int row = u.pm * BM + ai * HALF + wr * 64 + m * 16 + fr;
                const bool isx = row < TX;
                const float* ri = isx ? rin_x + (size_t)row * DM : rin_c + (size_t)(row - TX) * DM;
                float* ro = isx ? rout_x + (size_t)row * DM : rout_c + (size_t)(row - TX) * DM;
                const float* gp = gate + (size_t)(isx ? (row >> 11) : 16) * 9216;
#pragma unroll
                for (int bj = 0; bj < 2; ++bj)
#pragma unroll
                    for (int n = 0; n < 2; ++n) {
                        const int c = u.pn * BM + bj * HALF + wc * 32 + n * 16 + 4 * fq;
                        const f32x4 r = *(const f32x4*)(ri + c), g = *(const f32x4*)(gp + c);
                        *(f32x4*)(ro + c) = r + (g * gs) * acc[ai][bj][m][n];
                    }
                asm volatile("" ::: "memory");
            }
    }
};
struct EpiAbIn {
    static constexpr bool PERM = false, AFTER_DRAIN = false;
    bf16_t* P; const float* cosT; const float* sinT; float* ssq;
    __device__ __forceinline__ void operator()(const f32x4 (&acc)[2][2][4][2], const Unit& u, int wr, int wc, int fr, int fq) const {
#pragma unroll
        for (int ai = 0; ai < 2; ++ai)
#pragma unroll
            for (int m = 0; m < 4; ++m) {
                const int row = u.pm * BM + ai * HALF + wr * 64 + m * 16 + fr;
                const bool isx = row < TX; const int t = row & 2047, prow = t >> 6, pcol = t & 63;
                float sq = 0.f;
#pragma unroll
                for (int bj = 0; bj < 2; ++bj) {
                    const int cb = u.pn * BM + bj * HALF + wc * 32;
                    if (cb >= 1984) continue;
                    f32x4 v0 = acc[ai][bj][m][0], v1 = acc[ai][bj][m][1];
                    if (cb >= 1536 && cb < 1920) sq += (v0[0] * v0[0] + v0[1] * v0[1]) + (v0[2] * v0[2] + v0[3] * v0[3]) + (v1[0] * v1[0] + v1[1] * v1[1]) + (v1[2] * v1[2] + v1[3] * v1[3]);
                    if (isx && (cb < 1024 || cb >= 1920)) {
                        const int pos = ((cb >> 5) & 1) ? pcol : prow;
                        const f32x4 cs = *(const f32x4*)(cosT + pos * 16 + 4 * fq), sn = *(const f32x4*)(sinT + pos * 16 + 4 * fq);
                        const f32x4 o0 = v0 * cs - v1 * sn, o1 = v1 * cs + v0 * sn; v0 = o0; v1 = o1;
                    }
                    u32x2 w0, w1; w0.x = cvtpk(v0[0], v0[1]); w0.y = cvtpk(v0[2], v0[3]); w1.x = cvtpk(v1[0], v1[1]); w1.y = cvtpk(v1[2], v1[3]);
                    bf16_t* dst = P + (size_t)row * P0W + cb + 4 * fq;
                    *(u32x2*)dst = w0; *(u32x2*)(dst + 16) = w1;
                }
                if (u.pn >= 6) {
                    sq += __shfl_xor(sq, 16); sq += __shfl_xor(sq, 32);
                    if (fq == 0) atomicAdd(ssq + (size_t)row * 2 + (u.pn - 6), sq);
                }
                asm volatile("" ::: "memory");
            }
    }
};
struct EpiMlaUp {
    static constexpr bool PERM = false, AFTER_DRAIN = false;
    bf16_t* O; const float* ssq;
    __device__ __forceinline__ void operator()(const f32x4 (&acc)[2][2][4][2], const Unit& u, int wr, int wc, int fr, int fq) const {
        const bool kv = u.pn >= 3;
#pragma unroll
        for (int ai = 0; ai < 2; ++ai)
#pragma unroll
            for (int m = 0; m < 4; ++m) {
                const int row = u.pm * BM + ai * HALF + wr * 64 + m * 16 + fr;
                float s = 1.f;
                if (kv) s = rsqrtf(ssq[(size_t)row * 2 + 1] * (1.f / 128.f) + EPS);
#pragma unroll
                for (int bj = 0; bj < 2; ++bj)
#pragma unroll
                    for (int n = 0; n < 2; ++n) {
                        const int c = u.pn * BM + bj * HALF + wc * 32 + n * 16 + 4 * fq;
                        const f32x4 v = acc[ai][bj][m][n] * s; u32x2 w; w.x = cvtpk(v[0], v[1]); w.y = cvtpk(v[2], v[3]);
                        *(u32x2*)(O + (size_t)row * QKW + c) = w;
                    }
                asm volatile("" ::: "memory");
            }
    }
};
struct EpiStore {
    static constexpr bool PERM = false, AFTER_DRAIN = false;
    bf16_t* O; int ldc, ncols;
    __device__ __forceinline__ void operator()(const f32x4 (&acc)[2][2][4][2], const Unit& u, int wr, int wc, int fr, int fq) const {
#pragma unroll
        for (int ai = 0; ai < 2; ++ai)
#pragma unroll
            for (int m = 0; m < 4; ++m) {
                const int row = u.pm * BM + ai * HALF + wr * 64 + m * 16 + fr;
#pragma unroll
                for (int bj = 0; bj < 2; ++bj)
#pragma unroll
                    for (int n = 0; n < 2; ++n) {
                        const int c = u.pn * BM + bj * HALF + wc * 32 + n * 16 + 4 * fq;
                        if (c < ncols) { const f32x4 v = acc[ai][bj][m][n]; u32x2 w; w.x = cvtpk(v[0], v[1]); w.y = cvtpk(v[2], v[3]); *(u32x2*)(O + (size_t)row * ldc + c) = w; }
                    }
                asm volatile("" ::: "memory");
            }
    }
};
}

struct Params { const float* in[34]; float* out; unsigned char* ws; };
struct Fr {
    LAS unsigned char* lds; int tid, lane, wave, bid, G;
    const float* const* in; float* out; unsigned char* ws;
};
enum { I_X = 0, I_C, I_CTX, I_CCTX, I_WMOD, I_BMOD, I_GF1, I_WF1I, I_WF1O, I_GMIX, I_GF2, I_WF2I, I_WF2O, I_ABWIN, I_LQ1, I_LK1, I_LQ2, I_LK2, I_GSUB, I_GQ, I_WUQ, I_GKV,
       I_WUKV, I_ABWOUT, I_CDWIN, I_CONVW, I_CONVB, I_DTB, I_ALOG, I_DSKIP, I_GNORM, I_RPB, I_CDWOUT, I_GFINAL };

template <class Epi> DI void run_gemm(const Fr& F, const bf16_t* A, int lda, const bf16_t* Bt, int M, int N, int K, const Epi& E) {
    asm volatile("" : "+s"(K));
    pg8::Gemm g{A, Bt, M, N, K, lda}; pg8::StaticOrder S; S.init(M, N, F.G, F.bid);
    pg8::gemm_phase<Epi, pg8::StaticOrder, true, true>(F.lds, g, S, E);
}

DI void mod_phase(const Fr& F) {
    LAS float* sc = (LAS float*)F.lds;
    LAS float* red = sc + 17 * 1024;
    const float* c = F.in[I_C]; const float* cc = F.in[I_CCTX];
    for (int i = F.tid; i < 17 * 1024; i += 512) { const int m = i >> 10, k = i & 1023; const float v = m < 16 ? c[m * 1024 + k] : cc[k]; sc[i] = v / (1.f + __expf(-v)); }
    __syncthreads();
    const float* wmod = F.in[I_WMOD]; const float* bmod = F.in[I_BMOD]; float* mod = (float*)(F.ws + WS_MOD);
    for (int item = F.bid; item < 288; item += F.G) {
        const int l = item / 144, n0 = (item % 144) * 64, kp = F.wave;
        const float* wp = wmod + (size_t)l * 1024 * 9216 + n0 + F.lane;
        float acc[17];
#pragma unroll
        for (int m = 0; m < 17; ++m) acc[m] = 0.f;
        for (int k = kp * 128; k < kp * 128 + 128; k += 4) {
            const float w0 = wp[(size_t)k * 9216], w1 = wp[(size_t)(k + 1) * 9216], w2 = wp[(size_t)(k + 2) * 9216], w3 = wp[(size_t)(k + 3) * 9216];
#pragma unroll
            for (int m = 0; m < 17; ++m) { const f32x4 s = *(const LAS f32x4*)(sc + m * 1024 + k); acc[m] += (w0 * s[0] + w1 * s[1]) + (w2 * s[2] + w3 * s[3]); }
        }
#pragma unroll
        for (int m = 0; m < 17; ++m) red[(kp * 17 + m) * 64 + F.lane] = acc[m];
        __syncthreads();
        for (int i = F.tid; i < 17 * 64; i += 512) {
            const int m = i >> 6, cl = i & 63; float s = 0.f;
#pragma unroll
            for (int q = 0; q < 8; ++q) s += red[(q * 17 + m) * 64 + cl];
            mod[(size_t)(l * 17 + m) * 9216 + n0 + cl] = s + bmod[l * 9216 + n0 + cl];
        }
        __syncthreads();
    }
}
DI int maprow(int mode, int n0) {
    if (mode == 1) { const int up = n0 >= FF, j = up ? n0 - FF : n0; return (j >> 7) * 256 + (up ? 128 : 0) + (j & 127); }
    if (mode == 2) {
        if (n0 < 1024) return n0; if (n0 < 3072) return n0 - 1024 + C1_XBC; if (n0 < 3104) return n0 - 3072 + C1_DT;
        if (n0 < 3616) return n0 - 3104 + C1_Q; if (n0 < 4128) return n0 - 3616 + C1_K; return n0 - 4128 + C1_V;
    }
    return n0;
}
DI void conv_job(const Fr& F, int& base, const float* W, int K, int N, bf16_t* dst, int ldk, int koff, int mode, int rowoff, const float* kscale) {
    LAS float* scr = (LAS float*)(F.lds + F.wave * 8448);
    const int NGW = F.G * 8, gw = F.bid * 8 + F.wave, nblk = N / 32, nitems = (K / 64) * nblk, lane = F.lane;
    for (int it = ((gw - base) % NGW + NGW) % NGW; it < nitems; it += NGW) {
        const int kb = it / nblk, nb = it % nblk, k0 = 64 * kb, n0 = 32 * nb;
#pragma unroll 8
        for (int i = 0; i < 32; ++i) { const int kk = 2 * i + (lane >> 5); float v = W[(size_t)(k0 + kk) * N + n0 + (lane & 31)]; if (kscale) v *= kscale[k0 + kk]; scr[kk * 33 + (lane & 31)] = v; }
        asm volatile("s_waitcnt lgkmcnt(0)" ::: "memory");
        const int c = lane & 7, dr0 = rowoff + maprow(mode, n0);
#pragma unroll
        for (int j = 0; j < 4; ++j) {
            const int n = (lane >> 3) + 8 * j; const LAS float* s = scr + (8 * c) * 33 + n;
            u32x4 o; o.x = cvtpk(s[0 * 33], s[1 * 33]); o.y = cvtpk(s[2 * 33], s[3 * 33]); o.z = cvtpk(s[4 * 33], s[5 * 33]); o.w = cvtpk(s[6 * 33], s[7 * 33]);
            *(u32x4*)(dst + (size_t)(dr0 + n) * ldk + koff + k0 + 8 * c) = o;
        }
        asm volatile("s_waitcnt lgkmcnt(0)" ::: "memory");
    }
    base = (base + nitems) % NGW;
}
DI void zero_rect(const Fr& F, unsigned char* base, size_t pitch, int nrows, int chunks_per_row) {
    const int n = nrows * chunks_per_row; const u32x4 z = {0u, 0u, 0u, 0u};
    for (int i = F.bid * 512 + F.tid; i < n; i += F.G * 512) { const int r = i / chunks_per_row, c = i % chunks_per_row; *(u32x4*)(base + (size_t)r * pitch + (size_t)c * 16) = z; }
}
DI void prep_phase(const Fr& F) {
    mod_phase(F);
    int base = 0; unsigned char* ws = F.ws;
    const size_t LIN = (size_t)DM * 2 * FF, LOUT = (size_t)FF * DM;
    conv_job(F, base, F.in[I_WF1I], DM, 2 * FF, (bf16_t*)(ws + W0_F1I), DM, 0, 1, 0, nullptr);
    conv_job(F, base, F.in[I_WF1O], FF, DM, (bf16_t*)(ws + W0_F1O), FF, 0, 0, 0, nullptr);
    conv_job(F, base, F.in[I_WF2I], DM, 2 * FF, (bf16_t*)(ws + W0_F2I), DM, 0, 1, 0, nullptr);
    conv_job(F, base, F.in[I_WF2O], FF, DM, (bf16_t*)(ws + W0_F2O), FF, 0, 0, 0, nullptr);
    conv_job(F, base, F.in[I_ABWIN], DM, 1984, (bf16_t*)(ws + W0_ABI), DM, 0, 0, 0, nullptr);
    conv_job(F, base, F.in[I_WUQ], 256, 768, (bf16_t*)(ws + W0_UP), 384, 0, 0, 0, F.in[I_GQ]);
    conv_job(F, base, F.in[I_WUKV], 128, 1024, (bf16_t*)(ws + W0_UP), 384, 256, 0, 768, F.in[I_GKV]);
    conv_job(F, base, F.in[I_ABWOUT], DM, DM, (bf16_t*)(ws + W0_ABO), DM, 0, 0, 0, nullptr);
    conv_job(F, base, F.in[I_WF1I] + LIN, DM, 2 * FF, (bf16_t*)(ws + W1_F1I), DM, 0, 1, 0, nullptr);
    conv_job(F, base, F.in[I_WF1O] + LOUT, FF, DM, (bf16_t*)(ws + W1_F1O), FF, 0, 0, 0, nullptr);
    conv_job(F, base, F.in[I_WF2I] + LIN, DM, 2 * FF, (bf16_t*)(ws + W1_F2I), DM, 0, 1, 0, nullptr);
    conv_job(F, base, F.in[I_WF2O] + LOUT, FF, DM, (bf16_t*)(ws + W1_F2O), FF, 0, 0, 0, nullptr);
    conv_job(F, base, F.in[I_CDWIN], DM, 4640, (bf16_t*)(ws + W1_CDI), DM, 0, 2, 0, nullptr);
    conv_job(F, base, F.in[I_CDWOUT], 1536, DM, (bf16_t*)(ws + W1_CDO), 1536, 0, 0, 0, nullptr);
    zero_rect(F, ws + W0_ABI + (size_t)1984 * 2048, 2048, 64, 128);
    zero_rect(F, ws + W1_CDI + (size_t)4640 * 2048, 2048, 224, 128);
    zero_rect(F, ws + W0_UP + 512, 768, 768, 16);
    zero_rect(F, ws + W0_UP + (size_t)768 * 768, 768, 1024, 32);
    zero_rect(F, ws + WS_SSQ, (size_t)TT * 8, 1, TT * 8 / 16);
    if (F.bid == 0) {
        float* cosT = (float*)(ws + WS_ROPE); float* sinT = cosT + 1024;
        for (int i = F.tid; i < 1024; i += 512) {
            const int pos = i >> 4, fi = i & 15;
            const float freq = exp2f(-(float)fi * (13.287712379549449f / 16.f));
            const float ang = (float)pos * freq;
            const double tp = 6.283185307179586476925; const double n = __builtin_rint((double)ang / tp); const float r = (float)((double)ang - n * tp);
            cosT[i] = __cosf(r); sinT[i] = __sinf(r);
        }
    }
}
DI void norm_phase(const Fr& F, int layer, const float* g, int jshift, int nrows, const float* xin_x, const float* xin_c, bf16_t* H) {
    const float* mod = (const float*)(F.ws + WS_MOD) + (size_t)layer * 17 * 9216;
    const int NGW = F.G * 8, lane = F.lane;
    f32x4 gv[4];
#pragma unroll
    for (int j = 0; j < 4; ++j) gv[j] = *(const f32x4*)(g + 4 * lane + 256 * j);
    for (int row = F.bid * 8 + F.wave; row < nrows; row += NGW) {
        const bool isx = row < TX;
        const float* xr = isx ? xin_x + (size_t)row * DM : xin_c + (size_t)(row - TX) * DM;
        const float* mp = mod + (size_t)(isx ? (row >> 11) : 16) * 9216 + jshift * 1024;
        f32x4 v[4]; float s = 0.f;
#pragma unroll
        for (int j = 0; j < 4; ++j) { v[j] = *(const f32x4*)(xr + 4 * lane + 256 * j); s += (v[j][0] * v[j][0] + v[j][1] * v[j][1]) + (v[j][2] * v[j][2] + v[j][3] * v[j][3]); }
        const float rstd = rsqrtf(wave_sum(s) * (1.f / DM) + EPS);
#pragma unroll
        for (int j = 0; j < 4; ++j) {
            const f32x4 sh = *(const f32x4*)(mp + 4 * lane + 256 * j), sc = *(const f32x4*)(mp + 1024 + 4 * lane + 256 * j);
            const f32x4 y = v[j] * rstd * gv[j] * (sc + 1.f) + sh;
            u32x2 w; w.x = cvtpk(y[0], y[1]); w.y = cvtpk(y[2], y[3]);
            *(u32x2*)(H + (size_t)row * DM + 4 * lane + 256 * j) = w;
        }
    }
}
DI void final_norm_phase(const Fr& F) {
    const float* g = F.in[I_GFINAL]; const int NGW = F.G * 8, lane = F.lane;
    for (int row = F.bid * 8 + F.wave; row < TX; row += NGW) {
        float* xr = F.out + (size_t)row * DM; f32x4 v[4]; float s = 0.f;
#pragma unroll
        for (int j = 0; j < 4; ++j) { v[j] = *(const f32x4*)(xr + 4 * lane + 256 * j); s += (v[j][0] * v[j][0] + v[j][1] * v[j][1]) + (v[j][2] * v[j][2] + v[j][3] * v[j][3]); }
        const float rstd = rsqrtf(wave_sum(s) * (1.f / DM) + EPS);
#pragma unroll
        for (int j = 0; j < 4; ++j) *(f32x4*)(xr + 4 * lane + 256 * j) = v[j] * rstd * *(const f32x4*)(g + 4 * lane + 256 * j);
    }
}


struct KVSrc { const bf16_t* k1; int k1p, k1c; const bf16_t* k2; int k2p, k2c; const bf16_t* v; int vp, vc; };
constexpr int FL_K1 = 25600, FL_V0 = 51200, FL_VB = 17408, FL_VP = 272, FL_QR = 86016;

template <int DQK> DI void kv_load(const KVSrc& S, int rb, int tid, u32x4 (&kr)[DQK / 64], u32x4 (&vr)[2]) {
    constexpr int CPR = DQK / 8;
#pragma unroll
    for (int i = 0; i < DQK / 64; ++i) {
        const int id = tid + 512 * i, row = id / CPR, ch = id % CPR;
        const bf16_t* src = (DQK == 64 || ch < 16) ? S.k1 + (size_t)(rb + row) * S.k1p + S.k1c + ch * 8 : S.k2 + (size_t)(rb + row) * S.k2p + S.k2c + (ch - 16) * 8;
        kr[i] = *(const u32x4*)src;
    }
#pragma unroll
    for (int i = 0; i < 2; ++i) { const int id = tid + 512 * i, row = id >> 4, ch = id & 15; vr[i] = *(const u32x4*)(S.v + (size_t)(rb + row) * S.vp + S.vc + ch * 8); }
}
template <int DQK> DI void kv_store(LAS unsigned char* Kb, LAS unsigned char* Vb, int tid, const u32x4 (&kr)[DQK / 64], const u32x4 (&vr)[2]) {
    constexpr int CPR = DQK / 8, KP = DQK * 2 + 16;
#pragma unroll
    for (int i = 0; i < DQK / 64; ++i) { const int id = tid + 512 * i, row = id / CPR, ch = id % CPR; *(LAS u32x4*)(Kb + row * KP + ch * 16) = kr[i]; }
#pragma unroll
    for (int i = 0; i < 2; ++i) { const int id = tid + 512 * i, row = id >> 4, ch = id & 15; *(LAS u32x4*)(Vb + row * FL_VP + ch * 16) = vr[i]; }
}
template <int DQK, int NSR> DI void flash_run(const Fr& F, const KVSrc& S, const bf16x8 (&qf)[NSR], const LAS unsigned char* qlds, int nkt, int nxt, int xbase, int cbase, float sc2, f32x16 (&o)[4]) {
    constexpr int NS = DQK / 16, KP = DQK * 2 + 16;
    LAS unsigned char* lds = F.lds; const int tid = F.tid, lane = F.lane, r = lane & 31, h = lane >> 5;
    const int i16 = lane & 15, q4 = i16 >> 2, p4 = i16 & 3, blk = (lane >> 4) & 1;
    u32x4 kr[DQK / 64], vr[2];
    __syncthreads();
    kv_load<DQK>(S, nxt > 0 ? xbase : cbase, tid, kr, vr);
    kv_store<DQK>(lds, lds + FL_V0, tid, kr, vr);
    __syncthreads();
    float m = -1e30f, l = 0.f;
#pragma unroll
    for (int t = 0; t < 4; ++t) o[t] = zero16();
    for (int kt = 0; kt < nkt; ++kt) {
        const bool more = kt + 1 < nkt;
        if (more) { const int k1 = kt + 1; kv_load<DQK>(S, k1 < nxt ? xbase + 64 * k1 : cbase + 64 * (k1 - nxt), tid, kr, vr); }
        const LAS unsigned char* Kb = lds + (kt & 1) * FL_K1; const LAS unsigned char* Vb = lds + FL_V0 + (kt & 1) * FL_VB;
        f32x16 st[2];
#pragma unroll
        for (int ks = 0; ks < 2; ++ks) {
            f32x16 a = zero16();
#pragma unroll
            for (int s = 0; s < NS; ++s) { const bf16x8 kf = *(const LAS bf16x8*)(Kb + (ks * 32 + r) * KP + s * 32 + h * 16);
                bf16x8 qq; if (s < NSR) qq = qf[s < NSR ? s : 0]; else qq = *(const LAS bf16x8*)(qlds + (s - NSR) * 32);
                a = MFMA32(kf, qq, a);
                if (NS > 4 && (s & 3) == 3) asm volatile("" ::: "memory"); }
            st[ks] = a;
        }
        float mx = st[0][0];
#pragma unroll
        for (int i = 0; i < 16; ++i) { mx = fmaxf(mx, st[0][i]); mx = fmaxf(mx, st[1][i]); }
        mx *= sc2; mx = fmaxf(mx, __shfl_xor(mx, 32));
        const float mn = fmaxf(m, mx), alpha = ex2(m - mn); m = mn;
        float rs = 0.f;
#pragma unroll
        for (int ks = 0; ks < 2; ++ks)
#pragma unroll
            for (int i = 0; i < 16; ++i) { const float p = ex2(st[ks][i] * sc2 - mn); rs += p; st[ks][i] = p; }
        l = l * alpha + rs;
#pragma unroll
        for (int t = 0; t < 4; ++t) o[t] = o[t] * alpha;
#pragma unroll
        for (int ks = 0; ks < 2; ++ks)
#pragma unroll
            for (int s2 = 0; s2 < 2; ++s2) {
                const bf16x8 pf = pack8(st[ks][8 * s2], st[ks][8 * s2 + 1], st[ks][8 * s2 + 2], st[ks][8 * s2 + 3], st[ks][8 * s2 + 4], st[ks][8 * s2 + 5], st[ks][8 * s2 + 6], st[ks][8 * s2 + 7]);
                const LAS unsigned char* vb = Vb + (ks * 32 + 16 * s2 + 4 * h + q4) * FL_VP + (16 * blk + 4 * p4) * 2;
#pragma unroll
                for (int t = 0; t < 4; ++t) { const s16x4 lo = trread(vb + t * 64), hi = trread(vb + t * 64 + 8 * FL_VP); o[t] = MFMA32(cat8(lo, hi), pf, o[t]); }
                if (DQK > 64) asm volatile("" ::: "memory");
            }
        if (more) kv_store<DQK>(lds + ((kt + 1) & 1) * FL_K1, lds + FL_V0 + ((kt + 1) & 1) * FL_VB, tid, kr, vr);
        __syncthreads();
    }
    l += __shfl_xor(l, 32);
    const float inv = 1.f / l;
#pragma unroll
    for (int t = 0; t < 4; ++t) o[t] = o[t] * inv;
}

DI void attn0_phase(const Fr& F) {
    const bf16_t* P = (const bf16_t*)(F.ws + WS_P0); const bf16_t* QK = (const bf16_t*)(F.ws + WS_QKV);
    bf16_t* CAT = (bf16_t*)(F.ws + WS_H); bf16_t* ODS = (bf16_t*)(F.ws + WS_ODS);
    const int lane = F.lane, r = lane & 31, h = lane >> 5;
    float lam;
    {
        const float d1 = wave_sum(F.in[I_LQ1][lane] * F.in[I_LK1][lane]), d2 = wave_sum(F.in[I_LQ2][lane] * F.in[I_LK2][lane]);
        lam = __expf(d1) - __expf(d2) + 0.2f;
    }
    const float* gsub = F.in[I_GSUB];
    const float* cosT = (const float*)(F.ws + WS_ROPE); const float* sinT = cosT + 1024; const float* ssq = (const float*)(F.ws + WS_SSQ);
    for (int it = F.bid; it < 1152; it += F.G) {
        int type, b, qb, hd;
        if (it < 512) { type = 0; b = it >> 5; qb = (it >> 2) & 7; hd = it & 3; }
        else if (it < 1024) { type = 1; const int j = it - 512; b = j >> 5; qb = (j >> 2) & 7; hd = j & 3; }
        else if (it < 1088) { type = 2; const int j = it - 1024; b = j >> 2; qb = 0; hd = j & 3; }
        else { type = 3; const int j = it - 1088; b = j >> 2; qb = 0; hd = j & 3; }
        const bool xq = type < 2;
        const int row = (xq ? b * SEQ + qb * 256 : TX + b * CTXL) + F.wave * 32 + r;
        const int nkt = xq ? 36 : 4, nxt = xq ? 32 : 0, xbase = b * SEQ, cbase = TX + b * CTXL;
        f32x16 o[4];
        if ((type & 1) == 0) {
            KVSrc S{QK, QKW, 768 + hd * 256, P, P0W, 1920, QK, QKW, 768 + hd * 256 + 128};
            bf16x8 qf[8];
            const bf16_t* qptr = QK + (size_t)row * QKW + hd * 192;
#pragma unroll
            for (int s = 0; s < 8; ++s) qf[s] = *(const bf16x8*)(qptr + 16 * s + 8 * h);
            LAS unsigned char* qlds = F.lds + FL_QR + F.wave * 4608 + r * 144 + h * 16;
            {
                const int t = row & 2047;
#pragma unroll
                for (int grp = 0; grp < 2; ++grp) {
                    const int pos = grp ? (t & 63) : (t >> 6);
                    const bf16x8 x1 = *(const bf16x8*)(qptr + 128 + 32 * grp + 8 * h), x2 = *(const bf16x8*)(qptr + 144 + 32 * grp + 8 * h);
                    bf16x8 y1 = x1, y2 = x2;
                    if (xq) {
                        const f32x4 c0 = *(const f32x4*)(cosT + pos * 16 + 8 * h), c1 = *(const f32x4*)(cosT + pos * 16 + 8 * h + 4), s0 = *(const f32x4*)(sinT + pos * 16 + 8 * h), s1 = *(const f32x4*)(sinT + pos * 16 + 8 * h + 4);
                        float a[8], bq[8];
#pragma unroll
                        for (int j = 0; j < 8; ++j) { const float u1 = bf2f((unsigned short)x1[j]), u2 = bf2f((unsigned short)x2[j]), cv = j < 4 ? c0[j & 3] : c1[j & 3], sv = j < 4 ? s0[j & 3] : s1[j & 3];
                            a[j] = u1 * cv - u2 * sv; bq[j] = u2 * cv + u1 * sv; }
                        y1 = pack8(a[0], a[1], a[2], a[3], a[4], a[5], a[6], a[7]); y2 = pack8(bq[0], bq[1], bq[2], bq[3], bq[4], bq[5], bq[6], bq[7]);
                    }
                    *(LAS bf16x8*)(qlds + (2 * grp) * 32) = y1; *(LAS bf16x8*)(qlds + (2 * grp + 1) * 32) = y2;
                }
            }
            const float rq = rsqrtf(ssq[(size_t)row * 2] * (1.f / 256.f) + EPS);
            flash_run<192, 8>(F, S, qf, qlds, nkt, nxt, xbase, cbase, 0.07216878364870322f * LOG2E * rq, o);
#pragma unroll
            for (int t = 0; t < 4; ++t)
#pragma unroll
                for (int g = 0; g < 4; ++g) { u32x2 w; w.x = cvtpk(o[t][4 * g], o[t][4 * g + 1]); w.y = cvtpk(o[t][4 * g + 2], o[t][4 * g + 3]);
                    *(u32x2*)(CAT + (size_t)row * DM + 512 + hd * 128 + t * 32 + 8 * g + 4 * h) = w; }
        } else {
            for (int c = 0; c < 2; ++c) {
                KVSrc S{P, P0W, 512 + hd * 128 + c * 64, nullptr, 0, 0, P, P0W, 1024 + hd * 128};
                bf16x8 qf[4];
                { const bf16_t* qptr = P + (size_t)row * P0W + hd * 128 + c * 64;
#pragma unroll
                  for (int s = 0; s < 4; ++s) qf[s] = *(const bf16x8*)(qptr + 16 * s + 8 * h); }
                flash_run<64, 4>(F, S, qf, nullptr, nkt, nxt, xbase, cbase, 0.125f * LOG2E, o);
                bf16_t* sp = ODS + (size_t)row * 512 + hd * 128 + 4 * h;
                if (c == 0) {
#pragma unroll
                    for (int t = 0; t < 4; ++t)
#pragma unroll
                        for (int g = 0; g < 4; ++g) { u32x2 w; w.x = cvtpk(o[t][4 * g], o[t][4 * g + 1]); w.y = cvtpk(o[t][4 * g + 2], o[t][4 * g + 3]); *(u32x2*)(sp + t * 32 + 8 * g) = w; }
                } else {
                    float ss = 0.f;
#pragma unroll
                    for (int t = 0; t < 4; ++t)
#pragma unroll
                        for (int g = 0; g < 4; ++g) { const u32x2 w = *(const u32x2*)(sp + t * 32 + 8 * g);
                            const float a0 = bflo(w.x) - lam * o[t][4 * g], a1 = bfhi(w.x) - lam * o[t][4 * g + 1], a2 = bflo(w.y) - lam * o[t][4 * g + 2], a3 = bfhi(w.y) - lam * o[t][4 * g + 3];
                            o[t][4 * g] = a0; o[t][4 * g + 1] = a1; o[t][4 * g + 2] = a2; o[t][4 * g + 3] = a3; ss += (a0 * a0 + a1 * a1) + (a2 * a2 + a3 * a3); }
                    ss += __shfl_xor(ss, 32);
                    const float rstd = rsqrtf(ss * (1.f / 128.f) + EPS) * 0.8f;
#pragma unroll
                    for (int t = 0; t < 4; ++t)
#pragma unroll
                        for (int g = 0; g < 4; ++g) { const f32x4 gg = *(const f32x4*)(gsub + t * 32 + 8 * g + 4 * h); u32x2 w;
                            w.x = cvtpk(o[t][4 * g] * rstd * gg[0], o[t][4 * g + 1] * rstd * gg[1]); w.y = cvtpk(o[t][4 * g + 2] * rstd * gg[2], o[t][4 * g + 3] * rstd * gg[3]);
                            *(u32x2*)(CAT + (size_t)row * DM + hd * 128 + t * 32 + 8 * g + 4 * h) = w; }
                }
            }
        }
    }
}

constexpr int NA_KP = 528, NA_BUF = 64 * NA_KP, NA_V0 = 2 * NA_BUF, NA_RPB = 4 * NA_BUF;
DI void na_load(const bf16_t* P1, int rb, int kcol, int vcol, int tid, u32x4 (&kr)[4], u32x4 (&vr)[4]) {
#pragma unroll
    for (int i = 0; i < 4; ++i) { const int id = tid + 512 * i, row = id >> 5, ch = id & 31; const bf16_t* base = P1 + (size_t)(rb + row) * P1W + ch * 8;
        kr[i] = *(const u32x4*)(base + kcol); vr[i] = *(const u32x4*)(base + vcol); }
}
DI void na_store(LAS unsigned char* Kb, LAS unsigned char* Vb, int tid, const u32x4 (&kr)[4], const u32x4 (&vr)[4]) {
#pragma unroll
    for (int i = 0; i < 4; ++i) { const int id = tid + 512 * i, row = id >> 5, ch = id & 31; *(LAS u32x4*)(Kb + row * NA_KP + ch * 16) = kr[i]; *(LAS u32x4*)(Vb + row * NA_KP + ch * 16) = vr[i]; }
}
DI void na_item(const Fr& F, int b, int gr, int hg) {
    bf16_t* P1 = (bf16_t*)(F.ws + WS_P1);
    LAS unsigned char* lds = F.lds; const int tid = F.tid, lane = F.lane, r = lane & 31, h = lane >> 5;
    const int i16 = lane & 15, q4 = i16 >> 2, p4 = i16 & 3, blk = (lane >> 4) & 1;
    const int hl = F.wave & 3, qs = F.wave >> 2, head = hg * 4 + hl, qc = qs * 32 + r;
    const int row = b * SEQ + gr * 64 + qc;
    const int r0 = min(max(gr - 4, 0), 24), c0 = min(max(qc - 8, 0), 48);
    const int kcol = C1_K + hg * 256, vcol = C1_V + hg * 256;
    bf16_t* qptr = P1 + (size_t)row * P1W + C1_Q + head * 64;
    bf16x8 qf[4];
#pragma unroll
    for (int s = 0; s < 4; ++s) qf[s] = *(const bf16x8*)(qptr + 16 * s + 8 * h);
    u32x4 kr[4], vr[4];
    __syncthreads();
    LAS float* rpbs = (LAS float*)(lds + NA_RPB);
    { const float* rpb = F.in[I_RPB] + (size_t)hg * 4 * 465; for (int i = tid; i < 4 * 465; i += 512) rpbs[i] = rpb[i]; }
    na_load(P1, b * SEQ + r0 * 64, kcol, vcol, tid, kr, vr);
    na_store(lds, lds + NA_V0, tid, kr, vr);
    __syncthreads();
    float m = -1e30f, l = 0.f; f32x16 o[2]; o[0] = zero16(); o[1] = zero16();
    const float sc2 = 0.125f * LOG2E;
    for (int kt = 0; kt < 12; ++kt) {
        const bool more = kt + 1 < 12;
        if (more) { const int k1 = kt + 1; na_load(P1, k1 < 8 ? b * SEQ + (r0 + k1) * 64 : TX + b * CTXL + (k1 - 8) * 64, kcol, vcol, tid, kr, vr); }
        const LAS unsigned char* Kb = lds + (kt & 1) * NA_BUF + hl * 128; const LAS unsigned char* Vb = lds + NA_V0 + (kt & 1) * NA_BUF + hl * 128;
        f32x16 st[2];
#pragma unroll
        for (int ks = 0; ks < 2; ++ks) {
            f32x16 a = zero16();
#pragma unroll
            for (int s = 0; s < 4; ++s) { const bf16x8 kf = *(const LAS bf16x8*)(Kb + (ks * 32 + r) * NA_KP + s * 32 + h * 16); a = MFMA32(kf, qf[s], a); }
            st[ks] = a;
        }
        if (kt < 8) {
            const LAS float* bp = rpbs + (hl * 15 + (r0 + kt - gr + 7)) * 31 + 15 - qc;
#pragma unroll
            for (int ks = 0; ks < 2; ++ks)
#pragma unroll
                for (int i = 0; i < 16; ++i) { const int kc = ks * 32 + crow(i, h); const bool ok = kc >= c0 && kc < c0 + 16;
                    const float bias = ok ? bp[kc] : 0.f; st[ks][i] = ok ? (st[ks][i] * sc2 + bias * LOG2E) : -1e30f; }
        } else {
#pragma unroll
            for (int ks = 0; ks < 2; ++ks)
#pragma unroll
                for (int i = 0; i < 16; ++i) st[ks][i] = st[ks][i] * sc2;
        }
        float mx = st[0][0];
#pragma unroll
        for (int i = 0; i < 16; ++i) { mx = fmaxf(mx, st[0][i]); mx = fmaxf(mx, st[1][i]); }
        mx = fmaxf(mx, __shfl_xor(mx, 32));
        const float mn = fmaxf(m, mx), alpha = ex2(m - mn); m = mn;
        float rs = 0.f;
#pragma unroll
        for (int ks = 0; ks < 2; ++ks)
#pragma unroll
            for (int i = 0; i < 16; ++i) { const float p = ex2(st[ks][i] - mn); rs += p; st[ks][i] = p; }
        l = l * alpha + rs; o[0] = o[0] * alpha; o[1] = o[1] * alpha;
#pragma unroll
        for (int ks = 0; ks < 2; ++ks)
#pragma unroll
            for (int s2 = 0; s2 < 2; ++s2) {
                const bf16x8 pf = pack8(st[ks][8 * s2], st[ks][8 * s2 + 1], st[ks][8 * s2 + 2], st[ks][8 * s2 + 3], st[ks][8 * s2 + 4], st[ks][8 * s2 + 5], st[ks][8 * s2 + 6], st[ks][8 * s2 + 7]);
                const LAS unsigned char* vb = Vb + (ks * 32 + 16 * s2 + 4 * h + q4) * NA_KP + (16 * blk + 4 * p4) * 2;
#pragma unroll
                for (int t = 0; t < 2; ++t) { const s16x4 lo = trread(vb + t * 64), hi = trread(vb + t * 64 + 8 * NA_KP); o[t] = MFMA32(cat8(lo, hi), pf, o[t]); }
            }
        if (more) na_store(lds + ((kt + 1) & 1) * NA_BUF, lds + NA_V0 + ((kt + 1) & 1) * NA_BUF, tid, kr, vr);
        __syncthreads();
    }
    l += __shfl_xor(l, 32);
    const float inv = 1.f / l;
#pragma unroll
    for (int t = 0; t < 2; ++t)
#pragma unroll
        for (int g = 0; g < 4; ++g) { u32x2 w; w.x = cvtpk(o[t][4 * g] * inv, o[t][4 * g + 1] * inv); w.y = cvtpk(o[t][4 * g + 2] * inv, o[t][4 * g + 3] * inv);
            *(u32x2*)(qptr + t * 32 + 8 * g + 4 * h) = w; }
}


constexpr int SS_XP = 144, SS_BP = 272;
constexpr int SS_X = 0, SS_B = 18432, SS_C = 53248, SS_H = 88064, SS_DT = 105472, SS_ACS = 105984, SS_SW = 106496, SS_CW = 107008, SS_CB = 113408;
DI void ssd_item(const Fr& F, int b, int hd) {
    const bf16_t* P1 = (const bf16_t*)(F.ws + WS_P1); bf16_t* Y = (bf16_t*)(F.ws + WS_H);
    LAS unsigned char* lds = F.lds; const int tid = F.tid, lane = F.lane, wave = F.wave, r = lane & 31, h = lane >> 5;
    const int i16 = lane & 15, q4 = i16 >> 2, p4 = i16 & 3, blk = (lane >> 4) & 1;
    const int g = hd >> 2, pt = wave >> 2, lt = wave & 3;
    LAS float* dtv = (LAS float*)(lds + SS_DT); LAS float* acs = (LAS float*)(lds + SS_ACS); LAS float* sw = (LAS float*)(lds + SS_SW);
    LAS float* cws = (LAS float*)(lds + SS_CW); LAS float* cbs = (LAS float*)(lds + SS_CB);
    __syncthreads();
    for (int i = tid; i < 6 * 320; i += 512) {
        const int j = i / 320, ci = i % 320; const int ch = ci < 64 ? hd * 64 + ci : (ci < 192 ? 1024 + g * 128 + (ci - 64) : 1536 + g * 128 + (ci - 192));
        if (j < 5) cws[j * 320 + ci] = F.in[I_CONVW][j * 2048 + ch]; else cbs[ci] = F.in[I_CONVB][ch];
    }
    for (int d = 0; d < 2; ++d) {
        __syncthreads();
        const float a = -__expf(F.in[I_ALOG][d * 16 + hd]), Dsk = F.in[I_DSKIP][d * 16 + hd], dtb = F.in[I_DTB][d * 16 + hd];
        const int dtcol = C1_DT + d * 16 + hd;
        f32x16 hreg = zero16();
        for (int i = tid; i < 64 * SS_BP / 4; i += 512) ((LAS unsigned*)(lds + SS_H))[i] = 0u;
        for (int ci = 0; ci < 18; ++ci) {
            const bool isx = ci >= 2; const int cc = isx ? ci - 2 : ci, nch = isx ? 16 : 2, seglen = nch * 128, segrow0 = isx ? b * SEQ : TX + b * CTXL;
            const int tokbase = (d ? nch - 1 - cc : cc) * 128;
            __syncthreads();
            for (int it = tid; it < 640; it += 512) {
                const int cgp = it % 40, rb = it / 40, ci0 = cgp * 8;
                const int ch0 = ci0 < 64 ? hd * 64 + ci0 : (ci0 < 192 ? 1024 + g * 128 + (ci0 - 64) : 1536 + g * 128 + (ci0 - 192));
                const int t0 = tokbase + rb * 8 - 2;
                u32x4 raw[12];
#pragma unroll
                for (int k = 0; k < 12; ++k) { const int tt = t0 + k; raw[k] = (tt >= 0 && tt < seglen) ? *(const u32x4*)(P1 + (size_t)(segrow0 + tt) * P1W + C1_XBC + ch0) : (u32x4){0u, 0u, 0u, 0u}; }
                f32x4 w[5][2], bb[2];
#pragma unroll
                for (int j = 0; j < 5; ++j) { w[j][0] = *(const LAS f32x4*)(cws + j * 320 + ci0); w[j][1] = *(const LAS f32x4*)(cws + j * 320 + ci0 + 4); }
                bb[0] = *(const LAS f32x4*)(cbs + ci0); bb[1] = *(const LAS f32x4*)(cbs + ci0 + 4);
                LAS unsigned char* dst = ci0 < 64 ? lds + SS_X + ci0 * 2 : (ci0 < 192 ? lds + SS_B + (ci0 - 64) * 2 : lds + SS_C + (ci0 - 192) * 2);
                const int pitch = ci0 < 64 ? SS_XP : SS_BP;
#pragma unroll
                for (int i = 0; i < 8; ++i) {
                    f32x4 a0 = bb[0], a1 = bb[1];
#pragma unroll
                    for (int j = 0; j < 5; ++j) { const u32x4 q = raw[i + j];
                        a0 += w[j][0] * (f32x4){bflo(q.x), bfhi(q.x), bflo(q.y), bfhi(q.y)}; a1 += w[j][1] * (f32x4){bflo(q.z), bfhi(q.z), bflo(q.w), bfhi(q.w)}; }
                    u32x4 ov; ov.x = cvtpk(siluf(a0[0]), siluf(a0[1])); ov.y = cvtpk(siluf(a0[2]), siluf(a0[3])); ov.z = cvtpk(siluf(a1[0]), siluf(a1[1])); ov.w = cvtpk(siluf(a1[2]), siluf(a1[3]));
                    const int lr = rb * 8 + i, l = d ? 127 - lr : lr;
                    *(LAS u32x4*)(dst + l * pitch) = ov;
                }
            }
            if (tid < 128) {
                const int tok = tokbase + (d ? 127 - tid : tid);
                const float xr = bf2f(P1[(size_t)(segrow0 + tok) * P1W + dtcol]) + dtb;
                dtv[tid] = xr > 20.f ? xr : log1pf(__expf(xr));
            }
            __syncthreads();
            float el, dtot;
            {
                const float v0 = a * dtv[2 * lane], v1 = a * dtv[2 * lane + 1]; float ps = v0 + v1;
#pragma unroll
                for (int off = 1; off < 64; off <<= 1) { const float t = __shfl_up(ps, off); if (lane >= off) ps += t; }
                const float tot = __shfl(ps, 63);
                const float c0 = ps - v1, c1 = ps;
                acs[2 * lane] = c0; acs[2 * lane + 1] = c1;
                sw[2 * lane] = dtv[2 * lane] * __expf(tot - c0); sw[2 * lane + 1] = dtv[2 * lane + 1] * __expf(tot - c1);
                dtot = __expf(tot);
            }
            asm volatile("s_waitcnt lgkmcnt(0)" ::: "memory");
            if (isx) {
                const int lcol = lt * 32 + r; const float al = acs[lcol]; el = __expf(al);
                f32x16 yacc = zero16();
                for (int stl = 0; stl <= lt; ++stl) {
                    f32x16 sa = zero16();
#pragma unroll
                    for (int kk = 0; kk < 8; ++kk) {
                        const bf16x8 af = *(const LAS bf16x8*)(lds + SS_B + (stl * 32 + r) * SS_BP + kk * 32 + h * 16);
                        const bf16x8 bf = *(const LAS bf16x8*)(lds + SS_C + lcol * SS_BP + kk * 32 + h * 16);
                        sa = MFMA32(af, bf, sa);
                    }
#pragma unroll
                    for (int i = 0; i < 16; ++i) { const int s = stl * 32 + crow(i, h); const float e = __expf(fminf(al - acs[s], 0.f)) * dtv[s]; sa[i] = (s <= lcol) ? sa[i] * e : 0.f; }
#pragma unroll
                    for (int s2 = 0; s2 < 2; ++s2) {
                        const bf16x8 gf = pack8(sa[8 * s2], sa[8 * s2 + 1], sa[8 * s2 + 2], sa[8 * s2 + 3], sa[8 * s2 + 4], sa[8 * s2 + 5], sa[8 * s2 + 6], sa[8 * s2 + 7]);
                        const LAS unsigned char* xb = lds + SS_X + (stl * 32 + 16 * s2 + 4 * h + q4) * SS_XP + (pt * 32 + 16 * blk + 4 * p4) * 2;
                        const s16x4 lo = trread(xb), hi = trread(xb + 8 * SS_XP);
                        yacc = MFMA32(cat8(lo, hi), gf, yacc);
                    }
                }
                f32x16 oa = zero16();
#pragma unroll
                for (int kk = 0; kk < 8; ++kk) {
                    const bf16x8 af = *(const LAS bf16x8*)(lds + SS_H + (pt * 32 + r) * SS_BP + kk * 32 + h * 16);
                    const bf16x8 bf = *(const LAS bf16x8*)(lds + SS_C + lcol * SS_BP + kk * 32 + h * 16);
                    oa = MFMA32(af, bf, oa);
                }
                const int tok = tokbase + (d ? 127 - lcol : lcol);
                bf16_t* yp = Y + (size_t)(b * SEQ + tok) * DM + hd * 64 + pt * 32 + 4 * h;
#pragma unroll
                for (int gq = 0; gq < 4; ++gq) {
                    const u32x2 xw = *(const LAS u32x2*)(lds + SS_X + lcol * SS_XP + (pt * 32 + 8 * gq + 4 * h) * 2);
                    float y0 = yacc[4 * gq] + el * oa[4 * gq] + Dsk * bflo(xw.x), y1 = yacc[4 * gq + 1] + el * oa[4 * gq + 1] + Dsk * bfhi(xw.x);
                    float y2 = yacc[4 * gq + 2] + el * oa[4 * gq + 2] + Dsk * bflo(xw.y), y3 = yacc[4 * gq + 3] + el * oa[4 * gq + 3] + Dsk * bfhi(xw.y);
                    unsigned long long* gp = (unsigned long long*)(yp + 8 * gq);
                    if (d) { const unsigned long long old = __hip_atomic_load(gp, __ATOMIC_RELAXED, __HIP_MEMORY_SCOPE_AGENT); const unsigned lo = (unsigned)old, hi = (unsigned)(old >> 32);
                        y0 += bflo(lo); y1 += bfhi(lo); y2 += bflo(hi); y3 += bfhi(hi); }
                    *gp = (unsigned long long)cvtpk(y0, y1) | ((unsigned long long)cvtpk(y2, y3) << 32);
                }
            }
            __syncthreads();
            {
                f32x16 ha = hreg * dtot;
#pragma unroll
                for (int kk = 0; kk < 8; ++kk) {
                    const int k0 = 16 * kk + 8 * h;
                    const LAS unsigned char* xb = lds + SS_X + (k0 + q4) * SS_XP + (pt * 32 + 16 * blk + 4 * p4) * 2;
                    const s16x4 xl = trread(xb), xh = trread(xb + 4 * SS_XP);
                    const f32x4 w0 = *(const LAS f32x4*)(sw + k0), w1 = *(const LAS f32x4*)(sw + k0 + 4);
                    const bf16x8 af = pack8(bf2f((unsigned short)xl[0]) * w0[0], bf2f((unsigned short)xl[1]) * w0[1], bf2f((unsigned short)xl[2]) * w0[2], bf2f((unsigned short)xl[3]) * w0[3],
                                            bf2f((unsigned short)xh[0]) * w1[0], bf2f((unsigned short)xh[1]) * w1[1], bf2f((unsigned short)xh[2]) * w1[2], bf2f((unsigned short)xh[3]) * w1[3]);
                    const LAS unsigned char* bb = lds + SS_B + (k0 + q4) * SS_BP + (lt * 32 + 16 * blk + 4 * p4) * 2;
                    const s16x4 bl = trread(bb), bh = trread(bb + 4 * SS_BP);
                    ha = MFMA32(af, cat8(bl, bh), ha);
                }
                hreg = ha;
#pragma unroll
                for (int i = 0; i < 16; ++i) *(LAS unsigned short*)(lds + SS_H + (pt * 32 + crow(i, h)) * SS_BP + (lt * 32 + r) * 2) = (unsigned short)(cvtpk(ha[i], 0.f) & 0xffffu);
            }
        }
    }
}
DI void mix1_phase(const Fr& F) {
    for (int it = F.bid; it < 256; it += F.G) ssd_item(F, it >> 4, it & 15);
    for (int it = F.bid; it < 1024; it += F.G) na_item(F, it >> 6, (it >> 1) & 31, it & 1);
}
DI void merge1_phase(const Fr& F) {
    bf16_t* P1 = (bf16_t*)(F.ws + WS_P1); const bf16_t* Y = (const bf16_t*)(F.ws + WS_H); const float* gn = F.in[I_GNORM];
    const int NGW = F.G * 8, lane = F.lane;
    f32x4 gv[4];
#pragma unroll
    for (int j = 0; j < 4; ++j) gv[j] = *(const f32x4*)(gn + 16 * lane + 4 * j);
    for (int row = F.bid * 8 + F.wave; row < TX; row += NGW) {
        bf16_t* zp = P1 + (size_t)row * P1W + 16 * lane; const bf16_t* yp = Y + (size_t)row * DM + 16 * lane;
        const u32x4 z0 = *(const u32x4*)zp, z1 = *(const u32x4*)(zp + 8), y0 = *(const u32x4*)yp, y1 = *(const u32x4*)(yp + 8);
        float v[16];
        const unsigned zz[8] = {z0.x, z0.y, z0.z, z0.w, z1.x, z1.y, z1.z, z1.w}, yy[8] = {y0.x, y0.y, y0.z, y0.w, y1.x, y1.y, y1.z, y1.w};
        float s = 0.f;
#pragma unroll
        for (int i = 0; i < 8; ++i) { v[2 * i] = bflo(yy[i]) * siluf(bflo(zz[i])); v[2 * i + 1] = bfhi(yy[i]) * siluf(bfhi(zz[i])); s += v[2 * i] * v[2 * i] + v[2 * i + 1] * v[2 * i + 1]; }
        s += __shfl_xor(s, 1); s += __shfl_xor(s, 2); s += __shfl_xor(s, 4); s += __shfl_xor(s, 8);
        const float rstd = rsqrtf(s * (1.f / 256.f) + EPS);
        u32x4 o0, o1;
        o0.x = cvtpk(v[0] * rstd * gv[0][0], v[1] * rstd * gv[0][1]); o0.y = cvtpk(v[2] * rstd * gv[0][2], v[3] * rstd * gv[0][3]);
        o0.z = cvtpk(v[4] * rstd * gv[1][0], v[5] * rstd * gv[1][1]); o0.w = cvtpk(v[6] * rstd * gv[1][2], v[7] * rstd * gv[1][3]);
        o1.x = cvtpk(v[8] * rstd * gv[2][0], v[9] * rstd * gv[2][1]); o1.y = cvtpk(v[10] * rstd * gv[2][2], v[11] * rstd * gv[2][3]);
        o1.z = cvtpk(v[12] * rstd * gv[3][0], v[13] * rstd * gv[3][1]); o1.w = cvtpk(v[14] * rstd * gv[3][2], v[15] * rstd * gv[3][3]);
        *(u32x4*)zp = o0; *(u32x4*)(zp + 8) = o1;
    }
}

DI void refresh(Fr& F, const Params& prm) {
    int t = threadIdx.x; asm volatile("" : "+v"(t));
    F.tid = t; F.lane = t & 63; F.wave = __builtin_amdgcn_readfirstlane(t >> 6);
    unsigned char* w = prm.ws; asm volatile("" : "+s"(w)); F.ws = w;
    float* o = prm.out; asm volatile("" : "+s"(o)); F.out = o;
}
__global__ void __launch_bounds__(512, 2) mega_fwd(Params prm) {
    extern __shared__ __attribute__((aligned(16))) unsigned char lds_raw[];
    cg::grid_group grid = cg::this_grid();
    Fr F; F.lds = (LAS unsigned char*)lds_raw; F.bid = blockIdx.x; F.G = gridDim.x; F.in = prm.in;
    refresh(F, prm);
#define WB(off) ((const bf16_t*)(F.ws + (off)))
#define WP(off) ((bf16_t*)(F.ws + (off)))
#define MOD(l, j) ((const float*)(F.ws + WS_MOD) + (size_t)(l) * 17 * 9216 + (j) * 1024)
#define COST ((const float*)(F.ws + WS_ROPE))
#define SSQ ((float*)(F.ws + WS_SSQ))
#define CRES ((float*)(F.ws + WS_CTXRES))
#define SYNC() do { grid.sync(); refresh(F, prm); } while (0)
    prep_phase(F); SYNC();
    norm_phase(F, 0, F.in[I_GF1], 0, TT, F.in[I_X], F.in[I_CTX], WP(WS_H)); SYNC();
    run_gemm(F, WB(WS_H), DM, WB(W0_F1I), TT, 2 * FF, DM, pg8::EpiSwiglu{WP(WS_ACT)}); SYNC();
    run_gemm(F, WB(WS_ACT), FF, WB(W0_F1O), TT, DM, FF, pg8::EpiRes{F.in[I_X], F.in[I_CTX], F.out, CRES, MOD(0, 2), 0.5f}); SYNC();
    norm_phase(F, 0, F.in[I_GMIX], 3, TT, F.out, CRES, WP(WS_H)); SYNC();
    run_gemm(F, WB(WS_H), DM, WB(W0_ABI), TT, 2048, DM, pg8::EpiAbIn{WP(WS_P0), COST, COST + 1024, SSQ}); SYNC();
    run_gemm(F, WB(WS_P0) + 1536, P0W, WB(W0_UP), TT, QKW, 384, pg8::EpiMlaUp{WP(WS_QKV), SSQ}); SYNC();
    attn0_phase(F); SYNC();
    run_gemm(F, WB(WS_H), DM, WB(W0_ABO), TT, DM, DM, pg8::EpiRes{F.out, CRES, F.out, CRES, MOD(0, 5), 1.f}); SYNC();
    norm_phase(F, 0, F.in[I_GF2], 6, TT, F.out, CRES, WP(WS_H)); SYNC();
    run_gemm(F, WB(WS_H), DM, WB(W0_F2I), TT, 2 * FF, DM, pg8::EpiSwiglu{WP(WS_ACT)}); SYNC();
    run_gemm(F, WB(WS_ACT), FF, WB(W0_F2O), TT, DM, FF, pg8::EpiRes{F.out, CRES, F.out, CRES, MOD(0, 8), 0.5f}); SYNC();
    norm_phase(F, 1, F.in[I_GF1] + DM, 0, TT, F.out, CRES, WP(WS_H)); SYNC();
    run_gemm(F, WB(WS_H), DM, WB(W1_F1I), TT, 2 * FF, DM, pg8::EpiSwiglu{WP(WS_ACT)}); SYNC();
    run_gemm(F, WB(WS_ACT), FF, WB(W1_F1O), TT, DM, FF, pg8::EpiRes{F.out, CRES, F.out, CRES, MOD(1, 2), 0.5f}); SYNC();
    norm_phase(F, 1, F.in[I_GMIX] + DM, 3, TT, F.out, CRES, WP(WS_H)); SYNC();
    run_gemm(F, WB(WS_H), DM, WB(W1_CDI), TT, 4864, DM, pg8::EpiStore{WP(WS_P1), P1W, P1W}); SYNC();
    mix1_phase(F); SYNC();
    merge1_phase(F); SYNC();
    run_gemm(F, WB(WS_P1), P1W, WB(W1_CDO), TX, DM, 1536, pg8::EpiRes{F.out, CRES, F.out, CRES, MOD(1, 5), 1.f}); SYNC();
    norm_phase(F, 1, F.in[I_GF2] + DM, 6, TX, F.out, CRES, WP(WS_H)); SYNC();
    run_gemm(F, WB(WS_H), DM, WB(W1_F2I), TX, 2 * FF, DM, pg8::EpiSwiglu{WP(WS_ACT)}); SYNC();
    run_gemm(F, WB(WS_ACT), FF, WB(W1_F2O), TX, DM, FF, pg8::EpiRes{F.out, CRES, F.out, CRES, MOD(1, 8), 0.5f}); SYNC();
    final_norm_phase(F);
}

extern "C" void kernel_launch(void* const* d_in, const int* in_sizes, int n_in, void* d_out, int out_size, void* d_ws, size_t ws_size, hipStream_t stream) {
    static int grid = 0;
    if (grid == 0) {
        int dev = 0, cus = 0, per_cu = 0;
        (void)hipGetDevice(&dev); (void)hipDeviceGetAttribute(&cus, hipDeviceAttributeMultiprocessorCount, dev);
        if (hipFuncSetAttribute((const void*)mega_fwd, hipFuncAttributeMaxDynamicSharedMemorySize, LDS_BYTES) != hipSuccess) fprintf(stderr, "kernel_launch: hipFuncSetAttribute failed\n");
        if (hipOccupancyMaxActiveBlocksPerMultiprocessor(&per_cu, (const void*)mega_fwd, 512, LDS_BYTES) != hipSuccess || per_cu < 1) { fprintf(stderr, "kernel_launch: occupancy query gave %d\n", per_cu); per_cu = 1; }
        (void)hipGetLastError();
        if (cus <= 0) cus = 256;
        grid = cus * per_cu;
        if (n_in != 34 || ws_size < WS_END) fprintf(stderr, "kernel_launch: unexpected n_in %d / ws_size %zu (need %zu)\n", n_in, ws_size, (size_t)WS_END);
    }
    Params p{};
    for (int i = 0; i < 34; ++i) p.in[i] = (const float*)d_in[i];
    p.out = (float*)d_out; p.ws = (unsigned char*)d_ws;
    void* args[] = {&p};
    hipError_t e = hipLaunchCooperativeKernel((const void*)mega_fwd, dim3(grid), dim3(512), args, LDS_BYTES, stream);
    if (e != hipSuccess) fprintf(stderr, "cooperative launch failed: %s (grid %d)\n", hipGetErrorString(e), grid);
}
```

```cpp
#include <hip/hip_runtime.h>
#include <hip/hip_cooperative_groups.h>
#include <cstdio>
#include <cstdint>
namespace cg = cooperative_groups;

#define DI __device__ __forceinline__
#define LAS __attribute__((address_space(3)))
typedef short bf16x8 __attribute__((ext_vector_type(8)));
typedef short s16x4 __attribute__((ext_vector_type(4)));
typedef float f32x2 __attribute__((ext_vector_type(2)));
typedef float f32x4 __attribute__((ext_vector_type(4)));
typedef float f32x16 __attribute__((ext_vector_type(16)));
typedef unsigned u32x2 __attribute__((ext_vector_type(2)));
typedef unsigned u32x4 __attribute__((ext_vector_type(4)));
typedef __bf16 bf16x2_t __attribute__((ext_vector_type(2)));
typedef unsigned short bf16_t;

constexpr int DM = 1024, NB = 16, SEQ = 2048, CTXL = 256, FF = 2816;
constexpr int TX = NB * SEQ;
constexpr int TC = NB * CTXL;
constexpr int TT = TX + TC;
constexpr float EPS = 1e-6f;
constexpr float LOG2E = 1.4426950408889634f;
constexpr int P0W = 2048;
constexpr int QKW = 1792;
constexpr int P1W = 4640;
constexpr int C1_Q = 1024, C1_K = 1536, C1_V = 2048, C1_XBC = 2560, C1_DT = 4608;

constexpr size_t MiB = 1u << 20;
constexpr size_t WS_MOD = 0;
constexpr size_t WS_ROPE = 2 * MiB;
constexpr size_t WS_SSQ = 2 * MiB + 65536;
constexpr size_t WS_BAR = 2 * MiB + 512 * 1024;
constexpr size_t WS_W0 = 3 * MiB;
constexpr size_t W_FFN_IN = (size_t)2 * FF * DM * 2;
constexpr size_t W_FFN_OUT = (size_t)DM * FF * 2;
constexpr size_t W0_F1I = WS_W0, W0_F1O = W0_F1I + W_FFN_IN, W0_F2I = W0_F1O + W_FFN_OUT, W0_F2O = W0_F2I + W_FFN_IN;
constexpr size_t W0_ABI = W0_F2O + W_FFN_OUT;
constexpr size_t W0_UP = W0_ABI + (size_t)2048 * 1024 * 2;
constexpr size_t W0_ABO = W0_UP + (size_t)1536 * 1024;
constexpr size_t WS_W1 = 44 * MiB;
constexpr size_t W1_F1I = WS_W1, W1_F1O = W1_F1I + W_FFN_IN, W1_F2I = W1_F1O + W_FFN_OUT, W1_F2O = W1_F2I + W_FFN_IN;
constexpr size_t W1_CDI = W1_F2O + W_FFN_OUT;
constexpr size_t W1_CDO = W1_CDI + (size_t)4864 * 1024 * 2;
constexpr size_t WS_CTXRES = 90 * MiB;
constexpr size_t WS_H = 106 * MiB;
constexpr size_t WS_BIG = 178 * MiB;
constexpr size_t WS_ACT = WS_BIG;
constexpr size_t WS_P0 = WS_BIG;
constexpr size_t WS_QKV = WS_BIG + 144 * MiB;
constexpr size_t WS_ODS = WS_BIG + 270 * MiB;
constexpr size_t WS_P1 = WS_BIG;
constexpr size_t WS_END = WS_BIG + 327 * MiB;

constexpr int LDS_BYTES = 147456;

DI float bf2f(unsigned short b) { return __uint_as_float((unsigned)b << 16); }
DI float bflo(unsigned w) { return __uint_as_float(w << 16); }
DI float bfhi(unsigned w) { return __uint_as_float(w & 0xffff0000u); }
DI unsigned cvtpk(float lo, float hi) { f32x2 v = {lo, hi}; bf16x2_t b = __builtin_convertvector(v, bf16x2_t); return __builtin_bit_cast(unsigned, b); }
DI float ex2(float x) { return __builtin_amdgcn_exp2f(x); }
DI float fexp(float x) { return __builtin_amdgcn_exp2f(x * LOG2E); }
DI float frcp(float x) { return __builtin_amdgcn_rcpf(x); }
DI float siluf(float x) { return x * frcp(1.f + fexp(-x)); }
DI float wave_sum(float v) {
#pragma unroll
    for (int o = 1; o < 64; o <<= 1) v += __shfl_xor(v, o);
    return v;
}
DI int crow(int reg, int h) { return (reg & 3) + 8 * (reg >> 2) + 4 * h; }
#define MFMA32(a, b, c) __builtin_amdgcn_mfma_f32_32x32x16_bf16((a), (b), (c), 0, 0, 0)
typedef short v4i16_t __attribute__((ext_vector_type(4)));
DI s16x4 trread(const LAS unsigned char* p) { return __builtin_bit_cast(s16x4, __builtin_amdgcn_ds_read_tr16_b64_v4i16((LAS v4i16_t*)p)); }
DI bf16x8 cat8(s16x4 lo, s16x4 hi) { return __builtin_shufflevector(lo, hi, 0, 1, 2, 3, 4, 5, 6, 7); }
DI bf16x8 pack8(float a0, float a1, float a2, float a3, float a4, float a5, float a6, float a7) {
    u32x4 p; p.x = cvtpk(a0, a1); p.y = cvtpk(a2, a3); p.z = cvtpk(a4, a5); p.w = cvtpk(a6, a7); return __builtin_bit_cast(bf16x8, p);
}
DI f32x16 zero16() { f32x16 z;
#pragma unroll
    for (int i = 0; i < 16; ++i) z[i] = 0.f;
    return z; }


namespace pg8 {
#define PG8_LAS __attribute__((address_space(3)))

typedef unsigned short bf16_t;
typedef short bf16x8 __attribute__((ext_vector_type(8)));
typedef float f32x4 __attribute__((ext_vector_type(4)));
typedef unsigned u32x4 __attribute__((ext_vector_type(4)));
constexpr int BM = 256, BK = 64, HALF = 128, HTB = HALF * BK * 2  , STAGE_BYTES = 8 * HTB, NXCD = 8, WGM = 8;

__host__ __device__ __forceinline__ int lds_byte(int r, int c) { const int st = (r >> 4) * 2 + (c >> 5), rr = r & 15, cc = c & 31, ob = rr * 64 + cc * 2; return st * 1024 + (ob ^ (((ob >> 9) & 1) << 5)); }
__host__ __device__ __forceinline__ void stage_rc(int b, int& R, int& C) { const int st = b / 1024, sb = b % 1024, swz = sb ^ (((sb >> 9) & 1) << 5); R = (st >> 1) * 16 + swz / 64; C = (st & 1) * 32 + (swz % 64) / 2; }
__host__ __device__ __forceinline__ int perm32(int rho) { const int n = rho >> 4, i = rho & 15; return 8 * (i >> 2) + 4 * n + (i & 3); }

struct Unit { int pm, pn; };
struct Gemm { const bf16_t* A; const bf16_t* Bt; int M, N, K, lda; };

struct StaticOrder {
    int nM, nN, nwg, G, c;
    __host__ __device__ void init(int M, int N, int G_, int c_) { nM = M / BM; nN = N / BM; nwg = nM * nN; G = G_; c = c_; }
    __host__ __device__ bool next(int i, Unit& u) const {
        const long L = (long)i * G + c; if (L >= nwg) return false;
        int wgid = (int)L; { const int q = nwg / NXCD, r = nwg % NXCD, xcd = wgid % NXCD, off = wgid / NXCD; wgid = (xcd < r ? xcd * (q + 1) : r * (q + 1) + (xcd - r) * q) + off; }
        const int nig = WGM * nN, gid = wgid / nig, fm = gid * WGM, gsz = (nM - fm) < WGM ? (nM - fm) : WGM;
        u.pm = fm + ((wgid % nig) % gsz); u.pn = (wgid % nig) / gsz; return true;
    }
    __device__ __forceinline__ void a_ready(const Unit&) const {}
    __device__ __forceinline__ void done(const Unit&) const {}
};


template <class Epi, class Sched, bool ALIGN_EPI = false, bool SP2 = false>
__device__ __forceinline__ void gemm_phase(PG8_LAS unsigned char* lds, const Gemm g, const Sched& S, const Epi& E) {
    int tid_ = threadIdx.x; asm volatile("" : "+v"(tid_));
    const int tid = tid_, wid = __builtin_amdgcn_readfirstlane(tid >> 6), lane = tid & 63, wr = wid >> 2, wc = wid & 3, fr = lane & 15, fq = lane >> 4;
    const int K = g.K, nt = K / BK;
    unsigned voffA[2], voffB[2];
#pragma unroll
    for (int i = 0; i < 2; ++i) { int R, C; stage_rc(tid * 16 + i * 8192, R, C); const int Rb = Epi::PERM ? ((R & ~31) + perm32(R & 31)) : R;
        voffA[i] = (unsigned)(R * g.lda + C) * 2u; voffB[i] = (unsigned)(Rb * K + C) * 2u; }
    const size_t kstep = (size_t)(BK * 2);
    const size_t hstepB = (size_t)HALF * K * 2, hstepA = (size_t)HALF * g.lda * 2;
    const size_t tstepA = 2 * hstepA, tstepB = 2 * hstepB;
    const unsigned ldsw = (unsigned)wid * 1024u;
    const int aoff = lds_byte(wr * 64 + fr, fq * 8), boff = lds_byte(wc * 32 + fr, fq * 8);
#define PG8_SA(b, h) (((b) * 2 + (h)) * HTB)
#define PG8_SB(b, h) ((4 + (b) * 2 + (h)) * HTB)
#define PG8_STAGE(bufoff, gbase, voff) do { _Pragma("unroll") for (int _i = 0; _i < 2; ++_i) \
        __builtin_amdgcn_global_load_lds((const unsigned*)((const char*)(gbase) + (voff)[_i]), (PG8_LAS unsigned*)(lds + (bufoff) + ldsw + _i * 8192), 16, 0, 0); } while (0)
#define PG8_LDA(dst, b, h) do { _Pragma("unroll") for (int m = 0; m < 4; ++m) _Pragma("unroll") for (int k = 0; k < 2; ++k) dst[m][k] = *(const PG8_LAS bf16x8*)(lds + PG8_SA(b, h) + aoff + m * 2048 + k * 1024); } while (0)
#define PG8_LDB(dst, b, h) do { _Pragma("unroll") for (int n = 0; n < 2; ++n) _Pragma("unroll") for (int k = 0; k < 2; ++k) dst[n][k] = *(const PG8_LAS bf16x8*)(lds + PG8_SB(b, h) + boff + n * 2048 + k * 1024); } while (0)
#define PG8_MMA(ai, bj, At, Bt) do { __builtin_amdgcn_s_setprio(1); _Pragma("unroll") for (int m = 0; m < 4; ++m) _Pragma("unroll") for (int n = 0; n < 2; ++n) _Pragma("unroll") for (int k = 0; k < 2; ++k) \
        acc[ai][bj][m][n] = __builtin_amdgcn_mfma_f32_16x16x32_bf16(Bt[n][k], At[m][k], acc[ai][bj][m][n], 0, 0, 0); __builtin_amdgcn_s_setprio(0); } while (0)
#define PG8_WAIT_V(n) asm volatile("s_waitcnt vmcnt(" #n ")" ::: "memory")
#define PG8_WAIT_L(n) asm volatile("s_waitcnt lgkmcnt(" #n ")" ::: "memory")
#define PG8_BAR __builtin_amdgcn_s_barrier()
#define PG8_SCHED __builtin_amdgcn_sched_barrier(0)
    Unit cur, nxt; int ui = 0;
    if (!S.next(0, cur)) return;
    f32x4 acc[2][2][4][2];
#pragma unroll
    for (int a = 0; a < 2; ++a)
#pragma unroll
        for (int b = 0; b < 2; ++b)
#pragma unroll
            for (int m = 0; m < 4; ++m)
#pragma unroll
                for (int n = 0; n < 2; ++n) acc[a][b][m][n] = (f32x4){0.f, 0.f, 0.f, 0.f};
    bf16x8 At[4][2], B0[2][2], B1[2][2];
    const char* cA = (const char*)g.A + (size_t)cur.pm * tstepA; const char* cB = (const char*)g.Bt + (size_t)cur.pn * tstepB;
    S.a_ready(cur);
    if constexpr (SP2) {
        PG8_STAGE(PG8_SB(0, 0), cB, voffB); PG8_STAGE(PG8_SB(0, 1), cB + hstepB, voffB); PG8_STAGE(PG8_SA(0, 0), cA, voffA); PG8_STAGE(PG8_SA(0, 1), cA + hstepA, voffA);
        if (wr == 1) PG8_BAR;
        PG8_WAIT_V(2); PG8_BAR;
        PG8_STAGE(PG8_SB(1, 0), cB + kstep, voffB); PG8_STAGE(PG8_SA(1, 0), cA + kstep, voffA); PG8_STAGE(PG8_SB(1, 1), cB + hstepB + kstep, voffB);
        PG8_WAIT_V(6); PG8_BAR;
    } else {
        PG8_STAGE(PG8_SB(0, 0), cB, voffB); PG8_STAGE(PG8_SA(0, 0), cA, voffA); PG8_STAGE(PG8_SB(0, 1), cB + hstepB, voffB); PG8_STAGE(PG8_SA(0, 1), cA + hstepA, voffA);
        if (wr == 1) PG8_BAR;
        PG8_WAIT_V(4); PG8_BAR;
        PG8_STAGE(PG8_SB(1, 0), cB + kstep, voffB); PG8_STAGE(PG8_SA(1, 0), cA + kstep, voffA); PG8_STAGE(PG8_SB(1, 1), cB + hstepB + kstep, voffB);
        PG8_WAIT_V(6); PG8_BAR;
    }
    for (;;) {
        const bool has_next = S.next(ui + 1, nxt);
        const char* nA = has_next ? (const char*)g.A + (size_t)nxt.pm * tstepA : cA; const char* nB = has_next ? (const char*)g.Bt + (size_t)nxt.pn * tstepB : cB;
        for (int t = 0; t < nt; t += 2) {
            const bool last = (t == nt - 2);
            const char* a1 = cA + (size_t)(t + 1) * kstep;
            const char* a2 = last ? nA : cA + (size_t)(t + 2) * kstep; const char* b2 = last ? nB : cB + (size_t)(t + 2) * kstep;
            const char* a3 = a2 + kstep; const char* b3 = b2 + kstep;
            if (last && has_next) S.a_ready(nxt);
            if constexpr (SP2) {
            PG8_LDB(B0, 0, 0); PG8_LDB(B1, 0, 1); PG8_SCHED; PG8_LDA(At, 0, 0); PG8_STAGE(PG8_SA(1, 1), a1 + hstepA, voffA);
            PG8_WAIT_V(8); PG8_WAIT_L(0); PG8_BAR; PG8_MMA(0, 0, At, B0); PG8_MMA(0, 1, At, B1); PG8_BAR; PG8_SCHED;
            PG8_LDA(At, 0, 1); PG8_STAGE(PG8_SB(0, 0), b2, voffB); PG8_STAGE(PG8_SB(0, 1), b2 + hstepB, voffB); PG8_STAGE(PG8_SA(0, 0), a2, voffA);
            PG8_WAIT_V(8); PG8_WAIT_L(0); PG8_BAR; PG8_MMA(1, 0, At, B0); PG8_MMA(1, 1, At, B1); PG8_BAR; PG8_SCHED;
            PG8_LDB(B0, 1, 0); PG8_LDB(B1, 1, 1); PG8_SCHED; PG8_LDA(At, 1, 0); PG8_STAGE(PG8_SA(0, 1), a2 + hstepA, voffA);
            PG8_WAIT_V(8); PG8_WAIT_L(0); PG8_BAR; PG8_MMA(0, 0, At, B0); PG8_MMA(0, 1, At, B1); PG8_BAR; PG8_SCHED;
            PG8_LDA(At, 1, 1); PG8_STAGE(PG8_SB(1, 0), b3, voffB); PG8_STAGE(PG8_SB(1, 1), b3 + hstepB, voffB); PG8_STAGE(PG8_SA(1, 0), a3, voffA);
            PG8_WAIT_V(8); PG8_WAIT_L(0); PG8_BAR; PG8_MMA(1, 0, At, B0); PG8_MMA(1, 1, At, B1); PG8_BAR; PG8_SCHED;
            } else {
            PG8_LDB(B0, 0, 0); PG8_SCHED; PG8_LDA(At, 0, 0); PG8_STAGE(PG8_SA(1, 1), a1 + hstepA, voffA);
            PG8_WAIT_L(8); PG8_BAR; PG8_WAIT_L(0); PG8_MMA(0, 0, At, B0); PG8_BAR; PG8_SCHED;
            PG8_LDB(B1, 0, 1); PG8_STAGE(PG8_SB(0, 0), b2, voffB);
            PG8_BAR; PG8_WAIT_L(0); PG8_MMA(0, 1, At, B1); PG8_BAR;
            PG8_LDA(At, 0, 1); PG8_STAGE(PG8_SA(0, 0), a2, voffA);
            PG8_BAR; PG8_WAIT_L(0); PG8_MMA(1, 0, At, B0); PG8_BAR; PG8_SCHED;
            PG8_STAGE(PG8_SB(0, 1), b2 + hstepB, voffB);
            PG8_WAIT_V(6); PG8_BAR; PG8_MMA(1, 1, At, B1); PG8_BAR;
            PG8_LDB(B0, 1, 0); PG8_SCHED; PG8_LDA(At, 1, 0); PG8_STAGE(PG8_SA(0, 1), a2 + hstepA, voffA);
            PG8_WAIT_L(8); PG8_BAR; PG8_WAIT_L(0); PG8_MMA(0, 0, At, B0); PG8_BAR; PG8_SCHED;
            PG8_LDB(B1, 1, 1); PG8_STAGE(PG8_SB(1, 0), b3, voffB);
            PG8_BAR; PG8_WAIT_L(0); PG8_MMA(0, 1, At, B1); PG8_BAR;
            PG8_LDA(At, 1, 1); PG8_STAGE(PG8_SA(1, 0), a3, voffA);
            PG8_BAR; PG8_WAIT_L(0); PG8_MMA(1, 0, At, B0); PG8_BAR; PG8_SCHED;
            PG8_STAGE(PG8_SB(1, 1), b3 + hstepB, voffB);
            PG8_WAIT_V(6); PG8_BAR; PG8_MMA(1, 1, At, B1); PG8_BAR;
            }
        }
        if constexpr (ALIGN_EPI) { if (wr == 0) PG8_BAR; }
        if constexpr (!Epi::AFTER_DRAIN) { E(acc, cur, wr, wc, fr, fq); S.done(cur); }
        if (!has_next) break;
#pragma unroll
        for (int a = 0; a < 2; ++a)
#pragma unroll
            for (int b = 0; b < 2; ++b)
#pragma unroll
                for (int m = 0; m < 4; ++m)
#pragma unroll
                    for (int n = 0; n < 2; ++n) acc[a][b][m][n] = (f32x4){0.f, 0.f, 0.f, 0.f};
        cur = nxt; cA = nA; cB = nB; ++ui;
        if constexpr (ALIGN_EPI) { if (wr == 1) PG8_BAR; }
    }
    PG8_WAIT_V(0);
    if constexpr (!ALIGN_EPI) { if (wr == 0) PG8_BAR; }
    PG8_BAR;
    if constexpr (Epi::AFTER_DRAIN) { E.fused(acc, cur, wr, wc, fr, fq, lds, wid, lane); S.done(cur); }
#undef PG8_SA
#undef PG8_SB
#undef PG8_STAGE
#undef PG8_LDA
#undef PG8_LDB
#undef PG8_MMA
#undef PG8_WAIT_V
#undef PG8_WAIT_L
#undef PG8_BAR
#undef PG8_SCHED
}
}


namespace pg8 {
struct EpiSwiglu {
    static constexpr bool PERM = true, AFTER_DRAIN = false;
    bf16_t* O;
    __device__ __forceinline__ void operator()(const f32x4 (&acc)[2][2][4][2], const Unit& u, int wr, int wc, int fr, int fq) const {
        const int row0 = u.pm * BM + wr * 64 + fr, col0 = u.pn * 128 + wc * 32 + 8 * fq;
#pragma unroll
        for (int ai = 0; ai < 2; ++ai)
#pragma unroll
            for (int m = 0; m < 4; ++m) {
                const f32x4 g0 = acc[ai][0][m][0], g1 = acc[ai][0][m][1], u0 = acc[ai][1][m][0], u1 = acc[ai][1][m][1];
                u32x4 w;
                w.x = cvtpk(siluf(g0[0]) * u0[0], siluf(g0[1]) * u0[1]); w.y = cvtpk(siluf(g0[2]) * u0[2], siluf(g0[3]) * u0[3]);
                w.z = cvtpk(siluf(g1[0]) * u1[0], siluf(g1[1]) * u1[1]); w.w = cvtpk(siluf(g1[2]) * u1[2], siluf(g1[3]) * u1[3]);
                *(u32x4*)(O + (size_t)(row0 + ai * HALF + m * 16) * FF + col0) = w;
            }
    }
};
struct EpiRes {
    static constexpr bool PERM = false, AFTER_DRAIN = false;
    const float* rin_x; const float* rin_c; float* rout_x; float* rout_c; const float* gate  ; float gs;
    __device__ __forceinline__ void operator()(const f32x4 (&acc)[2][2][4][2], const Unit& u, int wr, int wc, int fr, int fq) const {
#pragma unroll
        for (int ai = 0; ai < 2; ++ai)
#pragma unroll
            for (int m = 0; m < 4; ++m) {
                const int row = u.pm * BM + ai * HALF + wr * 64 + m * 16 + fr;
                const bool isx = row < TX;
                const float* ri = isx ? rin_x + (size_t)row * DM : rin_c + (size_t)(row - TX) * DM;
                float* ro = isx ? rout_x + (size_t)row * DM : rout_c + (size_t)(row - TX) * DM;
                const float* gp = gate + (size_t)(isx ? (row >> 11) : 16) * 9216;
#pragma unroll
                for (int bj = 0; bj < 2; ++bj)
#pragma unroll
                    for (int n = 0; n < 2; ++n) {
                        const int c = u.pn * BM + bj * HALF + wc * 32 + n * 16 + 4 * fq;
                        const f32x4 r = *(const f32x4*)(ri + c), g = *(const f32x4*)(gp + c);
                        *(f32x4*)(ro + c) = r + (g * gs) * acc[ai][bj][m][n];
                    }
                asm volatile("" ::: "memory");
            }
    }
};
struct EpiAbIn {
    static constexpr bool PERM = false, AFTER_DRAIN = false;
    bf16_t* P; const float* cosT; const float* sinT; float* ssq;
    __device__ __forceinline__ void operator()(const f32x4 (&acc)[2][2][4][2], const Unit& u, int wr, int wc, int fr, int fq) const {
#pragma unroll
        for (int ai = 0; ai < 2; ++ai)
#pragma unroll
            for (int m = 0; m < 4; ++m) {
                const int row = u.pm * BM + ai * HALF + wr * 64 + m * 16 + fr;
                const bool isx = row < TX; const int t = row & 2047, prow = t >> 6, pcol = t & 63;
                float sq = 0.f;
#pragma unroll
                for (int bj = 0; bj < 2; ++bj) {
                    const int cb = u.pn * BM + bj * HALF + wc * 32;
                    if (cb >= 1984) continue;
                    f32x4 v0 = acc[ai][bj][m][0], v1 = acc[ai][bj][m][1];
                    if (cb >= 1536 && cb < 1920) sq += (v0[0] * v0[0] + v0[1] * v0[1]) + (v0[2] * v0[2] + v0[3] * v0[3]) + (v1[0] * v1[0] + v1[1] * v1[1]) + (v1[2] * v1[2] + v1[3] * v1[3]);
                    if (isx && (cb < 1024 || cb >= 1920)) {
                        const int pos = ((cb >> 5) & 1) ? pcol : prow;
                        const f32x4 cs = *(const f32x4*)(cosT + pos * 16 + 4 * fq), sn = *(const f32x4*)(sinT + pos * 16 + 4 * fq);
                        const f32x4 o0 = v0 * cs - v1 * sn, o1 = v1 * cs + v0 * sn; v0 = o0; v1 = o1;
                    }
                    u32x2 w0, w1; w0.x = cvtpk(v0[0], v0[1]); w0.y = cvtpk(v0[2], v0[3]); w1.x = cvtpk(v1[0], v1[1]); w1.y = cvtpk(v1[2], v1[3]);
                    bf16_t* dst = P + (size_t)row * P0W + cb + 4 * fq;
                    *(u32x2*)dst = w0; *(u32x2*)(dst + 16) = w1;
                }
                if (u.pn >= 6) {
                    sq += __shfl_xor(sq, 16); sq += __shfl_xor(sq, 32);
                    if (fq == 0) atomicAdd(ssq + (size_t)row * 2 + (u.pn - 6), sq);
                }
                asm volatile("" ::: "memory");
            }
    }
};
struct EpiMlaUp {
    static constexpr bool PERM = false, AFTER_DRAIN = false;
    bf16_t* O; const float* ssq;
    __device__ __forceinline__ void operator()(const f32x4 (&acc)[2][2][4][2], const Unit& u, int wr, int wc, int fr, int fq) const {
        const bool kv = u.pn >= 3;
#pragma unroll
        for (int ai = 0; ai < 2; ++ai)
#pragma unroll
            for (int m = 0; m < 4; ++m) {
                const int row = u.pm * BM + ai * HALF + wr * 64 + m * 16 + fr;
                float s = 1.f;
                if (kv) s = rsqrtf(ssq[(size_t)row * 2 + 1] * (1.f / 128.f) + EPS);
#pragma unroll
                for (int bj = 0; bj < 2; ++bj)
#pragma unroll
                    for (int n = 0; n < 2; ++n) {
                        const int c = u.pn * BM + bj * HALF + wc * 32 + n * 16 + 4 * fq;
                        const f32x4 v = acc[ai][bj][m][n] * s; u32x2 w; w.x = cvtpk(v[0], v[1]); w.y = cvtpk(v[2], v[3]);
                        *(u32x2*)(O + (size_t)row * QKW + c) = w;
                    }
                asm volatile("" ::: "memory");
            }
    }
};
struct EpiStore {
    static constexpr bool PERM = false, AFTER_DRAIN = false;
    bf16_t* O; int ldc, ncols;
    __device__ __forceinline__ void operator()(const f32x4 (&acc)[2][2][4][2], const Unit& u, int wr, int wc, int fr, int fq) const {
#pragma unroll
        for (int ai = 0; ai < 2; ++ai)
#pragma unroll
            for (int m = 0; m < 4; ++m) {
                const int row = u.pm * BM + ai * HALF + wr * 64 + m * 16 + fr;
#pragma unroll
                for (int bj = 0; bj < 2; ++bj)
#pragma unroll
                    for (int n = 0; n < 2; ++n) {
                        const int c = u.pn * BM + bj * HALF + wc * 32 + n * 16 + 4 * fq;
                        if (c < ncols) { const f32x4 v = acc[ai][bj][m][n]; u32x2 w; w.x = cvtpk(v[0], v[1]); w.y = cvtpk(v[2], v[3]); *(u32x2*)(O + (size_t)row * ldc + c) = w; }
                    }
                asm volatile("" ::: "memory");
            }
    }
};
}

struct Params { const float* in[34]; float* out; unsigned char* ws; };
struct Fr {
    LAS unsigned char* lds; int tid, lane, wave, bid, G;
    const float* const* in; float* out; unsigned char* ws;
};
enum { I_X = 0, I_C, I_CTX, I_CCTX, I_WMOD, I_BMOD, I_GF1, I_WF1I, I_WF1O, I_GMIX, I_GF2, I_WF2I, I_WF2O, I_ABWIN, I_LQ1, I_LK1, I_LQ2, I_LK2, I_GSUB, I_GQ, I_WUQ, I_GKV,
       I_WUKV, I_ABWOUT, I_CDWIN, I_CONVW, I_CONVB, I_DTB, I_ALOG, I_DSKIP, I_GNORM, I_RPB, I_CDWOUT, I_GFINAL };

template <class Epi> DI void run_gemm(const Fr& F, const bf16_t* A, int lda, const bf16_t* Bt, int M, int N, int K, const Epi& E) {
    asm volatile("" : "+s"(K));
    pg8::Gemm g{A, Bt, M, N, K, lda}; pg8::StaticOrder S; S.init(M, N, F.G, F.bid);
    pg8::gemm_phase<Epi, pg8::StaticOrder, true, true>(F.lds, g, S, E);
}

DI void mod_phase(const Fr& F) {
    LAS float* sc = (LAS float*)F.lds;
    LAS float* red = sc + 17 * 1024;
    const float* c = F.in[I_C]; const float* cc = F.in[I_CCTX];
    for (int i = F.tid; i < 17 * 1024; i += 512) { const int m = i >> 10, k = i & 1023; const float v = m < 16 ? c[m * 1024 + k] : cc[k]; sc[i] = v / (1.f + __expf(-v)); }
    __syncthreads();
    const float* wmod = F.in[I_WMOD]; const float* bmod = F.in[I_BMOD]; float* mod = (float*)(F.ws + WS_MOD);
    for (int item = F.bid; item < 288; item += F.G) {
        const int l = item / 144, n0 = (item % 144) * 64, kp = F.wave;
        const float* wp = wmod + (size_t)l * 1024 * 9216 + n0 + F.lane;
        float acc[17];
#pragma unroll
        for (int m = 0; m < 17; ++m) acc[m] = 0.f;
        for (int k = kp * 128; k < kp * 128 + 128; k += 4) {
            const float w0 = wp[(size_t)k * 9216], w1 = wp[(size_t)(k + 1) * 9216], w2 = wp[(size_t)(k + 2) * 9216], w3 = wp[(size_t)(k + 3) * 9216];
#pragma unroll
            for (int m = 0; m < 17; ++m) { const f32x4 s = *(const LAS f32x4*)(sc + m * 1024 + k); acc[m] += (w0 * s[0] + w1 * s[1]) + (w2 * s[2] + w3 * s[3]); }
        }
#pragma unroll
        for (int m = 0; m < 17; ++m) red[(kp * 17 + m) * 64 + F.lane] = acc[m];
        __syncthreads();
        for (int i = F.tid; i < 17 * 64; i += 512) {
            const int m = i >> 6, cl = i & 63; float s = 0.f;
#pragma unroll
            for (int q = 0; q < 8; ++q) s += red[(q * 17 + m) * 64 + cl];
            mod[(size_t)(l * 17 + m) * 9216 + n0 + cl] = s + bmod[l * 9216 + n0 + cl];
        }
        __syncthreads();
    }
}
DI int maprow(int mode, int n0) {
    if (mode == 1) { const int up = n0 >= FF, j = up ? n0 - FF : n0; return (j >> 7) * 256 + (up ? 128 : 0) + (j & 127); }
    if (mode == 2) {
        if (n0 < 1024) return n0; if (n0 < 3072) return n0 - 1024 + C1_XBC; if (n0 < 3104) return n0 - 3072 + C1_DT;
        if (n0 < 3616) return n0 - 3104 + C1_Q; if (n0 < 4128) return n0 - 3616 + C1_K; return n0 - 4128 + C1_V;
    }
    return n0;
}
DI void conv_job(const Fr& F, int& base, const float* W, int K, int N, bf16_t* dst, int ldk, int koff, int mode, int rowoff, const float* kscale) {
    LAS float* scr = (LAS float*)(F.lds + F.wave * 8448);
    const int NGW = F.G * 8, gw = F.bid * 8 + F.wave, nblk = N / 32, nitems = (K / 64) * nblk, lane = F.lane;
    for (int it = ((gw - base) % NGW + NGW) % NGW; it < nitems; it += NGW) {
        const int kb = it / nblk, nb = it % nblk, k0 = 64 * kb, n0 = 32 * nb;
#pragma unroll 8
        for (int i = 0; i < 32; ++i) { const int kk = 2 * i + (lane >> 5); float v = W[(size_t)(k0 + kk) * N + n0 + (lane & 31)]; if (kscale) v *= kscale[k0 + kk]; scr[kk * 33 + (lane & 31)] = v; }
        asm volatile("s_waitcnt lgkmcnt(0)" ::: "memory");
        const int c = lane & 7, dr0 = rowoff + maprow(mode, n0);
#pragma unroll
        for (int j = 0; j < 4; ++j) {
            const int n = (lane >> 3) + 8 * j; const LAS float* s = scr + (8 * c) * 33 + n;
            u32x4 o; o.x = cvtpk(s[0 * 33], s[1 * 33]); o.y = cvtpk(s[2 * 33], s[3 * 33]); o.z = cvtpk(s[4 * 33], s[5 * 33]); o.w = cvtpk(s[6 * 33], s[7 * 33]);
            *(u32x4*)(dst + (size_t)(dr0 + n) * ldk + koff + k0 + 8 * c) = o;
        }
        asm volatile("s_waitcnt lgkmcnt(0)" ::: "memory");
    }
    base = (base + nitems) % NGW;
}
DI void zero_rect(const Fr& F, unsigned char* base, size_t pitch, int nrows, int chunks_per_row) {
    const int n = nrows * chunks_per_row; const u32x4 z = {0u, 0u, 0u, 0u};
    for (int i = F.bid * 512 + F.tid; i < n; i += F.G * 512) { const int r = i / chunks_per_row, c = i % chunks_per_row; *(u32x4*)(base + (size_t)r * pitch + (size_t)c * 16) = z; }
}
DI void prep_phase(const Fr& F) {
    mod_phase(F);
    int base = 0; unsigned char* ws = F.ws;
    const size_t LIN = (size_t)DM * 2 * FF, LOUT = (size_t)FF * DM;
    conv_job(F, base, F.in[I_WF1I], DM, 2 * FF, (bf16_t*)(ws + W0_F1I), DM, 0, 1, 0, nullptr);
    conv_job(F, base, F.in[I_WF1O], FF, DM, (bf16_t*)(ws + W0_F1O), FF, 0, 0, 0, nullptr);
    conv_job(F, base, F.in[I_WF2I], DM, 2 * FF, (bf16_t*)(ws + W0_F2I), DM, 0, 1, 0, nullptr);
    conv_job(F, base, F.in[I_WF2O], FF, DM, (bf16_t*)(ws + W0_F2O), FF, 0, 0, 0, nullptr);
    conv_job(F, base, F.in[I_ABWIN], DM, 1984, (bf16_t*)(ws + W0_ABI), DM, 0, 0, 0, nullptr);
    conv_job(F, base, F.in[I_WUQ], 256, 768, (bf16_t*)(ws + W0_UP), 384, 0, 0, 0, F.in[I_GQ]);
    conv_job(F, base, F.in[I_WUKV], 128, 1024, (bf16_t*)(ws + W0_UP), 384, 256, 0, 768, F.in[I_GKV]);
    conv_job(F, base, F.in[I_ABWOUT], DM, DM, (bf16_t*)(ws + W0_ABO), DM, 0, 0, 0, nullptr);
    conv_job(F, base, F.in[I_WF1I] + LIN, DM, 2 * FF, (bf16_t*)(ws + W1_F1I), DM, 0, 1, 0, nullptr);
    conv_job(F, base, F.in[I_WF1O] + LOUT, FF, DM, (bf16_t*)(ws + W1_F1O), FF, 0, 0, 0, nullptr);
    conv_job(F, base, F.in[I_WF2I] + LIN, DM, 2 * FF, (bf16_t*)(ws + W1_F2I), DM, 0, 1, 0, nullptr);
    conv_job(F, base, F.in[I_WF2O] + LOUT, FF, DM, (bf16_t*)(ws + W1_F2O), FF, 0, 0, 0, nullptr);
    conv_job(F, base, F.in[I_CDWIN], DM, 4640, (bf16_t*)(ws + W1_CDI), DM, 0, 2, 0, nullptr);
    conv_job(F, base, F.in[I_CDWOUT], 1536, DM, (bf16_t*)(ws + W1_CDO), 1536, 0, 0, 0, nullptr);
    zero_rect(F, ws + W0_ABI + (size_t)1984 * 2048, 2048, 64, 128);
    zero_rect(F, ws + W1_CDI + (size_t)4640 * 2048, 2048, 224, 128);
    zero_rect(F, ws + W0_UP + 512, 768, 768, 16);
    zero_rect(F, ws + W0_UP + (size_t)768 * 768, 768, 1024, 32);
    zero_rect(F, ws + WS_SSQ, (size_t)TT * 8, 1, TT * 8 / 16);
    if (F.bid == 0) {
        float* cosT = (float*)(ws + WS_ROPE); float* sinT = cosT + 1024;
        for (int i = F.tid; i < 1024; i += 512) {
            const int pos = i >> 4, fi = i & 15;
            const float freq = exp2f(-(float)fi * (13.287712379549449f / 16.f));
            const float ang = (float)pos * freq;
            const double tp = 6.283185307179586476925; const double n = __builtin_rint((double)ang / tp); const float r = (float)((double)ang - n * tp);
            cosT[i] = __cosf(r); sinT[i] = __sinf(r);
        }
    }
}
DI void norm_phase(const Fr& F, int layer, const float* g, int jshift, int nrows, const float* xin_x, const float* xin_c, bf16_t* H) {
    const float* mod = (const float*)(F.ws + WS_MOD) + (size_t)layer * 17 * 9216;
    const int NGW = F.G * 8, lane = F.lane;
    f32x4 gv[4];
#pragma unroll
    for (int j = 0; j < 4; ++j) gv[j] = *(const f32x4*)(g + 4 * lane + 256 * j);
    for (int row = F.bid * 8 + F.wave; row < nrows; row += NGW) {
        const bool isx = row < TX;
        const float* xr = isx ? xin_x + (size_t)row * DM : xin_c + (size_t)(row - TX) * DM;
        const float* mp = mod + (size_t)(isx ? (row >> 11) : 16) * 9216 + jshift * 1024;
        f32x4 v[4]; float s = 0.f;
#pragma unroll
        for (int j = 0; j < 4; ++j) { v[j] = *(const f32x4*)(xr + 4 * lane + 256 * j); s += (v[j][0] * v[j][0] + v[j][1] * v[j][1]) + (v[j][2] * v[j][2] + v[j][3] * v[j][3]); }
        const float rstd = rsqrtf(wave_sum(s) * (1.f / DM) + EPS);
#pragma unroll
        for (int j = 0; j < 4; ++j) {
            const f32x4 sh = *(const f32x4*)(mp + 4 * lane + 256 * j), sc = *(const f32x4*)(mp + 1024 + 4 * lane + 256 * j);
            const f32x4 y = v[j] * rstd * gv[j] * (sc + 1.f) + sh;
            u32x2 w; w.x = cvtpk(y[0], y[1]); w.y = cvtpk(y[2], y[3]);
            *(u32x2*)(H + (size_t)row * DM + 4 * lane + 256 * j) = w;
        }
    }
}
DI void final_norm_phase(const Fr& F) {
    const float* g = F.in[I_GFINAL]; const int NGW = F.G * 8, lane = F.lane;
    for (int row = F.bid * 8 + F.wave; row < TX; row += NGW) {
        float* xr = F.out + (size_t)row * DM; f32x4 v[4]; float s = 0.f;
#pragma unroll
        for (int j = 0; j < 4; ++j) { v[j] = *(const f32x4*)(xr + 4 * lane + 256 * j); s += (v[j][0] * v[j][0] + v[j][1] * v[j][1]) + (v[j][2] * v[j][2] + v[j][3] * v[j][3]); }
        const float rstd = rsqrtf(wave_sum(s) * (1.f / DM) + EPS);
#pragma unroll
        for (int j = 0; j < 4; ++j) *(f32x4*)(xr + 4 * lane + 256 * j) = v[j] * rstd * *(const f32x4*)(g + 4 * lane + 256 * j);
    }
}


struct KVSrc { const bf16_t* k1; int k1p, k1c; const bf16_t* k2; int k2p, k2c; const bf16_t* v; int vp, vc; };
constexpr int FL_K1 = 25600, FL_V0 = 51200, FL_VB = 17408, FL_VP = 272, FL_QR = 86016;

template <int DQK> DI void kv_load(const KVSrc& S, int rb, int tid, u32x4 (&kr)[DQK / 64], u32x4 (&vr)[2]) {
    constexpr int CPR = DQK / 8;
#pragma unroll
    for (int i = 0; i < DQK / 64; ++i) {
        const int id = tid + 512 * i, row = id / CPR, ch = id % CPR;
        const bf16_t* src = (DQK == 64 || ch < 16) ? S.k1 + (size_t)(rb + row) * S.k1p + S.k1c + ch * 8 : S.k2 + (size_t)(rb + row) * S.k2p + S.k2c + (ch - 16) * 8;
        kr[i] = *(const u32x4*)src;
    }
#pragma unroll
    for (int i = 0; i < 2; ++i) { const int id = tid + 512 * i, row = id >> 4, ch = id & 15; vr[i] = *(const u32x4*)(S.v + (size_t)(rb + row) * S.vp + S.vc + ch * 8); }
}
template <int DQK> DI void kv_store(LAS unsigned char* Kb, LAS unsigned char* Vb, int tid, const u32x4 (&kr)[DQK / 64], const u32x4 (&vr)[2]) {
    constexpr int CPR = DQK / 8, KP = DQK * 2 + 16;
#pragma unroll
    for (int i = 0; i < DQK / 64; ++i) { const int id = tid + 512 * i, row = id / CPR, ch = id % CPR; *(LAS u32x4*)(Kb + row * KP + ch * 16) = kr[i]; }
#pragma unroll
    for (int i = 0; i < 2; ++i) { const int id = tid + 512 * i, row = id >> 4, ch = id & 15; *(LAS u32x4*)(Vb + row * FL_VP + ch * 16) = vr[i]; }
}
template <int DQK, int NSR> DI void flash_run(const Fr& F, const KVSrc& S, const bf16x8 (&qf)[NSR], const LAS unsigned char* qlds, int nkt, int nxt, int xbase, int cbase, float sc2, f32x16 (&o)[4]) {
    constexpr int NS = DQK / 16, KP = DQK * 2 + 16;
    LAS unsigned char* lds = F.lds; const int tid = F.tid, lane = F.lane, r = lane & 31, h = lane >> 5;
    const int i16 = lane & 15, q4 = i16 >> 2, p4 = i16 & 3, blk = (lane >> 4) & 1;
    u32x4 kr[DQK / 64], vr[2];
    __syncthreads();
    kv_load<DQK>(S, nxt > 0 ? xbase : cbase, tid, kr, vr);
    kv_store<DQK>(lds, lds + FL_V0, tid, kr, vr);
    __syncthreads();
    float m = -1e30f, l = 0.f;
#pragma unroll
    for (int t = 0; t < 4; ++t) o[t] = zero16();
    for (int kt = 0; kt < nkt; ++kt) {
        const bool more = kt + 1 < nkt;
        if (more) { const int k1 = kt + 1; kv_load<DQK>(S, k1 < nxt ? xbase + 64 * k1 : cbase + 64 * (k1 - nxt), tid, kr, vr); }
        const LAS unsigned char* Kb = lds + (kt & 1) * FL_K1; const LAS unsigned char* Vb = lds + FL_V0 + (kt & 1) * FL_VB;
        f32x16 st[2];
#pragma unroll
        for (int ks = 0; ks < 2; ++ks) {
            f32x16 a = zero16();
#pragma unroll
            for (int s = 0; s < NS; ++s) { const bf16x8 kf = *(const LAS bf16x8*)(Kb + (ks * 32 + r) * KP + s * 32 + h * 16);
                bf16x8 qq; if (s < NSR) qq = qf[s < NSR ? s : 0]; else qq = *(const LAS bf16x8*)(qlds + (s - NSR) * 32);
                a = MFMA32(kf, qq, a);
                if (NS > 4 && (s & 3) == 3) asm volatile("" ::: "memory"); }
            st[ks] = a;
        }
        float mx = st[0][0];
#pragma unroll
        for (int i = 0; i < 16; ++i) { mx = fmaxf(mx, st[0][i]); mx = fmaxf(mx, st[1][i]); }
        mx *= sc2; mx = fmaxf(mx, __shfl_xor(mx, 32));
        const float mn = fmaxf(m, mx), alpha = ex2(m - mn); m = mn;
        float rs = 0.f;
#pragma unroll
        for (int ks = 0; ks < 2; ++ks)
#pragma unroll
            for (int i = 0; i < 16; ++i) { const float p = ex2(st[ks][i] * sc2 - mn); rs += p; st[ks][i] = p; }
        l = l * alpha + rs;
#pragma unroll
        for (int t = 0; t < 4; ++t) o[t] = o[t] * alpha;
#pragma unroll
        for (int ks = 0; ks < 2; ++ks)
#pragma unroll
            for (int s2 = 0; s2 < 2; ++s2) {
                const bf16x8 pf = pack8(st[ks][8 * s2], st[ks][8 * s2 + 1], st[ks][8 * s2 + 2], st[ks][8 * s2 + 3], st[ks][8 * s2 + 4], st[ks][8 * s2 + 5], st[ks][8 * s2 + 6], st[ks][8 * s2 + 7]);
                const LAS unsigned char* vb = Vb + (ks * 32 + 16 * s2 + 4 * h + q4) * FL_VP + (16 * blk + 4 * p4) * 2;
#pragma unroll
                for (int t = 0; t < 4; ++t) { const s16x4 lo = trread(vb + t * 64), hi = trread(vb + t * 64 + 8 * FL_VP); o[t] = MFMA32(cat8(lo, hi), pf, o[t]); }
                if (DQK > 64) asm volatile("" ::: "memory");
            }
        if (more) kv_store<DQK>(lds + ((kt + 1) & 1) * FL_K1, lds + FL_V0 + ((kt + 1) & 1) * FL_VB, tid, kr, vr);
        __syncthreads();
    }
    l += __shfl_xor(l, 32);
    const float inv = 1.f / l;
#pragma unroll
    for (int t = 0; t < 4; ++t) o[t] = o[t] * inv;
}

DI void attn0_phase(const Fr& F) {
    const bf16_t* P = (const bf16_t*)(F.ws + WS_P0); const bf16_t* QK = (const bf16_t*)(F.ws + WS_QKV);
    bf16_t* CAT = (bf16_t*)(F.ws + WS_H); bf16_t* ODS = (bf16_t*)(F.ws + WS_ODS);
    const int lane = F.lane, r = lane & 31, h = lane >> 5;
    float lam;
    {
        const float d1 = wave_sum(F.in[I_LQ1][lane] * F.in[I_LK1][lane]), d2 = wave_sum(F.in[I_LQ2][lane] * F.in[I_LK2][lane]);
        lam = __expf(d1) - __expf(d2) + 0.2f;
    }
    const float* gsub = F.in[I_GSUB];
    const float* cosT = (const float*)(F.ws + WS_ROPE); const float* sinT = cosT + 1024; const float* ssq = (const float*)(F.ws + WS_SSQ);
    for (int it = F.bid; it < 1152; it += F.G) {
        int type, b, qb, hd;
        if (it < 512) { type = 0; b = it >> 5; qb = (it >> 2) & 7; hd = it & 3; }
        else if (it < 1024) { type = 1; const int j = it - 512; b = j >> 5; qb = (j >> 2) & 7; hd = j & 3; }
        else if (it < 1088) { type = 2; const int j = it - 1024; b = j >> 2; qb = 0; hd = j & 3; }
        else { type = 3; const int j = it - 1088; b = j >> 2; qb = 0; hd = j & 3; }
        const bool xq = type < 2;
        const int row = (xq ? b * SEQ + qb * 256 : TX + b * CTXL) + F.wave * 32 + r;
        const int nkt = xq ? 36 : 4, nxt = xq ? 32 : 0, xbase = b * SEQ, cbase = TX + b * CTXL;
        f32x16 o[4];
        if ((type & 1) == 0) {
            KVSrc S{QK, QKW, 768 + hd * 256, P, P0W, 1920, QK, QKW, 768 + hd * 256 + 128};
            bf16x8 qf[8];
            const bf16_t* qptr = QK + (size_t)row * QKW + hd * 192;
#pragma unroll
            for (int s = 0; s < 8; ++s) qf[s] = *(const bf16x8*)(qptr + 16 * s + 8 * h);
            LAS unsigned char* qlds = F.lds + FL_QR + F.wave * 4608 + r * 144 + h * 16;
            {
                const int t = row & 2047;
#pragma unroll
                for (int grp = 0; grp < 2; ++grp) {
                    const int pos = grp ? (t & 63) : (t >> 6);
                    const bf16x8 x1 = *(const bf16x8*)(qptr + 128 + 32 * grp + 8 * h), x2 = *(const bf16x8*)(qptr + 144 + 32 * grp + 8 * h);
                    bf16x8 y1 = x1, y2 = x2;
                    if (xq) {
                        const f32x4 c0 = *(const f32x4*)(cosT + pos * 16 + 8 * h), c1 = *(const f32x4*)(cosT + pos * 16 + 8 * h + 4), s0 = *(const f32x4*)(sinT + pos * 16 + 8 * h), s1 = *(const f32x4*)(sinT + pos * 16 + 8 * h + 4);
                        float a[8], bq[8];
#pragma unroll
                        for (int j = 0; j < 8; ++j) { const float u1 = bf2f((unsigned short)x1[j]), u2 = bf2f((unsigned short)x2[j]), cv = j < 4 ? c0[j & 3] : c1[j & 3], sv = j < 4 ? s0[j & 3] : s1[j & 3];
                            a[j] = u1 * cv - u2 * sv; bq[j] = u2 * cv + u1 * sv; }
                        y1 = pack8(a[0], a[1], a[2], a[3], a[4], a[5], a[6], a[7]); y2 = pack8(bq[0], bq[1], bq[2], bq[3], bq[4], bq[5], bq[6], bq[7]);
                    }
                    *(LAS bf16x8*)(qlds + (2 * grp) * 32) = y1; *(LAS bf16x8*)(qlds + (2 * grp + 1) * 32) = y2;
                }
            }
            const float rq = rsqrtf(ssq[(size_t)row * 2] * (1.f / 256.f) + EPS);
            flash_run<192, 8>(F, S, qf, qlds, nkt, nxt, xbase, cbase, 0.07216878364870322f * LOG2E * rq, o);
#pragma unroll
            for (int t = 0; t < 4; ++t)
#pragma unroll
                for (int g = 0; g < 4; ++g) { u32x2 w; w.x = cvtpk(o[t][4 * g], o[t][4 * g + 1]); w.y = cvtpk(o[t][4 * g + 2], o[t][4 * g + 3]);
                    *(u32x2*)(CAT + (size_t)row * DM + 512 + hd * 128 + t * 32 + 8 * g + 4 * h) = w; }
        } else {
            for (int c = 0; c < 2; ++c) {
                KVSrc S{P, P0W, 512 + hd * 128 + c * 64, nullptr, 0, 0, P, P0W, 1024 + hd * 128};
                bf16x8 qf[4];
                { const bf16_t* qptr = P + (size_t)row * P0W + hd * 128 + c * 64;
#pragma unroll
                  for (int s = 0; s < 4; ++s) qf[s] = *(const bf16x8*)(qptr + 16 * s + 8 * h); }
                flash_run<64, 4>(F, S, qf, nullptr, nkt, nxt, xbase, cbase, 0.125f * LOG2E, o);
                bf16_t* sp = ODS + (size_t)row * 512 + hd * 128 + 4 * h;
                if (c == 0) {
#pragma unroll
                    for (int t = 0; t < 4; ++t)
#pragma unroll
                        for (int g = 0; g < 4; ++g) { u32x2 w; w.x = cvtpk(o[t][4 * g], o[t][4 * g + 1]); w.y = cvtpk(o[t][4 * g + 2], o[t][4 * g + 3]); *(u32x2*)(sp + t * 32 + 8 * g) = w; }
                } else {
                    float ss = 0.f;
#pragma unroll
                    for (int t = 0; t < 4; ++t)
#pragma unroll
                        for (int g = 0; g < 4; ++g) { const u32x2 w = *(const u32x2*)(sp + t * 32 + 8 * g);
                            const float a0 = bflo(w.x) - lam * o[t][4 * g], a1 = bfhi(w.x) - lam * o[t][4 * g + 1], a2 = bflo(w.y) - lam * o[t][4 * g + 2], a3 = bfhi(w.y) - lam * o[t][4 * g + 3];
                            o[t][4 * g] = a0; o[t][4 * g + 1] = a1; o[t][4 * g + 2] = a2; o[t][4 * g + 3] = a3; ss += (a0 * a0 + a1 * a1) + (a2 * a2 + a3 * a3); }
                    ss += __shfl_xor(ss, 32);
                    const float rstd = rsqrtf(ss * (1.f / 128.f) + EPS) * 0.8f;
#pragma unroll
                    for (int t = 0; t < 4; ++t)
#pragma unroll
                        for (int g = 0; g < 4; ++g) { const f32x4 gg = *(const f32x4*)(gsub + t * 32 + 8 * g + 4 * h); u32x2 w;
                            w.x = cvtpk(o[t][4 * g] * rstd * gg[0], o[t][4 * g + 1] * rstd * gg[1]); w.y = cvtpk(o[t][4 * g + 2] * rstd * gg[2], o[t][4 * g + 3] * rstd * gg[3]);
                            *(u32x2*)(CAT + (size_t)row * DM + hd * 128 + t * 32 + 8 * g + 4 * h) = w; }
                }
            }
        }
    }
}

constexpr int NA_KP = 528, NA_BUF = 64 * NA_KP, NA_V0 = 2 * NA_BUF, NA_RPB = 4 * NA_BUF;
DI void na_load(const bf16_t* P1, int rb, int kcol, int vcol, int tid, u32x4 (&kr)[4], u32x4 (&vr)[4]) {
#pragma unroll
    for (int i = 0; i < 4; ++i) { const int id = tid + 512 * i, row = id >> 5, ch = id & 31; const bf16_t* base = P1 + (size_t)(rb + row) * P1W + ch * 8;
        kr[i] = *(const u32x4*)(base + kcol); vr[i] = *(const u32x4*)(base + vcol); }
}
DI void na_store(LAS unsigned char* Kb, LAS unsigned char* Vb, int tid, const u32x4 (&kr)[4], const u32x4 (&vr)[4]) {
#pragma unroll
    for (int i = 0; i < 4; ++i) { const int id = tid + 512 * i, row = id >> 5, ch = id & 31; *(LAS u32x4*)(Kb + row * NA_KP + ch * 16) = kr[i]; *(LAS u32x4*)(Vb + row * NA_KP + ch * 16) = vr[i]; }
}
DI void na_item(const Fr& F, int b, int gr, int hg) {
    bf16_t* P1 = (bf16_t*)(F.ws + WS_P1);
    LAS unsigned char* lds = F.lds; const int tid = F.tid, lane = F.lane, r = lane & 31, h = lane >> 5;
    const int i16 = lane & 15, q4 = i16 >> 2, p4 = i16 & 3, blk = (lane >> 4) & 1;
    const int hl = F.wave & 3, qs = F.wave >> 2, head = hg * 4 + hl, qc = qs * 32 + r;
    const int row = b * SEQ + gr * 64 + qc;
    const int r0 = min(max(gr - 4, 0), 24), c0 = min(max(qc - 8, 0), 48);
    const int kcol = C1_K + hg * 256, vcol = C1_V + hg * 256;
    bf16_t* qptr = P1 + (size_t)row * P1W + C1_Q + head * 64;
    bf16x8 qf[4];
#pragma unroll
    for (int s = 0; s < 4; ++s) qf[s] = *(const bf16x8*)(qptr + 16 * s + 8 * h);
    u32x4 kr[4], vr[4];
    __syncthreads();
    LAS float* rpbs = (LAS float*)(lds + NA_RPB);
    { const float* rpb = F.in[I_RPB] + (size_t)hg * 4 * 465; for (int i = tid; i < 4 * 465; i += 512) rpbs[i] = rpb[i]; }
    na_load(P1, b * SEQ + r0 * 64, kcol, vcol, tid, kr, vr);
    na_store(lds, lds + NA_V0, tid, kr, vr);
    __syncthreads();
    float m = -1e30f, l = 0.f; f32x16 o[2]; o[0] = zero16(); o[1] = zero16();
    const float sc2 = 0.125f * LOG2E;
    for (int kt = 0; kt < 12; ++kt) {
        const bool more = kt + 1 < 12;
        if (more) { const int k1 = kt + 1; na_load(P1, k1 < 8 ? b * SEQ + (r0 + k1) * 64 : TX + b * CTXL + (k1 - 8) * 64, kcol, vcol, tid, kr, vr); }
        const LAS unsigned char* Kb = lds + (kt & 1) * NA_BUF + hl * 128; const LAS unsigned char* Vb = lds + NA_V0 + (kt & 1) * NA_BUF + hl * 128;
        f32x16 st[2];
#pragma unroll
        for (int ks = 0; ks < 2; ++ks) {
            f32x16 a = zero16();
#pragma unroll
            for (int s = 0; s < 4; ++s) { const bf16x8 kf = *(const LAS bf16x8*)(Kb + (ks * 32 + r) * NA_KP + s * 32 + h * 16); a = MFMA32(kf, qf[s], a); }
            st[ks] = a;
        }
        if (kt < 8) {
            const LAS float* bp = rpbs + (hl * 15 + (r0 + kt - gr + 7)) * 31 + 15 - qc;
#pragma unroll
            for (int ks = 0; ks < 2; ++ks)
#pragma unroll
                for (int i = 0; i < 16; ++i) { const int kc = ks * 32 + crow(i, h); const bool ok = kc >= c0 && kc < c0 + 16;
                    const float bias = ok ? bp[kc] : 0.f; st[ks][i] = ok ? (st[ks][i] * sc2 + bias * LOG2E) : -1e30f; }
        } else {
#pragma unroll
            for (int ks = 0; ks < 2; ++ks)
#pragma unroll
                for (int i = 0; i < 16; ++i) st[ks][i] = st[ks][i] * sc2;
        }
        float mx = st[0][0];
#pragma unroll
        for (int i = 0; i < 16; ++i) { mx = fmaxf(mx, st[0][i]); mx = fmaxf(mx, st[1][i]); }
        mx = fmaxf(mx, __shfl_xor(mx, 32));
        const float mn = fmaxf(m, mx), alpha = ex2(m - mn); m = mn;
        float rs = 0.f;
#pragma unroll
        for (int ks = 0; ks < 2; ++ks)
#pragma unroll
            for (int i = 0; i < 16; ++i) { const float p = ex2(st[ks][i] - mn); rs += p; st[ks][i] = p; }
        l = l * alpha + rs; o[0] = o[0] * alpha; o[1] = o[1] * alpha;
#pragma unroll
        for (int ks = 0; ks < 2; ++ks)
#pragma unroll
            for (int s2 = 0; s2 < 2; ++s2) {
                const bf16x8 pf = pack8(st[ks][8 * s2], st[ks][8 * s2 + 1], st[ks][8 * s2 + 2], st[ks][8 * s2 + 3], st[ks][8 * s2 + 4], st[ks][8 * s2 + 5], st[ks][8 * s2 + 6], st[ks][8 * s2 + 7]);
                const LAS unsigned char* vb = Vb + (ks * 32 + 16 * s2 + 4 * h + q4) * NA_KP + (16 * blk + 4 * p4) * 2;
#pragma unroll
                for (int t = 0; t < 2; ++t) { const s16x4 lo = trread(vb + t * 64), hi = trread(vb + t * 64 + 8 * NA_KP); o[t] = MFMA32(cat8(lo, hi), pf, o[t]); }
            }
        if (more) na_store(lds + ((kt + 1) & 1) * NA_BUF, lds + NA_V0 + ((kt + 1) & 1) * NA_BUF, tid, kr, vr);
        __syncthreads();
    }
    l += __shfl_xor(l, 32);
    const float inv = 1.f / l;
#pragma unroll
    for (int t = 0; t < 2; ++t)
#pragma unroll
        for (int g = 0; g < 4; ++g) { u32x2 w; w.x = cvtpk(o[t][4 * g] * inv, o[t][4 * g + 1] * inv); w.y = cvtpk(o[t][4 * g + 2] * inv, o[t][4 * g + 3] * inv);
            *(u32x2*)(qptr + t * 32 + 8 * g + 4 * h) = w; }
}


constexpr int SS_XP = 144, SS_BP = 272;
constexpr int SS_X = 0, SS_B = 18432, SS_C = 53248, SS_H = 88064, SS_DT = 105472, SS_ACS = 105984, SS_SW = 106496, SS_CW = 107008, SS_CB = 113408;
DI void ssd_item(const Fr& F, int b, int hd) {
    const bf16_t* P1 = (const bf16_t*)(F.ws + WS_P1); bf16_t* Y = (bf16_t*)(F.ws + WS_H);
    LAS unsigned char* lds = F.lds; const int tid = F.tid, lane = F.lane, wave = F.wave, r = lane & 31, h = lane >> 5;
    const int i16 = lane & 15, q4 = i16 >> 2, p4 = i16 & 3, blk = (lane >> 4) & 1;
    const int g = hd >> 2, pt = wave >> 2, lt = wave & 3;
    LAS float* dtv = (LAS float*)(lds + SS_DT); LAS float* acs = (LAS float*)(lds + SS_ACS); LAS float* sw = (LAS float*)(lds + SS_SW);
    LAS float* cws = (LAS float*)(lds + SS_CW); LAS float* cbs = (LAS float*)(lds + SS_CB);
    __syncthreads();
    for (int i = tid; i < 6 * 320; i += 512) {
        const int j = i / 320, ci = i % 320; const int ch = ci < 64 ? hd * 64 + ci : (ci < 192 ? 1024 + g * 128 + (ci - 64) : 1536 + g * 128 + (ci - 192));
        if (j < 5) cws[j * 320 + ci] = F.in[I_CONVW][j * 2048 + ch]; else cbs[ci] = F.in[I_CONVB][ch];
    }
    for (int d = 0; d < 2; ++d) {
        __syncthreads();
        const float a = -__expf(F.in[I_ALOG][d * 16 + hd]), Dsk = F.in[I_DSKIP][d * 16 + hd], dtb = F.in[I_DTB][d * 16 + hd];
        const int dtcol = C1_DT + d * 16 + hd;
        f32x16 hreg = zero16();
        for (int i = tid; i < 64 * SS_BP / 4; i += 512) ((LAS unsigned*)(lds + SS_H))[i] = 0u;
        for (int ci = 0; ci < 18; ++ci) {
            const bool isx = ci >= 2; const int cc = isx ? ci - 2 : ci, nch = isx ? 16 : 2, seglen = nch * 128, segrow0 = isx ? b * SEQ : TX + b * CTXL;
            const int tokbase = (d ? nch - 1 - cc : cc) * 128;
            __syncthreads();
            for (int it = tid; it < 640; it += 512) {
                const int cgp = it % 40, rb = it / 40, ci0 = cgp * 8;
                const int ch0 = ci0 < 64 ? hd * 64 + ci0 : (ci0 < 192 ? 1024 + g * 128 + (ci0 - 64) : 1536 + g * 128 + (ci0 - 192));
                const int t0 = tokbase + rb * 8 - 2;
                u32x4 raw[12];
#pragma unroll
                for (int k = 0; k < 12; ++k) { const int tt = t0 + k; raw[k] = (tt >= 0 && tt < seglen) ? *(const u32x4*)(P1 + (size_t)(segrow0 + tt) * P1W + C1_XBC + ch0) : (u32x4){0u, 0u, 0u, 0u}; }
                f32x4 w[5][2], bb[2];
#pragma unroll
                for (int j = 0; j < 5; ++j) { w[j][0] = *(const LAS f32x4*)(cws + j * 320 + ci0); w[j][1] = *(const LAS f32x4*)(cws + j * 320 + ci0 + 4); }
                bb[0] = *(const LAS f32x4*)(cbs + ci0); bb[1] = *(const LAS f32x4*)(cbs + ci0 + 4);
                LAS unsigned char* dst = ci0 < 64 ? lds + SS_X + ci0 * 2 : (ci0 < 192 ? lds + SS_B + (ci0 - 64) * 2 : lds + SS_C + (ci0 - 192) * 2);
                const int pitch = ci0 < 64 ? SS_XP : SS_BP;
#pragma unroll
                for (int i = 0; i < 8; ++i) {
                    f32x4 a0 = bb[0], a1 = bb[1];
#pragma unroll
                    for (int j = 0; j < 5; ++j) { const u32x4 q = raw[i + j];
                        a0 += w[j][0] * (f32x4){bflo(q.x), bfhi(q.x), bflo(q.y), bfhi(q.y)}; a1 += w[j][1] * (f32x4){bflo(q.z), bfhi(q.z), bflo(q.w), bfhi(q.w)}; }
                    u32x4 ov; ov.x = cvtpk(siluf(a0[0]), siluf(a0[1])); ov.y = cvtpk(siluf(a0[2]), siluf(a0[3])); ov.z = cvtpk(siluf(a1[0]), siluf(a1[1])); ov.w = cvtpk(siluf(a1[2]), siluf(a1[3]));
                    const int lr = rb * 8 + i, l = d ? 127 - lr : lr;
                    *(LAS u32x4*)(dst + l * pitch) = ov;
                }
            }
            if (tid < 128) {
                const int tok = tokbase + (d ? 127 - tid : tid);
                const float xr = bf2f(P1[(size_t)(segrow0 + tok) * P1W + dtcol]) + dtb;
                dtv[tid] = xr > 20.f ? xr : log1pf(__expf(xr));
            }
            __syncthreads();
            float el, dtot;
            {
                const float v0 = a * dtv[2 * lane], v1 = a * dtv[2 * lane + 1]; float ps = v0 + v1;
#pragma unroll
                for (int off = 1; off < 64; off <<= 1) { const float t = __shfl_up(ps, off); if (lane >= off) ps += t; }
                const float tot = __shfl(ps, 63);
                const float c0 = ps - v1, c1 = ps;
                acs[2 * lane] = c0; acs[2 * lane + 1] = c1;
                sw[2 * lane] = dtv[2 * lane] * __expf(tot - c0); sw[2 * lane + 1] = dtv[2 * lane + 1] * __expf(tot - c1);
                dtot = __expf(tot);
            }
            asm volatile("s_waitcnt lgkmcnt(0)" ::: "memory");
            if (isx) {
                const int lcol = lt * 32 + r; const float al = acs[lcol]; el = __expf(al);
                f32x16 yacc = zero16();
                for (int stl = 0; stl <= lt; ++stl) {
                    f32x16 sa = zero16();
#pragma unroll
                    for (int kk = 0; kk < 8; ++kk) {
                        const bf16x8 af = *(const LAS bf16x8*)(lds + SS_B + (stl * 32 + r) * SS_BP + kk * 32 + h * 16);
                        const bf16x8 bf = *(const LAS bf16x8*)(lds + SS_C + lcol * SS_BP + kk * 32 + h * 16);
                        sa = MFMA32(af, bf, sa);
                    }
#pragma unroll
                    for (int i = 0; i < 16; ++i) { const int s = stl * 32 + crow(i, h); const float e = __expf(fminf(al - acs[s], 0.f)) * dtv[s]; sa[i] = (s <= lcol) ? sa[i] * e : 0.f; }
#pragma unroll
                    for (int s2 = 0; s2 < 2; ++s2) {
                        const bf16x8 gf = pack8(sa[8 * s2], sa[8 * s2 + 1], sa[8 * s2 + 2], sa[8 * s2 + 3], sa[8 * s2 + 4], sa[8 * s2 + 5], sa[8 * s2 + 6], sa[8 * s2 + 7]);
                        const LAS unsigned char* xb = lds + SS_X + (stl * 32 + 16 * s2 + 4 * h + q4) * SS_XP + (pt * 32 + 16 * blk + 4 * p4) * 2;
                        const s16x4 lo = trread(xb), hi = trread(xb + 8 * SS_XP);
                        yacc = MFMA32(cat8(lo, hi), gf, yacc);
                    }
                }
                f32x16 oa = zero16();
#pragma unroll
                for (int kk = 0; kk < 8; ++kk) {
                    const bf16x8 af = *(const LAS bf16x8*)(lds + SS_H + (pt * 32 + r) * SS_BP + kk * 32 + h * 16);
                    const bf16x8 bf = *(const LAS bf16x8*)(lds + SS_C + lcol * SS_BP + kk * 32 + h * 16);
                    oa = MFMA32(af, bf, oa);
                }
                const int tok = tokbase + (d ? 127 - lcol : lcol);
                bf16_t* yp = Y + (size_t)(b * SEQ + tok) * DM + hd * 64 + pt * 32 + 4 * h;
#pragma unroll
                for (int gq = 0; gq < 4; ++gq) {
                    const u32x2 xw = *(const LAS u32x2*)(lds + SS_X + lcol * SS_XP + (pt * 32 + 8 * gq + 4 * h) * 2);
                    float y0 = yacc[4 * gq] + el * oa[4 * gq] + Dsk * bflo(xw.x), y1 = yacc[4 * gq + 1] + el * oa[4 * gq + 1] + Dsk * bfhi(xw.x);
                    float y2 = yacc[4 * gq + 2] + el * oa[4 * gq + 2] + Dsk * bflo(xw.y), y3 = yacc[4 * gq + 3] + el * oa[4 * gq + 3] + Dsk * bfhi(xw.y);
                    unsigned long long* gp = (unsigned long long*)(yp + 8 * gq);
                    if (d) { const unsigned long long old = __hip_atomic_load(gp, __ATOMIC_RELAXED, __HIP_MEMORY_SCOPE_AGENT); const unsigned lo = (unsigned)old, hi = (unsigned)(old >> 32);
                        y0 += bflo(lo); y1 += bfhi(lo); y2 += bflo(hi); y3 += bfhi(hi); }
                    *gp = (unsigned long long)cvtpk(y0, y1) | ((unsigned long long)cvtpk(y2, y3) << 32);
                }
            }
            __syncthreads();
            {
                f32x16 ha = hreg * dtot;
#pragma unroll
                for (int kk = 0; kk < 8; ++kk) {
                    const int k0 = 16 * kk + 8 * h;
                    const LAS unsigned char* xb = lds + SS_X + (k0 + q4) * SS_XP + (pt * 32 + 16 * blk + 4 * p4) * 2;
                    const s16x4 xl = trread(xb), xh = trread(xb + 4 * SS_XP);
                    const f32x4 w0 = *(const LAS f32x4*)(sw + k0), w1 = *(const LAS f32x4*)(sw + k0 + 4);
                    const bf16x8 af = pack8(bf2f((unsigned short)xl[0]) * w0[0], bf2f((unsigned short)xl[1]) * w0[1], bf2f((unsigned short)xl[2]) * w0[2], bf2f((unsigned short)xl[3]) * w0[3],
                                            bf2f((unsigned short)xh[0]) * w1[0], bf2f((unsigned short)xh[1]) * w1[1], bf2f((unsigned short)xh[2]) * w1[2], bf2f((unsigned short)xh[3]) * w1[3]);
                    const LAS unsigned char* bb = lds + SS_B + (k0 + q4) * SS_BP + (lt * 32 + 16 * blk + 4 * p4) * 2;
                    const s16x4 bl = trread(bb), bh = trread(bb + 4 * SS_BP);
                    ha = MFMA32(af, cat8(bl, bh), ha);
                }
                hreg = ha;
#pragma unroll
                for (int i = 0; i < 16; ++i) *(LAS unsigned short*)(lds + SS_H + (pt * 32 + crow(i, h)) * SS_BP + (lt * 32 + r) * 2) = (unsigned short)(cvtpk(ha[i], 0.f) & 0xffffu);
            }
        }
    }
}
DI void mix1_phase(const Fr& F) {
    for (int it = F.bid; it < 256; it += F.G) ssd_item(F, it >> 4, it & 15);
#if defined(EXPM) && (EXPM & 4)
    for (int it = F.bid; it < 256; it += F.G) ssd_item(F, it >> 4, it & 15);
#endif
    for (int it = F.bid; it < 1024; it += F.G) na_item(F, it >> 6, (it >> 1) & 31, it & 1);
}
DI void merge1_phase(const Fr& F) {
    bf16_t* P1 = (bf16_t*)(F.ws + WS_P1); const bf16_t* Y = (const bf16_t*)(F.ws + WS_H); const float* gn = F.in[I_GNORM];
    const int NGW = F.G * 8, lane = F.lane;
    f32x4 gv[4];
#pragma unroll
    for (int j = 0; j < 4; ++j) gv[j] = *(const f32x4*)(gn + 16 * lane + 4 * j);
    for (int row = F.bid * 8 + F.wave; row < TX; row += NGW) {
        bf16_t* zp = P1 + (size_t)row * P1W + 16 * lane; const bf16_t* yp = Y + (size_t)row * DM + 16 * lane;
        const u32x4 z0 = *(const u32x4*)zp, z1 = *(const u32x4*)(zp + 8), y0 = *(const u32x4*)yp, y1 = *(const u32x4*)(yp + 8);
        float v[16];
        const unsigned zz[8] = {z0.x, z0.y, z0.z, z0.w, z1.x, z1.y, z1.z, z1.w}, yy[8] = {y0.x, y0.y, y0.z, y0.w, y1.x, y1.y, y1.z, y1.w};
        float s = 0.f;
#pragma unroll
        for (int i = 0; i < 8; ++i) { v[2 * i] = bflo(yy[i]) * siluf(bflo(zz[i])); v[2 * i + 1] = bfhi(yy[i]) * siluf(bfhi(zz[i])); s += v[2 * i] * v[2 * i] + v[2 * i + 1] * v[2 * i + 1]; }
        s += __shfl_xor(s, 1); s += __shfl_xor(s, 2); s += __shfl_xor(s, 4); s += __shfl_xor(s, 8);
        const float rstd = rsqrtf(s * (1.f / 256.f) + EPS);
        u32x4 o0, o1;
        o0.x = cvtpk(v[0] * rstd * gv[0][0], v[1] * rstd * gv[0][1]); o0.y = cvtpk(v[2] * rstd * gv[0][2], v[3] * rstd * gv[0][3]);
        o0.z = cvtpk(v[4] * rstd * gv[1][0], v[5] * rstd * gv[1][1]); o0.w = cvtpk(v[6] * rstd * gv[1][2], v[7] * rstd * gv[1][3]);
        o1.x = cvtpk(v[8] * rstd * gv[2][0], v[9] * rstd * gv[2][1]); o1.y = cvtpk(v[10] * rstd * gv[2][2], v[11] * rstd * gv[2][3]);
        o1.z = cvtpk(v[12] * rstd * gv[3][0], v[13] * rstd * gv[3][1]); o1.w = cvtpk(v[14] * rstd * gv[3][2], v[15] * rstd * gv[3][3]);
        *(u32x4*)zp = o0; *(u32x4*)(zp + 8) = o1;
    }
}

#define XB_TMO      128
#define XB_XCNT(j)  (256  + 64 * (j))
#define XB_XSUB(j)  (1280 + 64 * (j))
#define XB_XGEN(j)  (2304 + 64 * (j))
#define XB_TOP      3328
#define XB_TOPGEN   3392
#define XCD_BAR_WORDS 3456
#define XB_SPIN_CAP (1u << 18)

__device__ __forceinline__ unsigned xb_ld(unsigned* p)              { return __hip_atomic_load(p, __ATOMIC_RELAXED, __HIP_MEMORY_SCOPE_AGENT); }
__device__ __forceinline__ unsigned xb_add(unsigned* p, unsigned v) { return __hip_atomic_fetch_add(p, v, __ATOMIC_RELAXED, __HIP_MEMORY_SCOPE_AGENT); }
__device__ __forceinline__ unsigned xb_xcc_id() { return (unsigned)__builtin_amdgcn_s_getreg((3 << 11) | 20) & 0xFu; }
#define XB_SPIN(cond, bar) do { unsigned _sp = 0; while (cond) { __builtin_amdgcn_s_sleep(1); \
    if ((++_sp & 255u) == 0u) { if (xb_ld(&(bar)[XB_TMO])) break; if (_sp > XB_SPIN_CAP) { atomicAdd(&(bar)[XB_TMO], 1u); break; } } } } while (0)

struct XcdBarrier {
    unsigned* bar; unsigned x;
    volatile LAS unsigned* st;
};

__device__ __forceinline__ XcdBarrier xcd_barrier_post(unsigned* bar, volatile LAS unsigned* st) {
    XcdBarrier b; b.bar = bar; b.x = xb_xcc_id(); b.st = st;
    if (threadIdx.x == 0) (void)xb_add(&bar[XB_XCNT(b.x)], 1u);
    return b;
}
__device__ __forceinline__ void xcd_barrier_complete(unsigned* bar, unsigned x, unsigned& nloc, unsigned& nx) {
    const unsigned G = gridDim.x * gridDim.y * gridDim.z;
    unsigned sum, cnt, mine, sp = 0u;
    for (;;) {
        sum = 0u; cnt = 0u; mine = 0u;
#pragma unroll
        for (unsigned j = 0; j < 16; ++j) { const unsigned c = xb_ld(&bar[XB_XCNT(j)]); sum += c; cnt += (c > 0u) ? 1u : 0u; mine = (j == x) ? c : mine; }
        if (sum == G) break;
        __builtin_amdgcn_s_sleep(1);
        if ((++sp & 255u) == 0u) { if (xb_ld(&bar[XB_TMO])) break; if (sp > XB_SPIN_CAP) { atomicAdd(&bar[XB_TMO], 1u); break; } }
    }
    nloc = mine > 0u ? mine : 1u; nx = cnt > 0u ? cnt : 1u;
}

__device__ __forceinline__ void xcd_barrier(const XcdBarrier& b) {
    asm volatile("s_waitcnt vmcnt(0)" ::: "memory");
    __syncthreads();
    if (threadIdx.x == 0) {
        unsigned* bar = b.bar;
        __builtin_amdgcn_s_waitcnt(0);
        unsigned nloc = b.st[0], nx = b.st[1];
        if (nloc == 0u) { xcd_barrier_complete(bar, b.x, nloc, nx); b.st[0] = nloc; b.st[1] = nx; }
        const unsigned old = xb_add(&bar[XB_XSUB(b.x)], 1u);
        const unsigned gen = old / nloc;
        if (old + 1u == (gen + 1u) * nloc) {
            __builtin_amdgcn_fence(__ATOMIC_RELEASE, "agent");
            asm volatile("s_waitcnt vmcnt(0)" ::: "memory");
            const unsigned og = xb_add(&bar[XB_TOP], 1u);
            const unsigned tg = og / nx;
            if (og + 1u == (tg + 1u) * nx) xb_add(&bar[XB_TOPGEN], 1u);
            else XB_SPIN(xb_ld(&bar[XB_TOPGEN]) == tg, bar);
            __builtin_amdgcn_fence(__ATOMIC_ACQUIRE, "agent");
            xb_add(&bar[XB_XGEN(b.x)], 1u);
            asm volatile("s_waitcnt vmcnt(0)" ::: "memory");
        } else {
            XB_SPIN(xb_ld(&bar[XB_XGEN(b.x)]) == gen, bar);
            __builtin_amdgcn_fence(__ATOMIC_ACQUIRE, "agent");
            asm volatile("s_waitcnt vmcnt(0)" ::: "memory");
        }
    }
    __syncthreads();
}

DI void refresh(Fr& F, const Params& prm) {
    int t = threadIdx.x; asm volatile("" : "+v"(t));
    F.tid = t; F.lane = t & 63; F.wave = __builtin_amdgcn_readfirstlane(t >> 6);
    unsigned char* w = prm.ws; asm volatile("" : "+s"(w)); F.ws = w;
    float* o = prm.out; asm volatile("" : "+s"(o)); F.out = o;
}
__global__ void __launch_bounds__(512, 2) mega_fwd(Params prm) {
    extern __shared__ __attribute__((aligned(16))) unsigned char lds_raw[];
    cg::grid_group grid = cg::this_grid();
    Fr F; F.lds = (LAS unsigned char*)lds_raw; F.bid = blockIdx.x; F.G = gridDim.x; F.in = prm.in;
    refresh(F, prm);
#define WB(off) ((const bf16_t*)(F.ws + (off)))
#define WP(off) ((bf16_t*)(F.ws + (off)))
#define MOD(l, j) ((const float*)(F.ws + WS_MOD) + (size_t)(l) * 17 * 9216 + (j) * 1024)
#define COST ((const float*)(F.ws + WS_ROPE))
#define SSQ ((float*)(F.ws + WS_SSQ))
#define CRES ((float*)(F.ws + WS_CTXRES))
    volatile LAS unsigned* xst = (volatile LAS unsigned*)(F.lds + LDS_BYTES - 16);
    if (threadIdx.x < 4) xst[threadIdx.x] = 0u;
    __syncthreads();
    const XcdBarrier xbar = xcd_barrier_post((unsigned*)(prm.ws + WS_BAR), xst);
#ifndef EXPM
#define EXPM 0
#endif
#define SYNC() do { xcd_barrier(xbar); refresh(F, prm); } while (0)
    prep_phase(F); grid.sync(); refresh(F, prm);
    norm_phase(F, 0, F.in[I_GF1], 0, TT, F.in[I_X], F.in[I_CTX], WP(WS_H)); SYNC();
    run_gemm(F, WB(WS_H), DM, WB(W0_F1I), TT, 2 * FF, DM, pg8::EpiSwiglu{WP(WS_ACT)}); SYNC();
    run_gemm(F, WB(WS_ACT), FF, WB(W0_F1O), TT, DM, FF, pg8::EpiRes{F.in[I_X], F.in[I_CTX], F.out, CRES, MOD(0, 2), 0.5f}); SYNC();
    norm_phase(F, 0, F.in[I_GMIX], 3, TT, F.out, CRES, WP(WS_H)); SYNC();
    run_gemm(F, WB(WS_H), DM, WB(W0_ABI), TT, 2048, DM, pg8::EpiAbIn{WP(WS_P0), COST, COST + 1024, SSQ}); SYNC();
    run_gemm(F, WB(WS_P0) + 1536, P0W, WB(W0_UP), TT, QKW, 384, pg8::EpiMlaUp{WP(WS_QKV), SSQ}); SYNC();
    attn0_phase(F); SYNC();
#if EXPM & 2
    attn0_phase(F); SYNC();
#endif
    run_gemm(F, WB(WS_H), DM, WB(W0_ABO), TT, DM, DM, pg8::EpiRes{F.out, CRES, F.out, CRES, MOD(0, 5), 1.f}); SYNC();
    norm_phase(F, 0, F.in[I_GF2], 6, TT, F.out, CRES, WP(WS_H)); SYNC();
    run_gemm(F, WB(WS_H), DM, WB(W0_F2I), TT, 2 * FF, DM, pg8::EpiSwiglu{WP(WS_ACT)}); SYNC();
    run_gemm(F, WB(WS_ACT), FF, WB(W0_F2O), TT, DM, FF, pg8::EpiRes{F.out, CRES, F.out, CRES, MOD(0, 8), 0.5f}); SYNC();
    norm_phase(F, 1, F.in[I_GF1] + DM, 0, TT, F.out, CRES, WP(WS_H)); SYNC();
    run_gemm(F, WB(WS_H), DM, WB(W1_F1I), TT, 2 * FF, DM, pg8::EpiSwiglu{WP(WS_ACT)}); SYNC();
    run_gemm(F, WB(WS_ACT), FF, WB(W1_F1O), TT, DM, FF, pg8::EpiRes{F.out, CRES, F.out, CRES, MOD(1, 2), 0.5f}); SYNC();
    norm_phase(F, 1, F.in[I_GMIX] + DM, 3, TT, F.out, CRES, WP(WS_H)); SYNC();
    run_gemm(F, WB(WS_H), DM, WB(W1_CDI), TT, 4864, DM, pg8::EpiStore{WP(WS_P1), P1W, P1W}); SYNC();
    mix1_phase(F); SYNC();
    merge1_phase(F); SYNC();
    run_gemm(F, WB(WS_P1), P1W, WB(W1_CDO), TX, DM, 1536, pg8::EpiRes{F.out, CRES, F.out, CRES, MOD(1, 5), 1.f}); SYNC();
    norm_phase(F, 1, F.in[I_GF2] + DM, 6, TX, F.out, CRES, WP(WS_H)); SYNC();
    run_gemm(F, WB(WS_H), DM, WB(W1_F2I), TX, 2 * FF, DM, pg8::EpiSwiglu{WP(WS_ACT)}); SYNC();
    run_gemm(F, WB(WS_ACT), FF, WB(W1_F2O), TX, DM, FF, pg8::EpiRes{F.out, CRES, F.out, CRES, MOD(1, 8), 0.5f}); SYNC();
    final_norm_phase(F);
}

extern "C" void kernel_launch(void* const* d_in, const int* in_sizes, int n_in, void* d_out, int out_size, void* d_ws, size_t ws_size, hipStream_t stream) {
    static int grid = 0;
    if (grid == 0) {
        int dev = 0, cus = 0, per_cu = 0;
        (void)hipGetDevice(&dev); (void)hipDeviceGetAttribute(&cus, hipDeviceAttributeMultiprocessorCount, dev);
        if (hipFuncSetAttribute((const void*)mega_fwd, hipFuncAttributeMaxDynamicSharedMemorySize, LDS_BYTES) != hipSuccess) fprintf(stderr, "kernel_launch: hipFuncSetAttribute failed\n");
        if (hipOccupancyMaxActiveBlocksPerMultiprocessor(&per_cu, (const void*)mega_fwd, 512, LDS_BYTES) != hipSuccess || per_cu < 1) { fprintf(stderr, "kernel_launch: occupancy query gave %d\n", per_cu); per_cu = 1; }
        (void)hipGetLastError();
        if (cus <= 0) cus = 256;
        grid = cus * per_cu;
        if (n_in != 34 || ws_size < WS_END) fprintf(stderr, "kernel_launch: unexpected n_in %d / ws_size %zu (need %zu)\n", n_in, ws_size, (size_t)WS_END);
    }
    Params p{};
    for (int i = 0; i < 34; ++i) p.in[i] = (const float*)d_in[i];
    p.out = (float*)d_out; p.ws = (unsigned char*)d_ws;
    (void)hipMemsetAsync((unsigned char*)d_ws + WS_BAR, 0, 16384, stream);
    void* args[] = {&p};
    hipError_t e = hipLaunchCooperativeKernel((const void*)mega_fwd, dim3(grid), dim3(512), args, LDS_BYTES, stream);
    if (e != hipSuccess) fprintf(stderr, "cooperative launch failed: %s (grid %d)\n", hipGetErrorString(e), grid);
}
```

```cpp
#include <hip/hip_runtime.h>
#include <hip/hip_cooperative_groups.h>
#include <cstdio>
#include <cstdint>
namespace cg = cooperative_groups;

#define DI __device__ __forceinline__
#define LAS __attribute__((address_space(3)))
typedef short bf16x8 __attribute__((ext_vector_type(8)));
typedef short s16x4 __attribute__((ext_vector_type(4)));
typedef float f32x2 __attribute__((ext_vector_type(2)));
typedef float f32x4 __attribute__((ext_vector_type(4)));
typedef float f32x16 __attribute__((ext_vector_type(16)));
typedef unsigned u32x2 __attribute__((ext_vector_type(2)));
typedef unsigned u32x4 __attribute__((ext_vector_type(4)));
typedef __bf16 bf16x2_t __attribute__((ext_vector_type(2)));
typedef unsigned short bf16_t;

constexpr int DM = 1024, NB = 16, SEQ = 2048, CTXL = 256, FF = 2816;
constexpr int TX = NB * SEQ;
constexpr int TC = NB * CTXL;
constexpr int TT = TX + TC;
constexpr float EPS = 1e-6f;
constexpr float LOG2E = 1.4426950408889634f;
constexpr int P0W = 2048;
constexpr int QKW = 1792;
constexpr int P1W = 4640;
constexpr int C1_Q = 1024, C1_K = 1536, C1_V = 2048, C1_XBC = 2560, C1_DT = 4608;

constexpr size_t MiB = 1u << 20;
constexpr size_t WS_MOD = 0;
constexpr size_t WS_ROPE = 2 * MiB;
constexpr size_t WS_SSQ = 2 * MiB + 65536;
constexpr size_t WS_BAR = 2 * MiB + 512 * 1024;
constexpr size_t WS_STAMP = 2 * MiB + 768 * 1024;
constexpr size_t WS_SCAN = 3 * MiB;
constexpr size_t WS_W0 = 3 * MiB;
constexpr size_t W_FFN_IN = (size_t)2 * FF * DM * 2;
constexpr size_t W_FFN_OUT = (size_t)DM * FF * 2;
constexpr size_t W0_F1I = WS_W0, W0_F1O = W0_F1I + W_FFN_IN, W0_F2I = W0_F1O + W_FFN_OUT, W0_F2O = W0_F2I + W_FFN_IN;
constexpr size_t W0_ABI = W0_F2O + W_FFN_OUT;
constexpr size_t W0_UP = W0_ABI + (size_t)2048 * 1024 * 2;
constexpr size_t W0_ABO = W0_UP + (size_t)1536 * 1024;
constexpr size_t WS_W1 = 44 * MiB;
constexpr size_t W1_F1I = WS_W1, W1_F1O = W1_F1I + W_FFN_IN, W1_F2I = W1_F1O + W_FFN_OUT, W1_F2O = W1_F2I + W_FFN_IN;
constexpr size_t W1_CDI = W1_F2O + W_FFN_OUT;
constexpr size_t W1_CDO = W1_CDI + (size_t)4864 * 1024 * 2;
constexpr size_t WS_CTXRES = 90 * MiB;
constexpr size_t WS_H = 106 * MiB;
constexpr size_t WS_BIG = 178 * MiB;
constexpr size_t WS_ACT = WS_BIG;
constexpr size_t WS_P0 = WS_BIG;
constexpr size_t WS_QKV = WS_BIG + 144 * MiB;
constexpr size_t WS_ODS = WS_BIG + 270 * MiB;
constexpr size_t WS_P1 = WS_BIG;
constexpr size_t WS_HALO = WS_BIG + 327 * MiB;
constexpr size_t WS_END = WS_HALO + 5 * MiB;

constexpr int LDS_BYTES = 147456;

DI float bf2f(unsigned short b) { return __uint_as_float((unsigned)b << 16); }
DI float bflo(unsigned w) { return __uint_as_float(w << 16); }
DI float bfhi(unsigned w) { return __uint_as_float(w & 0xffff0000u); }
DI unsigned cvtpk(float lo, float hi) { f32x2 v = {lo, hi}; bf16x2_t b = __builtin_convertvector(v, bf16x2_t); return __builtin_bit_cast(unsigned, b); }
DI float ex2(float x) { return __builtin_amdgcn_exp2f(x); }
DI float fexp(float x) { return __builtin_amdgcn_exp2f(x * LOG2E); }
DI float frcp(float x) { return __builtin_amdgcn_rcpf(x); }
DI float siluf(float x) { return x * frcp(1.f + fexp(-x)); }
DI float wave_sum(float v) {
#pragma unroll
    for (int o = 1; o < 64; o <<= 1) v += __shfl_xor(v, o);
    return v;
}
DI int crow(int reg, int h) { return (reg & 3) + 8 * (reg >> 2) + 4 * h; }
#define MFMA32(a, b, c) __builtin_amdgcn_mfma_f32_32x32x16_bf16((a), (b), (c), 0, 0, 0)
typedef short v4i16_t __attribute__((ext_vector_type(4)));
DI s16x4 trread(const LAS unsigned char* p) { return __builtin_bit_cast(s16x4, __builtin_amdgcn_ds_read_tr16_b64_v4i16((LAS v4i16_t*)p)); }
DI bf16x8 cat8(s16x4 lo, s16x4 hi) { return __builtin_shufflevector(lo, hi, 0, 1, 2, 3, 4, 5, 6, 7); }
DI bf16x8 pack8(float a0, float a1, float a2, float a3, float a4, float a5, float a6, float a7) {
    u32x4 p; p.x = cvtpk(a0, a1); p.y = cvtpk(a2, a3); p.z = cvtpk(a4, a5); p.w = cvtpk(a6, a7); return __builtin_bit_cast(bf16x8, p);
}
DI f32x16 zero16() { f32x16 z;
#pragma unroll
    for (int i = 0; i < 16; ++i) z[i] = 0.f;
    return z; }
DI int lane_id() { unsigned ones = ~0u; asm volatile("" : "+s"(ones)); return (int)__builtin_amdgcn_mbcnt_hi(ones, __builtin_amdgcn_mbcnt_lo(ones, 0u)); }

namespace pg8 {
#define PG8_LAS __attribute__((address_space(3)))

typedef unsigned short bf16_t;
typedef short bf16x8 __attribute__((ext_vector_type(8)));
typedef float f32x4 __attribute__((ext_vector_type(4)));
typedef unsigned u32x4 __attribute__((ext_vector_type(4)));
constexpr int BM = 256, BK = 64, HALF = 128, HTB = HALF * BK * 2  , STAGE_BYTES = 8 * HTB, NXCD = 8, WGM = 8;

__host__ __device__ __forceinline__ int lds_byte(int r, int c) { const int st = (r >> 4) * 2 + (c >> 5), rr = r & 15, cc = c & 31, ob = rr * 64 + cc * 2; return st * 1024 + (ob ^ (((ob >> 9) & 1) << 5)); }
__host__ __device__ __forceinline__ void stage_rc(int b, int& R, int& C) { const int st = b / 1024, sb = b % 1024, swz = sb ^ (((sb >> 9) & 1) << 5); R = (st >> 1) * 16 + swz / 64; C = (st & 1) * 32 + (swz % 64) / 2; }
__host__ __device__ __forceinline__ int perm32(int rho) { const int n = rho >> 4, i = rho & 15; return 8 * (i >> 2) + 4 * n + (i & 3); }

struct Unit { int pm, pn; };
struct Gemm { const bf16_t* A; const bf16_t* Bt; int M, N, K, lda; int pn_split, k0_lo, nt_lo, k0_hi, nt_hi; };

struct StaticOrder {
    int nM, nN, nwg, G, c;
    __host__ __device__ void init(int M, int N, int G_, int c_) { nM = M / BM; nN = N / BM; nwg = nM * nN; G = G_; c = c_; }
    __host__ __device__ bool next(int i, Unit& u) const {
        const long L = (long)i * G + c; if (L >= nwg) return false;
        int wgid = (int)L; { const int q = nwg / NXCD, r = nwg % NXCD, xcd = wgid % NXCD, off = wgid / NXCD; wgid = (xcd < r ? xcd * (q + 1) : r * (q + 1) + (xcd - r) * q) + off; }
        const int nig = WGM * nN, gid = wgid / nig, fm = gid * WGM, gsz = (nM - fm) < WGM ? (nM - fm) : WGM;
        u.pm = fm + ((wgid % nig) % gsz); u.pn = (wgid % nig) / gsz; return true;
    }
    __device__ __forceinline__ void a_ready(const Unit&) const {}
    __device__ __forceinline__ void done(const Unit&) const {}
};


template <class Epi, class Sched, bool ALIGN_EPI = false, bool SP2 = false>
__device__ __forceinline__ void gemm_phase(PG8_LAS unsigned char* lds, const Gemm g, const Sched& S, const Epi& E, int tid_in) {
    int tid_ = tid_in; asm volatile("" : "+v"(tid_));
    const int tid = tid_, wid = __builtin_amdgcn_readfirstlane(tid >> 6), lane = tid & 63, wr = wid >> 2, wc = wid & 3, fr = lane & 15, fq = lane >> 4;
    const int K = g.K;
#define PG8_KOF(u) ((size_t)(((u).pn < g.pn_split) ? g.k0_lo : g.k0_hi) * 2)
#define PG8_NT(u) (((u).pn < g.pn_split) ? g.nt_lo : g.nt_hi)
    unsigned voffA[2], voffB[2];
#pragma unroll
    for (int i = 0; i < 2; ++i) { int R, C; stage_rc(tid * 16 + i * 8192, R, C); const int Rb = Epi::PERM ? ((R & ~31) + perm32(R & 31)) : R;
        voffA[i] = (unsigned)(R * g.lda + C) * 2u; voffB[i] = (unsigned)(Rb * K + C) * 2u; }
    const size_t kstep = (size_t)(BK * 2);
    const size_t hstepB = (size_t)HALF * K * 2, hstepA = (size_t)HALF * g.lda * 2;
    const size_t tstepA = 2 * hstepA, tstepB = 2 * hstepB;
    const unsigned ldsw = (unsigned)wid * 1024u;
    const int aoff = lds_byte(wr * 64 + fr, fq * 8), boff = lds_byte(wc * 32 + fr, fq * 8);
#define PG8_SA(b, h) (((b) * 2 + (h)) * HTB)
#define PG8_SB(b, h) ((4 + (b) * 2 + (h)) * HTB)
#define PG8_STAGE(bufoff, gbase, voff) do { _Pragma("unroll") for (int _i = 0; _i < 2; ++_i) \
        __builtin_amdgcn_global_load_lds((const unsigned*)((const char*)(gbase) + (voff)[_i]), (PG8_LAS unsigned*)(lds + (bufoff) + ldsw + _i * 8192), 16, 0, 0); } while (0)
#define PG8_LDA(dst, b, h) do { _Pragma("unroll") for (int m = 0; m < 4; ++m) _Pragma("unroll") for (int k = 0; k < 2; ++k) dst[m][k] = *(const PG8_LAS bf16x8*)(lds + PG8_SA(b, h) + aoff + m * 2048 + k * 1024); } while (0)
#define PG8_LDB(dst, b, h) do { _Pragma("unroll") for (int n = 0; n < 2; ++n) _Pragma("unroll") for (int k = 0; k < 2; ++k) dst[n][k] = *(const PG8_LAS bf16x8*)(lds + PG8_SB(b, h) + boff + n * 2048 + k * 1024); } while (0)
#define PG8_MMA(ai, bj, At, Bt) do { __builtin_amdgcn_s_setprio(1); _Pragma("unroll") for (int m = 0; m < 4; ++m) _Pragma("unroll") for (int n = 0; n < 2; ++n) _Pragma("unroll") for (int k = 0; k < 2; ++k) \
        acc[ai][bj][m][n] = __builtin_amdgcn_mfma_f32_16x16x32_bf16(Bt[n][k], At[m][k], acc[ai][bj][m][n], 0, 0, 0); __builtin_amdgcn_s_setprio(0); } while (0)
#define PG8_WAIT_V(n) asm volatile("s_waitcnt vmcnt(" #n ")" ::: "memory")
#define PG8_WAIT_L(n) asm volatile("s_waitcnt lgkmcnt(" #n ")" ::: "memory")
#define PG8_BAR __builtin_amdgcn_s_barrier()
#define PG8_SCHED __builtin_amdgcn_sched_barrier(0)
    Unit cur, nxt; int ui = 0;
    if (!S.next(0, cur)) return;
    f32x4 acc[2][2][4][2];
#pragma unroll
    for (int a = 0; a < 2; ++a)
#pragma unroll
        for (int b = 0; b < 2; ++b)
#pragma unroll
            for (int m = 0; m < 4; ++m)
#pragma unroll
                for (int n = 0; n < 2; ++n) acc[a][b][m][n] = (f32x4){0.f, 0.f, 0.f, 0.f};
    bf16x8 At[4][2], B0[2][2], B1[2][2];
    const char* cA = (const char*)g.A + (size_t)cur.pm * tstepA + PG8_KOF(cur); const char* cB = (const char*)g.Bt + (size_t)cur.pn * tstepB + PG8_KOF(cur);
    int nt = PG8_NT(cur);
    S.a_ready(cur);
    if constexpr (SP2) {
        PG8_STAGE(PG8_SB(0, 0), cB, voffB); PG8_STAGE(PG8_SB(0, 1), cB + hstepB, voffB); PG8_STAGE(PG8_SA(0, 0), cA, voffA); PG8_STAGE(PG8_SA(0, 1), cA + hstepA, voffA);
        if (wr == 1) PG8_BAR;
        PG8_WAIT_V(2); PG8_BAR;
        PG8_STAGE(PG8_SB(1, 0), cB + kstep, voffB); PG8_STAGE(PG8_SA(1, 0), cA + kstep, voffA); PG8_STAGE(PG8_SB(1, 1), cB + hstepB + kstep, voffB);
        PG8_WAIT_V(6); PG8_BAR;
    } else {
        PG8_STAGE(PG8_SB(0, 0), cB, voffB); PG8_STAGE(PG8_SA(0, 0), cA, voffA); PG8_STAGE(PG8_SB(0, 1), cB + hstepB, voffB); PG8_STAGE(PG8_SA(0, 1), cA + hstepA, voffA);
        if (wr == 1) PG8_BAR;
        PG8_WAIT_V(4); PG8_BAR;
        PG8_STAGE(PG8_SB(1, 0), cB + kstep, voffB); PG8_STAGE(PG8_SA(1, 0), cA + kstep, voffA); PG8_STAGE(PG8_SB(1, 1), cB + hstepB + kstep, voffB);
        PG8_WAIT_V(6); PG8_BAR;
    }
    for (;;) {
        const bool has_next = S.next(ui + 1, nxt);
        const char* nA = has_next ? (const char*)g.A + (size_t)nxt.pm * tstepA + PG8_KOF(nxt) : cA; const char* nB = has_next ? (const char*)g.Bt + (size_t)nxt.pn * tstepB + PG8_KOF(nxt) : cB;
        for (int t = 0; t < nt; t += 2) {
            const bool last = (t == nt - 2);
            const char* a1 = cA + (size_t)(t + 1) * kstep;
            const char* a2 = last ? nA : cA + (size_t)(t + 2) * kstep; const char* b2 = last ? nB : cB + (size_t)(t + 2) * kstep;
            const char* a3 = a2 + kstep; const char* b3 = b2 + kstep;
            if (last && has_next) S.a_ready(nxt);
            if constexpr (SP2) {
            PG8_LDB(B0, 0, 0); PG8_LDB(B1, 0, 1); PG8_SCHED; PG8_LDA(At, 0, 0); PG8_STAGE(PG8_SA(1, 1), a1 + hstepA, voffA);
            PG8_WAIT_V(8); PG8_WAIT_L(0); PG8_BAR; PG8_MMA(0, 0, At, B0); PG8_MMA(0, 1, At, B1); PG8_BAR; PG8_SCHED;
            PG8_LDA(At, 0, 1); PG8_STAGE(PG8_SB(0, 0), b2, voffB); PG8_STAGE(PG8_SB(0, 1), b2 + hstepB, voffB); PG8_STAGE(PG8_SA(0, 0), a2, voffA);
            PG8_WAIT_V(8); PG8_WAIT_L(0); PG8_BAR; PG8_MMA(1, 0, At, B0); PG8_MMA(1, 1, At, B1); PG8_BAR; PG8_SCHED;
            PG8_LDB(B0, 1, 0); PG8_LDB(B1, 1, 1); PG8_SCHED; PG8_LDA(At, 1, 0); PG8_STAGE(PG8_SA(0, 1), a2 + hstepA, voffA);
            PG8_WAIT_V(8); PG8_WAIT_L(0); PG8_BAR; PG8_MMA(0, 0, At, B0); PG8_MMA(0, 1, At, B1); PG8_BAR; PG8_SCHED;
            PG8_LDA(At, 1, 1); PG8_STAGE(PG8_SB(1, 0), b3, voffB); PG8_STAGE(PG8_SB(1, 1), b3 + hstepB, voffB); PG8_STAGE(PG8_SA(1, 0), a3, voffA);
            PG8_WAIT_V(8); PG8_WAIT_L(0); PG8_BAR; PG8_MMA(1, 0, At, B0); PG8_MMA(1, 1, At, B1); PG8_BAR; PG8_SCHED;
            } else {
            PG8_LDB(B0, 0, 0); PG8_SCHED; PG8_LDA(At, 0, 0); PG8_STAGE(PG8_SA(1, 1), a1 + hstepA, voffA);
            PG8_WAIT_L(8); PG8_BAR; PG8_WAIT_L(0); PG8_MMA(0, 0, At, B0); PG8_BAR; PG8_SCHED;
            PG8_LDB(B1, 0, 1); PG8_STAGE(PG8_SB(0, 0), b2, voffB);
            PG8_BAR; PG8_WAIT_L(0); PG8_MMA(0, 1, At, B1); PG8_BAR;
            PG8_LDA(At, 0, 1); PG8_STAGE(PG8_SA(0, 0), a2, voffA);
            PG8_BAR; PG8_WAIT_L(0); PG8_MMA(1, 0, At, B0); PG8_BAR; PG8_SCHED;
            PG8_STAGE(PG8_SB(0, 1), b2 + hstepB, voffB);
            PG8_WAIT_V(6); PG8_BAR; PG8_MMA(1, 1, At, B1); PG8_BAR;
            PG8_LDB(B0, 1, 0); PG8_SCHED; PG8_LDA(At, 1, 0); PG8_STAGE(PG8_SA(0, 1), a2 + hstepA, voffA);
            PG8_WAIT_L(8); PG8_BAR; PG8_WAIT_L(0); PG8_MMA(0, 0, At, B0); PG8_BAR; PG8_SCHED;
            PG8_LDB(B1, 1, 1); PG8_STAGE(PG8_SB(1, 0), b3, voffB);
            PG8_BAR; PG8_WAIT_L(0); PG8_MMA(0, 1, At, B1); PG8_BAR;
            PG8_LDA(At, 1, 1); PG8_STAGE(PG8_SA(1, 0), a3, voffA);
            PG8_BAR; PG8_WAIT_L(0); PG8_MMA(1, 0, At, B0); PG8_BAR; PG8_SCHED;
            PG8_STAGE(PG8_SB(1, 1), b3 + hstepB, voffB);
            PG8_WAIT_V(6); PG8_BAR; PG8_MMA(1, 1, At, B1); PG8_BAR;
            }
        }
        if constexpr (ALIGN_EPI) { if (wr == 0) PG8_BAR; }
        if constexpr (!Epi::AFTER_DRAIN) { E(acc, cur, wr, wc, fr, fq); S.done(cur); }
        if (!has_next) break;
#pragma unroll
        for (int a = 0; a < 2; ++a)
#pragma unroll
            for (int b = 0; b < 2; ++b)
#pragma unroll
                for (int m = 0; m < 4; ++m)
#pragma unroll
                    for (int n = 0; n < 2; ++n) acc[a][b][m][n] = (f32x4){0.f, 0.f, 0.f, 0.f};
        cur = nxt; cA = nA; cB = nB; ++ui; nt = PG8_NT(cur);
        if constexpr (ALIGN_EPI) { if (wr == 1) PG8_BAR; }
    }
    PG8_WAIT_V(0);
    if constexpr (!ALIGN_EPI) { if (wr == 0) PG8_BAR; }
    PG8_BAR;
    if constexpr (Epi::AFTER_DRAIN) { E.fused(acc, cur, wr, wc, fr, fq, lds, wid, lane); S.done(cur); }
#undef PG8_KOF
#undef PG8_NT
#undef PG8_SA
#undef PG8_SB
#undef PG8_STAGE
#undef PG8_LDA
#undef PG8_LDB
#undef PG8_MMA
#undef PG8_WAIT_V
#undef PG8_WAIT_L
#undef PG8_BAR
#undef PG8_SCHED
}
}


namespace pg8 {
struct EpiSwiglu {
    static constexpr bool PERM = true, AFTER_DRAIN = false;
    bf16_t* O;
    __device__ __forceinline__ void operator()(const f32x4 (&acc)[2][2][4][2], const Unit& u, int wr, int wc, int fr, int fq) const {
        const int row0 = u.pm * BM + wr * 64 + fr, col0 = u.pn * 128 + wc * 32 + 8 * fq;
#pragma unroll
        for (int ai = 0; ai < 2; ++ai)
#pragma unroll
            for (int m = 0; m < 4; ++m) {
                const f32x4 g0 = acc[ai][0][m][0], g1 = acc[ai][0][m][1], u0 = acc[ai][1][m][0], u1 = acc[ai][1][m][1];
                u32x4 w;
                w.x = cvtpk(siluf(g0[0]) * u0[0], siluf(g0[1]) * u0[1]); w.y = cvtpk(siluf(g0[2]) * u0[2], siluf(g0[3]) * u0[3]);
                w.z = cvtpk(siluf(g1[0]) * u1[0], siluf(g1[1]) * u1[1]); w.w = cvtpk(siluf(g1[2]) * u1[2], siluf(g1[3]) * u1[3]);
                *(u32x4*)(O + (size_t)(row0 + ai * HALF + m * 16) * FF + col0) = w;
            }
    }
};
struct EpiRes {
    static constexpr bool PERM = false, AFTER_DRAIN = false;
    const float* rin_x; const float* rin_c; float* rout_x; float* rout_c; const float* gate  ; float gs; int roff;
    __device__ __forceinline__ void operator()(const f32x4 (&acc)[2][2][4][2], const Unit& u, int wr, int wc, int fr, int fq) const {
        const int rowb = roff + u.pm * BM; const bool isx = rowb < TX;
        const float* gp = gate + (size_t)(isx ? (rowb >> 11) : 16) * 9216 + u.pn * BM + wc * 32 + 4 * fq;
        f32x4 gv[2][2];
#pragma unroll
        for (int bj = 0; bj < 2; ++bj)
#pragma unroll
            for (int n = 0; n < 2; ++n) gv[bj][n] = *(const f32x4*)(gp + bj * HALF + n * 16) * gs;
        const float* ri0 = (isx ? rin_x + (size_t)rowb * DM : rin_c + (size_t)(rowb - TX) * DM) + (size_t)(wr * 64 + fr) * DM + u.pn * BM + wc * 32 + 4 * fq;
        float* ro0 = (isx ? rout_x + (size_t)rowb * DM : rout_c + (size_t)(rowb - TX) * DM) + (size_t)(wr * 64 + fr) * DM + u.pn * BM + wc * 32 + 4 * fq;
#pragma unroll
        for (int ai = 0; ai < 2; ++ai)
#pragma unroll
            for (int mp = 0; mp < 2; ++mp) {
                f32x4 rv[2][2][2];
#pragma unroll
                for (int mm = 0; mm < 2; ++mm)
#pragma unroll
                    for (int bj = 0; bj < 2; ++bj)
#pragma unroll
                        for (int n = 0; n < 2; ++n) rv[mm][bj][n] = *(const f32x4*)(ri0 + (size_t)(ai * HALF + (2 * mp + mm) * 16) * DM + bj * HALF + n * 16);
#pragma unroll
                for (int mm = 0; mm < 2; ++mm)
#pragma unroll
                    for (int bj = 0; bj < 2; ++bj)
#pragma unroll
                        for (int n = 0; n < 2; ++n) *(f32x4*)(ro0 + (size_t)(ai * HALF + (2 * mp + mm) * 16) * DM + bj * HALF + n * 16) = rv[mm][bj][n] + gv[bj][n] * acc[ai][bj][2 * mp + mm][n];
                asm volatile("" ::: "memory");
            }
    }
};
struct EpiAbIn {
    static constexpr bool PERM = false, AFTER_DRAIN = false;
    bf16_t* P; const float* cosT; const float* sinT; float* ssq;
    __device__ __forceinline__ void operator()(const f32x4 (&acc)[2][2][4][2], const Unit& u, int wr, int wc, int fr, int fq) const {
#pragma unroll
        for (int ai = 0; ai < 2; ++ai)
#pragma unroll
            for (int m = 0; m < 4; ++m) {
                const int row = u.pm * BM + ai * HALF + wr * 64 + m * 16 + fr;
                const bool isx = row < TX; const int t = row & 2047, prow = t >> 6, pcol = t & 63;
                float sq = 0.f;
#pragma unroll
                for (int bj = 0; bj < 2; ++bj) {
                    const int cb = u.pn * BM + bj * HALF + wc * 32;
                    if (cb >= 1984) continue;
                    f32x4 v0 = acc[ai][bj][m][0], v1 = acc[ai][bj][m][1];
                    if (cb >= 1536 && cb < 1920) sq += (v0[0] * v0[0] + v0[1] * v0[1]) + (v0[2] * v0[2] + v0[3] * v0[3]) + (v1[0] * v1[0] + v1[1] * v1[1]) + (v1[2] * v1[2] + v1[3] * v1[3]);
                    if (isx && (cb < 1024 || cb >= 1920)) {
                        const int pos = ((cb >> 5) & 1) ? pcol : prow;
                        const f32x4 cs = *(const f32x4*)(cosT + pos * 16 + 4 * fq), sn = *(const f32x4*)(sinT + pos * 16 + 4 * fq);
                        const f32x4 o0 = v0 * cs - v1 * sn, o1 = v1 * cs + v0 * sn; v0 = o0; v1 = o1;
                    }
                    u32x2 w0, w1; w0.x = cvtpk(v0[0], v0[1]); w0.y = cvtpk(v0[2], v0[3]); w1.x = cvtpk(v1[0], v1[1]); w1.y = cvtpk(v1[2], v1[3]);
                    bf16_t* dst = P + (size_t)row * P0W + cb + 4 * fq;
                    *(u32x2*)dst = w0; *(u32x2*)(dst + 16) = w1;
                }
                if (u.pn >= 6) {
                    sq += __shfl_xor(sq, 16); sq += __shfl_xor(sq, 32);
                    if (fq == 0) atomicAdd(ssq + (size_t)row * 2 + (u.pn - 6), sq);
                }
                asm volatile("" ::: "memory");
            }
    }
};
struct EpiMlaUp {
    static constexpr bool PERM = false, AFTER_DRAIN = false;
    bf16_t* O; const float* ssq;
    __device__ __forceinline__ void operator()(const f32x4 (&acc)[2][2][4][2], const Unit& u, int wr, int wc, int fr, int fq) const {
        const bool kv = u.pn >= 3;
#pragma unroll
        for (int ai = 0; ai < 2; ++ai)
#pragma unroll
            for (int m = 0; m < 4; ++m) {
                const int row = u.pm * BM + ai * HALF + wr * 64 + m * 16 + fr;
                float s = 1.f;
                if (kv) s = rsqrtf(ssq[(size_t)row * 2 + 1] * (1.f / 128.f) + EPS);
#pragma unroll
                for (int bj = 0; bj < 2; ++bj)
#pragma unroll
                    for (int n = 0; n < 2; ++n) {
                        const int c = u.pn * BM + bj * HALF + wc * 32 + n * 16 + 4 * fq;
                        const f32x4 v = acc[ai][bj][m][n] * s; u32x2 w; w.x = cvtpk(v[0], v[1]); w.y = cvtpk(v[2], v[3]);
                        *(u32x2*)(O + (size_t)row * QKW + c) = w;
                    }
                asm volatile("" ::: "memory");
            }
    }
};
struct EpiStore {
    static constexpr bool PERM = false, AFTER_DRAIN = false;
    bf16_t* O; int ldc, ncols;
    __device__ __forceinline__ void operator()(const f32x4 (&acc)[2][2][4][2], const Unit& u, int wr, int wc, int fr, int fq) const {
#pragma unroll
        for (int ai = 0; ai < 2; ++ai)
#pragma unroll
            for (int m = 0; m < 4; ++m) {
                const int row = u.pm * BM + ai * HALF + wr * 64 + m * 16 + fr;
#pragma unroll
                for (int bj = 0; bj < 2; ++bj)
#pragma unroll
                    for (int n = 0; n < 2; ++n) {
                        const int c = u.pn * BM + bj * HALF + wc * 32 + n * 16 + 4 * fq;
                        if (c < ncols) { const f32x4 v = acc[ai][bj][m][n]; u32x2 w; w.x = cvtpk(v[0], v[1]); w.y = cvtpk(v[2], v[3]); *(u32x2*)(O + (size_t)row * ldc + c) = w; }
                    }
                asm volatile("" ::: "memory");
            }
    }
};
}

struct Params { const float* in[34]; float* out; unsigned char* ws; };
struct Fr {
    LAS unsigned char* lds; int tid, lane, wave, bid, G, wave0;
    const float* const* in; float* out; unsigned char* ws;
};
enum { I_X = 0, I_C, I_CTX, I_CCTX, I_WMOD, I_BMOD, I_GF1, I_WF1I, I_WF1O, I_GMIX, I_GF2, I_WF2I, I_WF2O, I_ABWIN, I_LQ1, I_LK1, I_LQ2, I_LK2, I_GSUB, I_GQ, I_WUQ, I_GKV,
       I_WUKV, I_ABWOUT, I_CDWIN, I_CONVW, I_CONVB, I_DTB, I_ALOG, I_DSKIP, I_GNORM, I_RPB, I_CDWOUT, I_GFINAL };

template <class Epi> DI void run_gemm(const Fr& F, const bf16_t* A, int lda, const bf16_t* Bt, int M, int N, int K, const Epi& E, int Gsub = 0, int pn_split = 0, int k0_lo = 0, int nt_lo = 0, int k0_hi = 0, int nt_hi = -1) {
    asm volatile("" : "+s"(K));
    if (nt_hi < 0) nt_hi = K / 64;
    asm volatile("" : "+s"(nt_hi), "+s"(nt_lo));
    pg8::Gemm g{A, Bt, M, N, K, lda, pn_split, k0_lo, nt_lo, k0_hi, nt_hi}; pg8::StaticOrder S; S.init(M, N, Gsub ? Gsub : F.G, F.bid);
    pg8::gemm_phase<Epi, pg8::StaticOrder, true, true>(F.lds, g, S, E, F.tid);
}

DI void mod_phase(const Fr& F) {
    LAS float* sc = (LAS float*)F.lds;
    LAS float* red = sc + 17 * 1024;
    const float* c = F.in[I_C]; const float* cc = F.in[I_CCTX];
    for (int i = F.tid; i < 17 * 1024; i += 512) { const int m = i >> 10, k = i & 1023; const float v = m < 16 ? c[m * 1024 + k] : cc[k]; sc[i] = v / (1.f + __expf(-v)); }
    __syncthreads();
    const float* wmod = F.in[I_WMOD]; const float* bmod = F.in[I_BMOD]; float* mod = (float*)(F.ws + WS_MOD);
    for (int item = F.bid; item < 288; item += F.G) {
        const int l = item / 144, n0 = (item % 144) * 64, kp = F.wave;
        const float* wp = wmod + (size_t)l * 1024 * 9216 + n0 + F.lane;
        float acc[17];
#pragma unroll
        for (int m = 0; m < 17; ++m) acc[m] = 0.f;
#pragma unroll 4
        for (int k = kp * 128; k < kp * 128 + 128; k += 4) {
            const float w0 = wp[(size_t)k * 9216], w1 = wp[(size_t)(k + 1) * 9216], w2 = wp[(size_t)(k + 2) * 9216], w3 = wp[(size_t)(k + 3) * 9216];
#pragma unroll
            for (int m = 0; m < 17; ++m) { const f32x4 s = *(const LAS f32x4*)(sc + m * 1024 + k); acc[m] += (w0 * s[0] + w1 * s[1]) + (w2 * s[2] + w3 * s[3]); }
        }
#pragma unroll
        for (int m = 0; m < 17; ++m) red[(kp * 17 + m) * 64 + F.lane] = acc[m];
        __syncthreads();
        for (int i = F.tid; i < 17 * 64; i += 512) {
            const int m = i >> 6, cl = i & 63; float s = 0.f;
#pragma unroll
            for (int q = 0; q < 8; ++q) s += red[(q * 17 + m) * 64 + cl];
            mod[(size_t)(l * 17 + m) * 9216 + n0 + cl] = s + bmod[l * 9216 + n0 + cl];
        }
        __syncthreads();
    }
}
DI int maprow(int mode, int n0) {
    if (mode == 1) { const int up = n0 >= FF, j = up ? n0 - FF : n0; return (j >> 7) * 256 + (up ? 128 : 0) + (j & 127); }
    if (mode == 2) {
        if (n0 < 1024) return n0; if (n0 < 3072) return n0 - 1024 + C1_XBC; if (n0 < 3104) return n0 - 3072 + C1_DT;
        if (n0 < 3616) return n0 - 3104 + C1_Q; if (n0 < 4128) return n0 - 3616 + C1_K; return n0 - 4128 + C1_V;
    }
    return n0;
}
DI void conv_job(const Fr& F, int& base, const float* W, int K, int N, bf16_t* dst, int ldk, int koff, int mode, int rowoff, const float* kscale, int vb = -1, int nvb = 0) {
    LAS float* scr = (LAS float*)(F.lds + F.wave * 8448);
    if (vb < 0) { vb = F.bid; nvb = F.G; }
    const int NGW = nvb * 8, gw = vb * 8 + F.wave, nblk = N / 32, nitems = (K / 64) * nblk, lane = F.lane;
    for (int it = ((gw - base) % NGW + NGW) % NGW; it < nitems; it += NGW) {
        const int kb = it / nblk, nb = it % nblk, k0 = 64 * kb, n0 = 32 * nb;
#pragma unroll
        for (int i = 0; i < 32; ++i) { const int kk = 2 * i + (lane >> 5); float v = W[(size_t)(k0 + kk) * N + n0 + (lane & 31)];
 if (kscale) v *= kscale[k0 + kk]; scr[kk * 33 + (lane & 31)] = v; }
        asm volatile("s_waitcnt lgkmcnt(0)" ::: "memory");
        const int c = lane & 7, dr0 = rowoff + maprow(mode, n0);
#pragma unroll
        for (int j = 0; j < 4; ++j) {
            const int n = (lane >> 3) + 8 * j; const LAS float* s = scr + (8 * c) * 33 + n;
            u32x4 o; o.x = cvtpk(s[0 * 33], s[1 * 33]); o.y = cvtpk(s[2 * 33], s[3 * 33]); o.z = cvtpk(s[4 * 33], s[5 * 33]); o.w = cvtpk(s[6 * 33], s[7 * 33]);
            *(u32x4*)(dst + (size_t)(dr0 + n) * ldk + koff + k0 + 8 * c) = o;
        }
        asm volatile("s_waitcnt lgkmcnt(0)" ::: "memory");
    }
    base = (base + nitems) % NGW;
}
DI void zero_rect(const Fr& F, unsigned char* base, size_t pitch, int nrows, int chunks_per_row) {
    const int n = nrows * chunks_per_row; const u32x4 z = {0u, 0u, 0u, 0u};
    for (int i = F.bid * 512 + F.tid; i < n; i += F.G * 512) { const int r = i / chunks_per_row, c = i % chunks_per_row; *(u32x4*)(base + (size_t)r * pitch + (size_t)c * 16) = z; }
}
DI void prep_phase(const Fr& F) {
    mod_phase(F);
    int base = 0; unsigned char* ws = F.ws;
    const size_t LIN = (size_t)DM * 2 * FF, LOUT = (size_t)FF * DM;
    conv_job(F, base, F.in[I_WF1I], DM, 2 * FF, (bf16_t*)(ws + W0_F1I), DM, 0, 1, 0, nullptr);
    conv_job(F, base, F.in[I_WF1O], FF, DM, (bf16_t*)(ws + W0_F1O), FF, 0, 0, 0, nullptr);
    conv_job(F, base, F.in[I_WF2I], DM, 2 * FF, (bf16_t*)(ws + W0_F2I), DM, 0, 1, 0, nullptr);
    conv_job(F, base, F.in[I_WF2O], FF, DM, (bf16_t*)(ws + W0_F2O), FF, 0, 0, 0, nullptr);
    conv_job(F, base, F.in[I_ABWIN], DM, 1984, (bf16_t*)(ws + W0_ABI), DM, 0, 0, 0, nullptr);
    conv_job(F, base, F.in[I_WUQ], 256, 768, (bf16_t*)(ws + W0_UP), 384, 0, 0, 0, F.in[I_GQ]);
    conv_job(F, base, F.in[I_WUKV], 128, 1024, (bf16_t*)(ws + W0_UP), 384, 256, 0, 768, F.in[I_GKV]);
    conv_job(F, base, F.in[I_ABWOUT], DM, DM, (bf16_t*)(ws + W0_ABO), DM, 0, 0, 0, nullptr);
    zero_rect(F, ws + W0_ABI + (size_t)1984 * 2048, 2048, 64, 128);
    zero_rect(F, ws + W0_UP + 512, 768, 768, 16);
    zero_rect(F, ws + W0_UP + (size_t)768 * 768, 768, 1024, 32);
    zero_rect(F, ws + WS_SSQ, (size_t)TT * 8, 1, TT * 8 / 16);
    if (F.bid == 0) {
        float* cosT = (float*)(ws + WS_ROPE); float* sinT = cosT + 1024;
        for (int i = F.tid; i < 1024; i += 512) {
            const int pos = i >> 4, fi = i & 15;
            const float freq = exp2f(-(float)fi * (13.287712379549449f / 16.f));
            const float ang = (float)pos * freq;
            const double tp = 6.283185307179586476925; const double n = __builtin_rint((double)ang / tp); const float r = (float)((double)ang - n * tp);
            cosT[i] = __cosf(r); sinT[i] = __sinf(r);
        }
    }
}
DI void conv_l1_part(const Fr& F, int part, int vb, int nvb) {
    int base = 0; unsigned char* ws = F.ws;
    const size_t LIN = (size_t)DM * 2 * FF, LOUT = (size_t)FF * DM;
    if (part == 0) {
        conv_job(F, base, F.in[I_WF1I] + LIN, DM, 2 * FF, (bf16_t*)(ws + W1_F1I), DM, 0, 1, 0, nullptr, vb, nvb);
        conv_job(F, base, F.in[I_WF1O] + LOUT, FF, DM, (bf16_t*)(ws + W1_F1O), FF, 0, 0, 0, nullptr, vb, nvb);
    } else if (part == 1) {
        conv_job(F, base, F.in[I_WF2I] + LIN, DM, 2 * FF, (bf16_t*)(ws + W1_F2I), DM, 0, 1, 0, nullptr, vb, nvb);
        conv_job(F, base, F.in[I_WF2O] + LOUT, FF, DM, (bf16_t*)(ws + W1_F2O), FF, 0, 0, 0, nullptr, vb, nvb);
    } else {
        conv_job(F, base, F.in[I_CDWIN], DM, 4640, (bf16_t*)(ws + W1_CDI), DM, 0, 2, 0, nullptr, vb, nvb);
        conv_job(F, base, F.in[I_CDWOUT], 1536, DM, (bf16_t*)(ws + W1_CDO), 1536, 0, 0, 0, nullptr, vb, nvb);
        const int n = 224 * 128; const u32x4 z = {0u, 0u, 0u, 0u};
        for (int i = vb * 512 + F.tid; i < n; i += nvb * 512) *(u32x4*)(ws + W1_CDI + (size_t)4640 * 2048 + (size_t)i * 16) = z;
    }
}
DI void norm_phase(const Fr& F, int layer, const float* g, int jshift, int rbeg, int nrows, const float* xin_x, const float* xin_c, bf16_t* H, int vb = -1, int nvb = 0) {
    const float* mod = (const float*)(F.ws + WS_MOD) + (size_t)layer * 17 * 9216;
    if (vb < 0) { vb = F.bid; nvb = F.G; }
    const int NGW = nvb * 8, lane = F.lane;
    f32x4 gv[4];
#pragma unroll
    for (int j = 0; j < 4; ++j) gv[j] = *(const f32x4*)(g + 4 * lane + 256 * j);
    for (int row0 = rbeg + vb * 8 + F.wave; row0 < nrows; row0 += 2 * NGW) {
        const int row1 = row0 + NGW < nrows ? row0 + NGW : row0;
        f32x4 v[2][4]; float s[2] = {0.f, 0.f};
#pragma unroll
        for (int q = 0; q < 2; ++q) { const int row = q ? row1 : row0;
            const float* xr = row < TX ? xin_x + (size_t)row * DM : xin_c + (size_t)(row - TX) * DM;
#pragma unroll
            for (int j = 0; j < 4; ++j) v[q][j] = *(const f32x4*)(xr + 4 * lane + 256 * j); }
#pragma unroll
        for (int q = 0; q < 2; ++q)
#pragma unroll
            for (int j = 0; j < 4; ++j) s[q] += (v[q][j][0] * v[q][j][0] + v[q][j][1] * v[q][j][1]) + (v[q][j][2] * v[q][j][2] + v[q][j][3] * v[q][j][3]);
#pragma unroll
        for (int q = 0; q < 2; ++q) { const int row = q ? row1 : row0;
            if (q && row1 == row0) break;
            const float* mp = mod + (size_t)(row < TX ? (row >> 11) : 16) * 9216 + jshift * 1024;
            const float rstd = rsqrtf(wave_sum(s[q]) * (1.f / DM) + EPS);
#pragma unroll
            for (int j = 0; j < 4; ++j) {
                const f32x4 sh = *(const f32x4*)(mp + 4 * lane + 256 * j), sc = *(const f32x4*)(mp + 1024 + 4 * lane + 256 * j);
                const f32x4 y = v[q][j] * rstd * gv[j] * (sc + 1.f) + sh;
                u32x2 w; w.x = cvtpk(y[0], y[1]); w.y = cvtpk(y[2], y[3]);
                *(u32x2*)(H + (size_t)row * DM + 4 * lane + 256 * j) = w;
            }
        }
    }
}
DI void final_norm_phase(const Fr& F, int nperturb) {
    const float* g = F.in[I_GFINAL]; const int NGW = F.G * 8, lane = F.lane;
    for (int row = F.bid * 8 + F.wave; row < TX; row += NGW) {
        float* xr = F.out + (size_t)row * DM; f32x4 v[4]; float s = 0.f;
#pragma unroll
        for (int j = 0; j < 4; ++j) { v[j] = *(const f32x4*)(xr + 4 * lane + 256 * j); s += (v[j][0] * v[j][0] + v[j][1] * v[j][1]) + (v[j][2] * v[j][2] + v[j][3] * v[j][3]); }
        const float rstd = rsqrtf(wave_sum(s) * (1.f / DM) + EPS);
#pragma unroll
        for (int j = 0; j < 4; ++j) { f32x4 y = v[j] * rstd * *(const f32x4*)(g + 4 * lane + 256 * j); if (row * DM + 4 * lane + 256 * j < nperturb) y += 0.05f; *(f32x4*)(xr + 4 * lane + 256 * j) = y; }
    }
}


struct KVSrc { const bf16_t* k1; int k1p, k1c; const bf16_t* k2; int k2p, k2c; const bf16_t* v; int vp, vc; };
constexpr int FL_K1 = 25600, FL_V0 = 51200, FL_VB = 17408, FL_VP = 272, FL_QR = 86016;

template <int DQK> DI void kv_load(const KVSrc& S, int rb, int tid, u32x4 (&kr)[DQK / 64], u32x4 (&vr)[2]) {
    constexpr int CPR = DQK / 8;
#pragma unroll
    for (int i = 0; i < DQK / 64; ++i) {
        const int id = tid + 512 * i, row = id / CPR, ch = id % CPR;
        const bf16_t* src = (DQK == 64 || ch < 16) ? S.k1 + (size_t)(rb + row) * S.k1p + S.k1c + ch * 8 : S.k2 + (size_t)(rb + row) * S.k2p + S.k2c + (ch - 16) * 8;
        kr[i] = *(const u32x4*)src;
    }
#pragma unroll
    for (int i = 0; i < 2; ++i) { const int id = tid + 512 * i, row = id >> 4, ch = id & 15; vr[i] = *(const u32x4*)(S.v + (size_t)(rb + row) * S.vp + S.vc + ch * 8); }
}
template <int DQK> DI void kv_store(LAS unsigned char* Kb, LAS unsigned char* Vb, int tid, const u32x4 (&kr)[DQK / 64], const u32x4 (&vr)[2]) {
    constexpr int CPR = DQK / 8, KP = DQK * 2 + 16;
#pragma unroll
    for (int i = 0; i < DQK / 64; ++i) { const int id = tid + 512 * i, row = id / CPR, ch = id % CPR; *(LAS u32x4*)(Kb + row * KP + ch * 16) = kr[i]; }
#pragma unroll
    for (int i = 0; i < 2; ++i) { const int id = tid + 512 * i, row = id >> 4, ch = id & 15; *(LAS u32x4*)(Vb + row * FL_VP + ch * 16) = vr[i]; }
}
template <int DQK, int NSR> DI void flash_run(const Fr& F, const KVSrc& S, const bf16x8 (&qf)[NSR], const LAS unsigned char* qlds, int nkt, int nxt, int xbase, int cbase, float sc2, f32x16 (&o)[4]) {
    constexpr int NS = DQK / 16, KP = DQK * 2 + 16;
    LAS unsigned char* lds = F.lds; const int tid = F.tid, lane = F.lane, r = lane & 31, h = lane >> 5;
    const int i16 = lane & 15, q4 = i16 >> 2, p4 = i16 & 3, blk = (lane >> 4) & 1;
    u32x4 kr[DQK / 64], vr[2];
    __syncthreads();
    kv_load<DQK>(S, nxt > 0 ? xbase : cbase, tid, kr, vr);
    kv_store<DQK>(lds, lds + FL_V0, tid, kr, vr);
    __syncthreads();
    float m = -1e30f, l = 0.f;
#pragma unroll
    for (int t = 0; t < 4; ++t) o[t] = zero16();
    for (int kt = 0; kt < nkt; ++kt) {
        const bool more = kt + 1 < nkt;
        if (more) { const int k1 = kt + 1; kv_load<DQK>(S, k1 < nxt ? xbase + 64 * k1 : cbase + 64 * (k1 - nxt), tid, kr, vr); }
        const LAS unsigned char* Kb = lds + (kt & 1) * FL_K1; const LAS unsigned char* Vb = lds + FL_V0 + (kt & 1) * FL_VB;
        f32x16 st[2];
#pragma unroll
        for (int ks = 0; ks < 2; ++ks) {
            f32x16 a = zero16();
#pragma unroll
            for (int s = 0; s < NS; ++s) { const bf16x8 kf = *(const LAS bf16x8*)(Kb + (ks * 32 + r) * KP + s * 32 + h * 16);
                bf16x8 qq; if (s < NSR) qq = qf[s < NSR ? s : 0]; else qq = *(const LAS bf16x8*)(qlds + (s - NSR) * 32);
                a = MFMA32(kf, qq, a);
                if (NS > 4 && (s & 3) == 3) asm volatile("" ::: "memory"); }
            st[ks] = a;
        }
        float mx = st[0][0];
#pragma unroll
        for (int i = 0; i < 16; ++i) { mx = fmaxf(mx, st[0][i]); mx = fmaxf(mx, st[1][i]); }
        mx *= sc2; mx = fmaxf(mx, __shfl_xor(mx, 32));
        const float mn = fmaxf(m, mx), alpha = ex2(m - mn); m = mn;
        float rs = 0.f;
#pragma unroll
        for (int ks = 0; ks < 2; ++ks)
#pragma unroll
            for (int i = 0; i < 16; ++i) { const float p = ex2(st[ks][i] * sc2 - mn); rs += p; st[ks][i] = p; }
        l = l * alpha + rs;
#pragma unroll
        for (int t = 0; t < 4; ++t) o[t] = o[t] * alpha;
#pragma unroll
        for (int ks = 0; ks < 2; ++ks)
#pragma unroll
            for (int s2 = 0; s2 < 2; ++s2) {
                const bf16x8 pf = pack8(st[ks][8 * s2], st[ks][8 * s2 + 1], st[ks][8 * s2 + 2], st[ks][8 * s2 + 3], st[ks][8 * s2 + 4], st[ks][8 * s2 + 5], st[ks][8 * s2 + 6], st[ks][8 * s2 + 7]);
                const LAS unsigned char* vb = Vb + (ks * 32 + 16 * s2 + 4 * h + q4) * FL_VP + (16 * blk + 4 * p4) * 2;
#pragma unroll
                for (int t = 0; t < 4; ++t) { const s16x4 lo = trread(vb + t * 64), hi = trread(vb + t * 64 + 8 * FL_VP); o[t] = MFMA32(cat8(lo, hi), pf, o[t]); }
                if (DQK > 64) asm volatile("" ::: "memory");
            }
        if (more) kv_store<DQK>(lds + ((kt + 1) & 1) * FL_K1, lds + FL_V0 + ((kt + 1) & 1) * FL_VB, tid, kr, vr);
        __syncthreads();
    }
    l += __shfl_xor(l, 32);
    const float inv = 1.f / l;
#pragma unroll
    for (int t = 0; t < 4; ++t) o[t] = o[t] * inv;
}

DI void attn0_phase(const Fr& F) {
    const bf16_t* P = (const bf16_t*)(F.ws + WS_P0); const bf16_t* QK = (const bf16_t*)(F.ws + WS_QKV);
    bf16_t* CAT = (bf16_t*)(F.ws + WS_H); bf16_t* ODS = (bf16_t*)(F.ws + WS_ODS);
    const int lane = F.lane, r = lane & 31, h = lane >> 5;
    float lam;
    {
        const float d1 = wave_sum(F.in[I_LQ1][lane] * F.in[I_LK1][lane]), d2 = wave_sum(F.in[I_LQ2][lane] * F.in[I_LK2][lane]);
        lam = __expf(d1) - __expf(d2) + 0.2f;
    }
    const float* gsub = F.in[I_GSUB];
    const float* cosT = (const float*)(F.ws + WS_ROPE); const float* sinT = cosT + 1024; const float* ssq = (const float*)(F.ws + WS_SSQ);
    for (int it = F.bid; it < 1152; it += F.G) {
        int type, b, qb, hd;
        if (it < 512) { type = 0; b = it >> 5; qb = (it >> 2) & 7; hd = it & 3; }
        else if (it < 1024) { type = 1; const int j = it - 512; b = j >> 5; qb = (j >> 2) & 7; hd = j & 3; }
        else if (it < 1088) { type = 2; const int j = it - 1024; b = j >> 2; qb = 0; hd = j & 3; }
        else { type = 3; const int j = it - 1088; b = j >> 2; qb = 0; hd = j & 3; }
        const bool xq = type < 2;
        const int row = (xq ? b * SEQ + qb * 256 : TX + b * CTXL) + F.wave * 32 + r;
        const int nkt = xq ? 36 : 4, nxt = xq ? 32 : 0, xbase = b * SEQ, cbase = TX + b * CTXL;
        f32x16 o[4];
        if ((type & 1) == 0) {
            KVSrc S{QK, QKW, 768 + hd * 256, P, P0W, 1920, QK, QKW, 768 + hd * 256 + 128};
            bf16x8 qf[8];
            const bf16_t* qptr = QK + (size_t)row * QKW + hd * 192;
#pragma unroll
            for (int s = 0; s < 8; ++s) qf[s] = *(const bf16x8*)(qptr + 16 * s + 8 * h);
            LAS unsigned char* qlds = F.lds + FL_QR + F.wave * 4608 + r * 144 + h * 16;
            {
                const int t = row & 2047; int hr = h; asm volatile("" : "+v"(hr));
#pragma unroll
                for (int grp = 0; grp < 2; ++grp) {
                    const int pos = grp ? (t & 63) : (t >> 6);
                    const bf16x8 x1 = *(const bf16x8*)(qptr + 128 + 32 * grp + 8 * h), x2 = *(const bf16x8*)(qptr + 144 + 32 * grp + 8 * h);
                    bf16x8 y1 = x1, y2 = x2;
                    if (xq) {
                        const f32x4 c0 = *(const f32x4*)(cosT + pos * 16 + 8 * hr), c1 = *(const f32x4*)(cosT + pos * 16 + 8 * hr + 4), s0 = *(const f32x4*)(sinT + pos * 16 + 8 * hr), s1 = *(const f32x4*)(sinT + pos * 16 + 8 * hr + 4);
                        float a[8], bq[8];
#pragma unroll
                        for (int j = 0; j < 8; ++j) { const float u1 = bf2f((unsigned short)x1[j]), u2 = bf2f((unsigned short)x2[j]), cv = j < 4 ? c0[j & 3] : c1[j & 3], sv = j < 4 ? s0[j & 3] : s1[j & 3];
                            a[j] = u1 * cv - u2 * sv; bq[j] = u2 * cv + u1 * sv; }
                        y1 = pack8(a[0], a[1], a[2], a[3], a[4], a[5], a[6], a[7]); y2 = pack8(bq[0], bq[1], bq[2], bq[3], bq[4], bq[5], bq[6], bq[7]);
                    }
                    *(LAS bf16x8*)(qlds + (2 * grp) * 32) = y1; *(LAS bf16x8*)(qlds + (2 * grp + 1) * 32) = y2;
                }
            }
            const float rq = rsqrtf(ssq[(size_t)row * 2] * (1.f / 256.f) + EPS);
            flash_run<192, 8>(F, S, qf, qlds, nkt, nxt, xbase, cbase, 0.07216878364870322f * LOG2E * rq, o);
            { int hq = h, rowq = row; asm volatile("" : "+v"(hq), "+v"(rowq));
#pragma unroll
            for (int t = 0; t < 4; ++t)
#pragma unroll
                for (int g = 0; g < 4; ++g) { u32x2 w; w.x = cvtpk(o[t][4 * g], o[t][4 * g + 1]); w.y = cvtpk(o[t][4 * g + 2], o[t][4 * g + 3]);
                    *(u32x2*)(CAT + (size_t)rowq * DM + 512 + hd * 128 + t * 32 + 8 * g + 4 * hq) = w; } }
        } else {
            for (int c = 0; c < 2; ++c) {
                KVSrc S{P, P0W, 512 + hd * 128 + c * 64, nullptr, 0, 0, P, P0W, 1024 + hd * 128};
                bf16x8 qf[4];
                { const bf16_t* qptr = P + (size_t)row * P0W + hd * 128 + c * 64;
#pragma unroll
                  for (int s = 0; s < 4; ++s) qf[s] = *(const bf16x8*)(qptr + 16 * s + 8 * h); }
                flash_run<64, 4>(F, S, qf, nullptr, nkt, nxt, xbase, cbase, 0.125f * LOG2E, o);
                int hq = h, rowq = row; asm volatile("" : "+v"(hq), "+v"(rowq));
                bf16_t* sp = ODS + (size_t)rowq * 512 + hd * 128 + 4 * hq;
                if (c == 0) {
#pragma unroll
                    for (int t = 0; t < 4; ++t)
#pragma unroll
                        for (int g = 0; g < 4; ++g) { u32x2 w; w.x = cvtpk(o[t][4 * g], o[t][4 * g + 1]); w.y = cvtpk(o[t][4 * g + 2], o[t][4 * g + 3]); *(u32x2*)(sp + t * 32 + 8 * g) = w; }
                } else {
                    float ss = 0.f;
#pragma unroll
                    for (int t = 0; t < 4; ++t)
#pragma unroll
                        for (int g = 0; g < 4; ++g) { const u32x2 w = *(const u32x2*)(sp + t * 32 + 8 * g);
                            const float a0 = bflo(w.x) - lam * o[t][4 * g], a1 = bfhi(w.x) - lam * o[t][4 * g + 1], a2 = bflo(w.y) - lam * o[t][4 * g + 2], a3 = bfhi(w.y) - lam * o[t][4 * g + 3];
                            o[t][4 * g] = a0; o[t][4 * g + 1] = a1; o[t][4 * g + 2] = a2; o[t][4 * g + 3] = a3; ss += (a0 * a0 + a1 * a1) + (a2 * a2 + a3 * a3); }
                    ss += __shfl_xor(ss, 32);
                    const float rstd = rsqrtf(ss * (1.f / 128.f) + EPS) * 0.8f;
#pragma unroll
                    for (int t = 0; t < 4; ++t)
#pragma unroll
                        for (int g = 0; g < 4; ++g) { const f32x4 gg = *(const f32x4*)(gsub + t * 32 + 8 * g + 4 * hq); u32x2 w;
                            w.x = cvtpk(o[t][4 * g] * rstd * gg[0], o[t][4 * g + 1] * rstd * gg[1]); w.y = cvtpk(o[t][4 * g + 2] * rstd * gg[2], o[t][4 * g + 3] * rstd * gg[3]);
                            *(u32x2*)(CAT + (size_t)rowq * DM + hd * 128 + t * 32 + 8 * g + 4 * hq) = w; }
                }
            }
        }
    }
}

constexpr int NA_KP = 528, NA_BUF = 64 * NA_KP, NA_V0 = 2 * NA_BUF, NA_RPB = 4 * NA_BUF;
DI void na_load(const bf16_t* P1, int rb, int kcol, int vcol, int tid, u32x4 (&kr)[4], u32x4 (&vr)[4]) {
#pragma unroll
    for (int i = 0; i < 4; ++i) { const int id = tid + 512 * i, row = id >> 5, ch = id & 31; const bf16_t* base = P1 + (size_t)(rb + row) * P1W + ch * 8;
        kr[i] = *(const u32x4*)(base + kcol); vr[i] = *(const u32x4*)(base + vcol); }
}
DI void na_store(LAS unsigned char* Kb, LAS unsigned char* Vb, int tid, const u32x4 (&kr)[4], const u32x4 (&vr)[4]) {
#pragma unroll
    for (int i = 0; i < 4; ++i) { const int id = tid + 512 * i, row = id >> 5, ch = id & 31; *(LAS u32x4*)(Kb + row * NA_KP + ch * 16) = kr[i]; *(LAS u32x4*)(Vb + row * NA_KP + ch * 16) = vr[i]; }
}
DI void na_item(const Fr& F, int b, int gr, int hg) {
    bf16_t* P1 = (bf16_t*)(F.ws + WS_P1);
    LAS unsigned char* lds = F.lds; const int tid = F.tid, lane = F.lane, r = lane & 31, h = lane >> 5;
    const int i16 = lane & 15, q4 = i16 >> 2, p4 = i16 & 3, blk = (lane >> 4) & 1;
    const int hl = F.wave & 3, qs = F.wave >> 2, head = hg * 4 + hl, qc = qs * 32 + r;
    const int row = b * SEQ + gr * 64 + qc;
    const int r0 = min(max(gr - 4, 0), 24), c0 = min(max(qc - 8, 0), 48);
    const int kcol = C1_K + hg * 256, vcol = C1_V + hg * 256;
    bf16_t* qptr = P1 + (size_t)row * P1W + C1_Q + head * 64;
    bf16x8 qf[4];
#pragma unroll
    for (int s = 0; s < 4; ++s) qf[s] = *(const bf16x8*)(qptr + 16 * s + 8 * h);
    u32x4 kr[4], vr[4];
    __syncthreads();
    LAS float* rpbs = (LAS float*)(lds + NA_RPB);
    { const float* rpb = F.in[I_RPB] + (size_t)hg * 4 * 465; for (int i = tid; i < 4 * 465; i += 512) rpbs[i] = rpb[i]; }
    na_load(P1, b * SEQ + r0 * 64, kcol, vcol, tid, kr, vr);
    na_store(lds, lds + NA_V0, tid, kr, vr);
    __syncthreads();
    float m = -1e30f, l = 0.f; f32x16 o[2]; o[0] = zero16(); o[1] = zero16();
    const float sc2 = 0.125f * LOG2E;
    for (int kt = 0; kt < 12; ++kt) {
        const bool more = kt + 1 < 12;
        if (more) { const int k1 = kt + 1; na_load(P1, k1 < 8 ? b * SEQ + (r0 + k1) * 64 : TX + b * CTXL + (k1 - 8) * 64, kcol, vcol, tid, kr, vr); }
        const LAS unsigned char* Kb = lds + (kt & 1) * NA_BUF + hl * 128; const LAS unsigned char* Vb = lds + NA_V0 + (kt & 1) * NA_BUF + hl * 128;
        f32x16 st[2];
#pragma unroll
        for (int ks = 0; ks < 2; ++ks) {
            f32x16 a = zero16();
#pragma unroll
            for (int s = 0; s < 4; ++s) { const bf16x8 kf = *(const LAS bf16x8*)(Kb + (ks * 32 + r) * NA_KP + s * 32 + h * 16); a = MFMA32(kf, qf[s], a); }
            st[ks] = a;
        }
        if (kt < 8) {
            const LAS float* bp = rpbs + (hl * 15 + (r0 + kt - gr + 7)) * 31 + 15 - qc;
#pragma unroll
            for (int ks = 0; ks < 2; ++ks)
#pragma unroll
                for (int i = 0; i < 16; ++i) { const int kc = ks * 32 + crow(i, h); const bool ok = kc >= c0 && kc < c0 + 16;
                    const float bias = ok ? bp[kc] : 0.f; st[ks][i] = ok ? (st[ks][i] * sc2 + bias * LOG2E) : -1e30f; }
        } else {
#pragma unroll
            for (int ks = 0; ks < 2; ++ks)
#pragma unroll
                for (int i = 0; i < 16; ++i) st[ks][i] = st[ks][i] * sc2;
        }
        float mx = st[0][0];
#pragma unroll
        for (int i = 0; i < 16; ++i) { mx = fmaxf(mx, st[0][i]); mx = fmaxf(mx, st[1][i]); }
        mx = fmaxf(mx, __shfl_xor(mx, 32));
        const float mn = fmaxf(m, mx), alpha = ex2(m - mn); m = mn;
        float rs = 0.f;
#pragma unroll
        for (int ks = 0; ks < 2; ++ks)
#pragma unroll
            for (int i = 0; i < 16; ++i) { const float p = ex2(st[ks][i] - mn); rs += p; st[ks][i] = p; }
        l = l * alpha + rs; o[0] = o[0] * alpha; o[1] = o[1] * alpha;
#pragma unroll
        for (int ks = 0; ks < 2; ++ks)
#pragma unroll
            for (int s2 = 0; s2 < 2; ++s2) {
                const bf16x8 pf = pack8(st[ks][8 * s2], st[ks][8 * s2 + 1], st[ks][8 * s2 + 2], st[ks][8 * s2 + 3], st[ks][8 * s2 + 4], st[ks][8 * s2 + 5], st[ks][8 * s2 + 6], st[ks][8 * s2 + 7]);
                const LAS unsigned char* vb = Vb + (ks * 32 + 16 * s2 + 4 * h + q4) * NA_KP + (16 * blk + 4 * p4) * 2;
#pragma unroll
                for (int t = 0; t < 2; ++t) { const s16x4 lo = trread(vb + t * 64), hi = trread(vb + t * 64 + 8 * NA_KP); o[t] = MFMA32(cat8(lo, hi), pf, o[t]); }
            }
        if (more) na_store(lds + ((kt + 1) & 1) * NA_BUF, lds + NA_V0 + ((kt + 1) & 1) * NA_BUF, tid, kr, vr);
        __syncthreads();
    }
    l += __shfl_xor(l, 32);
    const float inv = 1.f / l;
#pragma unroll
    for (int t = 0; t < 2; ++t)
#pragma unroll
        for (int g = 0; g < 4; ++g) { u32x2 w; w.x = cvtpk(o[t][4 * g] * inv, o[t][4 * g + 1] * inv); w.y = cvtpk(o[t][4 * g + 2] * inv, o[t][4 * g + 3] * inv);
            *(u32x2*)(qptr + t * 32 + 8 * g + 4 * h) = w; }
}

constexpr int NB_KP = 144, NB_KBUF = 128 * NB_KP, NB_V0 = 2 * NB_KBUF, NB_RPB = 4 * NB_KBUF;
DI void na_item2(const Fr& F, int b, int head, int gq) {
    bf16_t* P1 = (bf16_t*)(F.ws + WS_P1);
    LAS unsigned char* lds = F.lds; const int tid = F.tid, lane = F.lane, r = lane & 31, h = lane >> 5;
    const int i16 = lane & 15, q4 = i16 >> 2, p4 = i16 & 3, blk = (lane >> 4) & 1;
    const int grw = gq * 4 + (F.wave >> 1), qc = (F.wave & 1) * 32 + r;
    const int row = b * SEQ + grw * 64 + qc;
    const int r0w = min(max(grw - 4, 0), 24), c0 = min(max(qc - 8, 0), 48);
    const int rlo = min(max(gq * 4 - 4, 0), 24), rhi = min(max(gq * 4 - 1, 0), 24) + 7;
    const int nl2 = (rhi - rlo + 2) >> 1, nst = nl2 + 2;
    const int kcol = C1_K + head * 64, vcol = C1_V + head * 64;
    bf16_t* qptr = P1 + (size_t)row * P1W + C1_Q + head * 64;
    bf16x8 qf[4];
#pragma unroll
    for (int s = 0; s < 4; ++s) qf[s] = *(const bf16x8*)(qptr + 16 * s + 8 * h);
    u32x4 kr[2], vr[2];
    __syncthreads();
    LAS float* rpbs = (LAS float*)(lds + NB_RPB);
    { const float* rpb = F.in[I_RPB] + (size_t)head * 465; if (tid < 465) rpbs[tid] = rpb[tid]; }
#define NB_BASE(s_, u_) ((s_) < nl2 ? b * SEQ + min(rlo + 2 * (s_) + (u_), rhi) * 64 : TX + b * CTXL + (2 * ((s_) - nl2) + (u_)) * 64)
#define NB_LOAD(s_) do { _Pragma("unroll") for (int i = 0; i < 2; ++i) { const int id = tid + 512 * i, krow = id >> 3, ch = id & 7; \
        const bf16_t* base = P1 + (size_t)(NB_BASE(s_, krow >> 6) + (krow & 63)) * P1W + ch * 8; kr[i] = *(const u32x4*)(base + kcol); vr[i] = *(const u32x4*)(base + vcol); } } while (0)
#define NB_STORE(buf_) do { _Pragma("unroll") for (int i = 0; i < 2; ++i) { const int id = tid + 512 * i, krow = id >> 3, ch = id & 7; \
        *(LAS u32x4*)(lds + (buf_) * NB_KBUF + krow * NB_KP + ch * 16) = kr[i]; *(LAS u32x4*)(lds + NB_V0 + (buf_) * NB_KBUF + krow * NB_KP + ch * 16) = vr[i]; } } while (0)
    NB_LOAD(0); NB_STORE(0);
    __syncthreads();
    float m = -1e30f, l = 0.f; f32x16 o[2]; o[0] = zero16(); o[1] = zero16();
    const float sc2 = 0.125f * LOG2E;
    for (int st_ = 0; st_ < nst; ++st_) {
        const bool more = st_ + 1 < nst;
        if (more) NB_LOAD(st_ + 1);
        for (int u = 0; u < 2; ++u) {
            const bool lat = st_ < nl2; const int R = rlo + 2 * st_ + u;
            if (lat && (R > rhi || R < r0w || R >= r0w + 8)) continue;
            const LAS unsigned char* Kb = lds + (st_ & 1) * NB_KBUF + u * 64 * NB_KP; const LAS unsigned char* Vb = lds + NB_V0 + (st_ & 1) * NB_KBUF + u * 64 * NB_KP;
            f32x16 st[2];
#pragma unroll
            for (int ks = 0; ks < 2; ++ks) {
                f32x16 a = zero16();
#pragma unroll
                for (int s = 0; s < 4; ++s) { const bf16x8 kf = *(const LAS bf16x8*)(Kb + (ks * 32 + r) * NB_KP + s * 32 + h * 16); a = MFMA32(kf, qf[s], a); }
                st[ks] = a;
            }
            if (lat) {
                const LAS float* bp = rpbs + (R - grw + 7) * 31 + 15 - qc;
#pragma unroll
                for (int ks = 0; ks < 2; ++ks)
#pragma unroll
                    for (int i = 0; i < 16; ++i) { const int kc = ks * 32 + crow(i, h); const bool ok = (unsigned)(kc - c0) < 16u;
                        const float bias = ok ? bp[kc] : 0.f; st[ks][i] = ok ? (st[ks][i] * sc2 + bias * LOG2E) : -1e30f; }
            } else {
#pragma unroll
                for (int ks = 0; ks < 2; ++ks)
#pragma unroll
                    for (int i = 0; i < 16; ++i) st[ks][i] = st[ks][i] * sc2;
            }
            float mx = st[0][0];
#pragma unroll
            for (int i = 0; i < 16; ++i) { mx = fmaxf(mx, st[0][i]); mx = fmaxf(mx, st[1][i]); }
            mx = fmaxf(mx, __shfl_xor(mx, 32));
            const float mn = fmaxf(m, mx), alpha = ex2(m - mn); m = mn;
            float rs = 0.f;
#pragma unroll
            for (int ks = 0; ks < 2; ++ks)
#pragma unroll
                for (int i = 0; i < 16; ++i) { const float p = ex2(st[ks][i] - mn); rs += p; st[ks][i] = p; }
            l = l * alpha + rs; o[0] = o[0] * alpha; o[1] = o[1] * alpha;
#pragma unroll
            for (int ks = 0; ks < 2; ++ks)
#pragma unroll
                for (int s2 = 0; s2 < 2; ++s2) {
                    const bf16x8 pf = pack8(st[ks][8 * s2], st[ks][8 * s2 + 1], st[ks][8 * s2 + 2], st[ks][8 * s2 + 3], st[ks][8 * s2 + 4], st[ks][8 * s2 + 5], st[ks][8 * s2 + 6], st[ks][8 * s2 + 7]);
                    const LAS unsigned char* vb = Vb + (ks * 32 + 16 * s2 + 4 * h + q4) * NB_KP + (16 * blk + 4 * p4) * 2;
#pragma unroll
                    for (int t = 0; t < 2; ++t) { const s16x4 lo = trread(vb + t * 64), hi = trread(vb + t * 64 + 8 * NB_KP); o[t] = MFMA32(cat8(lo, hi), pf, o[t]); }
                }
        }
        if (more) NB_STORE((st_ + 1) & 1);
        __syncthreads();
    }
#undef NB_BASE
#undef NB_LOAD
#undef NB_STORE
    l += __shfl_xor(l, 32);
    const float inv = 1.f / l;
#pragma unroll
    for (int t = 0; t < 2; ++t)
#pragma unroll
        for (int g = 0; g < 4; ++g) { u32x2 w; w.x = cvtpk(o[t][4 * g] * inv, o[t][4 * g + 1] * inv); w.y = cvtpk(o[t][4 * g + 2] * inv, o[t][4 * g + 3] * inv);
            *(u32x2*)(qptr + t * 32 + 8 * g + 4 * h) = w; }
}


constexpr int SS_XP = 144, SS_BP = 272;
constexpr int SS_X = 0, SS_B = 18432, SS_C = 53248, SS_H = 88064, SS_HB = 17408  , SS_DT = 122880, SS_ACS = 123392, SS_SW = 123904;
DI void halo1_phase(const Fr& F) {
    const bf16_t* P1 = (const bf16_t*)(F.ws + WS_P1); bf16_t* HL = (bf16_t*)(F.ws + WS_HALO);
    const int n = 288 * 4 * 256, stride = F.G * 512, i0 = F.bid * 512 + F.tid;
    for (int ib = i0; ib < n; ib += 4 * stride) {
        u32x4 v[4];
#pragma unroll
        for (int q = 0; q < 4; ++q) {
            const int i = ib + q * stride; v[q] = (u32x4){0u, 0u, 0u, 0u};
            if (i < n) {
                const int c = i >> 10, w = (i >> 8) & 3, ch = i & 255;
                const bool isx = c < 256; const int cc = isx ? (c & 15) : ((c - 256) & 1), nch = isx ? 16 : 2;
                const bool valid = w < 2 ? cc > 0 : cc < nch - 1;
                const int row = c * 128 + (w < 2 ? w - 2 : 126 + w);
                if (valid) v[q] = *(const u32x4*)(P1 + (size_t)row * P1W + C1_XBC + ch * 8);
            }
        }
#pragma unroll
        for (int q = 0; q < 4; ++q) {
            const int i = ib + q * stride;
            if (i < n) { const int c = i >> 10, w = (i >> 8) & 3, ch = i & 255; *(u32x4*)(HL + ((size_t)(c * 4 + w) * 2048 + ch * 8)) = v[q]; }
        }
    }
}
DI void conv1_load(const bf16_t* P1, const bf16_t* HL, int it, int rb, int cgp, u32x4 (&raw)[12]) {
    const int c = it >> 3, ch0 = (it & 7) * 256 + cgp * 8;
#pragma unroll
    for (int k = 0; k < 12; ++k) {
        const int l = rb * 8 - 2 + k;
        const bf16_t* src = (l >= 0 && l < 128) ? P1 + (size_t)(c * 128 + l) * P1W + C1_XBC + ch0 : HL + (size_t)(c * 4 + (l < 0 ? l + 2 : l - 126)) * 2048 + ch0;
        raw[k] = *(const u32x4*)src;
    }
}
DI void conv1_phase(const Fr& F) {
    bf16_t* P1 = (bf16_t*)(F.ws + WS_P1); const bf16_t* HL = (const bf16_t*)(F.ws + WS_HALO);
    const float* cw = F.in[I_CONVW]; const float* cb = F.in[I_CONVB];
    const int rb = F.tid >> 5, cgp = F.tid & 31;
    u32x4 raw[12], rawn[12];
    if (F.bid < 288 * 8) conv1_load(P1, HL, F.bid, rb, cgp, raw);
    for (int it = F.bid; it < 288 * 8; it += F.G) {
        const int c = it >> 3, ch0 = (it & 7) * 256 + cgp * 8;
        const bool more = it + F.G < 288 * 8;
        if (more) conv1_load(P1, HL, it + F.G, rb, cgp, rawn);
        f32x4 w[5][2], bb[2];
#pragma unroll
        for (int j = 0; j < 5; ++j) { w[j][0] = *(const f32x4*)(cw + j * 2048 + ch0); w[j][1] = *(const f32x4*)(cw + j * 2048 + ch0 + 4); }
        bb[0] = *(const f32x4*)(cb + ch0); bb[1] = *(const f32x4*)(cb + ch0 + 4);
        u32x4 ov[8];
#pragma unroll
        for (int i = 0; i < 8; ++i) {
            f32x4 a0 = bb[0], a1 = bb[1];
#pragma unroll
            for (int j = 0; j < 5; ++j) { const u32x4 q = raw[i + j];
                a0 += w[j][0] * (f32x4){bflo(q.x), bfhi(q.x), bflo(q.y), bfhi(q.y)}; a1 += w[j][1] * (f32x4){bflo(q.z), bfhi(q.z), bflo(q.w), bfhi(q.w)}; }
            ov[i].x = cvtpk(siluf(a0[0]), siluf(a0[1])); ov[i].y = cvtpk(siluf(a0[2]), siluf(a0[3])); ov[i].z = cvtpk(siluf(a1[0]), siluf(a1[1])); ov[i].w = cvtpk(siluf(a1[2]), siluf(a1[3]));
        }
        __syncthreads();
#pragma unroll
        for (int i = 0; i < 8; ++i) *(u32x4*)(P1 + (size_t)(c * 128 + rb * 8 + i) * P1W + C1_XBC + ch0) = ov[i];
        if (more) {
#pragma unroll
            for (int k = 0; k < 12; ++k) raw[k] = rawn[k];
        }
    }
}
DI void scan1_pre(const Fr& F) {
    const bf16_t* P1 = (const bf16_t*)(F.ws + WS_P1); float* SC = (float*)(F.ws + WS_SCAN);
    const int NGW = F.G * 8, lane = F.lane;
    for (int rec = F.bid * 8 + F.wave; rec < 16 * 2 * 16 * 18; rec += NGW) {
        const int ci = rec % 18, hd = (rec / 18) & 15, d = (rec / (18 * 16)) & 1, b = rec / (18 * 32);
        const bool isx = ci >= 2; const int cc = isx ? ci - 2 : ci, nch = isx ? 16 : 2;
        const int row0 = (isx ? b * SEQ : TX + b * CTXL) + (d ? nch - 1 - cc : cc) * 128;
        const float a = -__expf(F.in[I_ALOG][d * 16 + hd]), dtb = F.in[I_DTB][d * 16 + hd];
        float dt[2];
#pragma unroll
        for (int q = 0; q < 2; ++q) { const int l = 2 * lane + q; const float xr = bf2f(P1[(size_t)(row0 + (d ? 127 - l : l)) * P1W + C1_DT + d * 16 + hd]) + dtb; dt[q] = xr > 20.f ? xr : log1pf(__expf(xr)); }
        const float v0 = a * dt[0], v1 = a * dt[1]; float ps = v0 + v1;
#pragma unroll
        for (int off = 1; off < 64; off <<= 1) { const float t = __shfl_up(ps, off); if (lane >= off) ps += t; }
        const float tot = __shfl(ps, 63), c0 = ps - v1, c1 = ps;
        float* rp = SC + (size_t)rec * 384 + 2 * lane;
        *(f32x2*)rp = (f32x2){dt[0], dt[1]}; *(f32x2*)(rp + 128) = (f32x2){c0, c1}; *(f32x2*)(rp + 256) = (f32x2){dt[0] * __expf(tot - c0), dt[1] * __expf(tot - c1)};
    }
}
DI void ssd_load(const bf16_t* P1, const float* SC, int b, int hd, int g, int st, int tid, u32x4 (&pf)[10], float& scv) {
    const int d = st >= 18, ci = d ? st - 18 : st; const bool isx = ci >= 2; const int cc = isx ? ci - 2 : ci, nch = isx ? 16 : 2;
    const int row0 = (isx ? b * SEQ : TX + b * CTXL) + (d ? nch - 1 - cc : cc) * 128;
#pragma unroll
    for (int i = 0; i < 10; ++i) {
        const int id = tid + 512 * i; int row, col;
        if (i < 2) { row = id >> 3; col = hd * 64 + (id & 7) * 8; }
        else if (i < 6) { const int j = id - 1024; row = j >> 4; col = 1024 + g * 128 + (j & 15) * 8; }
        else { const int j = id - 3072; row = j >> 4; col = 1536 + g * 128 + (j & 15) * 8; }
        pf[i] = *(const u32x4*)(P1 + (size_t)(row0 + row) * P1W + C1_XBC + col);
    }
    if (tid < 384) scv = SC[(size_t)((((b * 2 + d) * 16 + hd) * 18) + ci) * 384 + tid];
}
#ifndef LDS_BAR
#define LDS_BAR() do { asm volatile("s_waitcnt lgkmcnt(0)" ::: "memory"); __builtin_amdgcn_s_barrier(); asm volatile("" ::: "memory"); } while (0)
#endif
DI void ssd_item(const Fr& F, int b, int hd) {
    const bf16_t* P1 = (const bf16_t*)(F.ws + WS_P1); bf16_t* Y = (bf16_t*)(F.ws + WS_H);
    LAS unsigned char* lds = F.lds; const int tid = F.tid, lane = F.lane, wave = F.wave, r = lane & 31, h = lane >> 5;
    const int i16 = lane & 15, q4 = i16 >> 2, p4 = i16 & 3, blk = (lane >> 4) & 1;
    const int g = hd >> 2, pt = wave >> 2, lt = wave < 4 ? wave : 7 - wave;
    LAS float* dtv = (LAS float*)(lds + SS_DT); LAS float* acs = (LAS float*)(lds + SS_ACS); LAS float* sw = (LAS float*)(lds + SS_SW);
    const float* SC = (const float*)(F.ws + WS_SCAN);
    u32x4 pf[10]; float scv = 0.f;
    __syncthreads();
    ssd_load(P1, SC, b, hd, g, 0, tid, pf, scv);
    float Dsk = 0.f; f32x16 hreg = zero16();
    for (int st = 0; st < 36; ++st) {
        const int d = st >= 18, ci = d ? st - 18 : st;
        const bool isx = ci >= 2; const int cc = isx ? ci - 2 : ci, nch = isx ? 16 : 2;
        const int tokbase = (d ? nch - 1 - cc : cc) * 128;
        if (ci == 0) asm volatile("s_waitcnt vmcnt(0)" ::: "memory");
        LDS_BAR();
        if (ci == 0) {
            Dsk = F.in[I_DSKIP][d * 16 + hd];
            hreg = zero16();
            for (int i = tid; i < 64 * SS_BP / 4; i += 512) ((LAS unsigned*)(lds + SS_H + (st & 1) * SS_HB))[i] = 0u;
        }
#pragma unroll
        for (int i = 0; i < 10; ++i) {
            const int id = tid + 512 * i; int row; LAS unsigned char* dst;
            if (i < 2) { row = id >> 3; dst = lds + SS_X + (id & 7) * 16 + (d ? 127 - row : row) * SS_XP; }
            else if (i < 6) { const int j = id - 1024; row = j >> 4; dst = lds + SS_B + (j & 15) * 16 + (d ? 127 - row : row) * SS_BP; }
            else { const int j = id - 3072; row = j >> 4; dst = lds + SS_C + (j & 15) * 16 + (d ? 127 - row : row) * SS_BP; }
            *(LAS u32x4*)dst = pf[i];
        }
        if (tid < 384) dtv[tid] = scv;
        LDS_BAR();
        if (st + 1 < 36) ssd_load(P1, SC, b, hd, g, st + 1, tid, pf, scv);
        float el; const float dtot = __expf(acs[127]);
        asm volatile("s_waitcnt lgkmcnt(0)" ::: "memory");
        if (isx) {
            const int lcol = lt * 32 + r; const float al = acs[lcol]; el = __expf(al);
            const int tok = tokbase + (d ? 127 - lcol : lcol);
            bf16_t* yp = Y + (size_t)(b * SEQ + tok) * DM + hd * 64 + pt * 32 + 4 * h;
            unsigned long long yold[4] = {0ull, 0ull, 0ull, 0ull};
            if (d) {
#pragma unroll
                for (int gq = 0; gq < 4; ++gq) yold[gq] = __hip_atomic_load((unsigned long long*)(yp + 8 * gq), __ATOMIC_RELAXED, __HIP_MEMORY_SCOPE_AGENT);
            }
            f32x16 yacc = zero16();
            for (int stl = 0; stl <= lt; ++stl) {
                f32x16 sa = zero16();
#pragma unroll
                for (int kk = 0; kk < 8; ++kk) {
                    const bf16x8 af = *(const LAS bf16x8*)(lds + SS_B + (stl * 32 + r) * SS_BP + kk * 32 + h * 16);
                    const bf16x8 bf = *(const LAS bf16x8*)(lds + SS_C + lcol * SS_BP + kk * 32 + h * 16);
                    sa = MFMA32(af, bf, sa);
                }
#pragma unroll
                for (int gq = 0; gq < 4; ++gq) {
                    const int s0 = stl * 32 + 8 * gq + 4 * h;
                    const f32x4 a4 = *(const LAS f32x4*)(acs + s0), d4 = *(const LAS f32x4*)(dtv + s0);
#pragma unroll
                    for (int j = 0; j < 4; ++j) { const float e = fexp(fminf(al - a4[j], 0.f)) * d4[j]; sa[4 * gq + j] = (s0 + j <= lcol) ? sa[4 * gq + j] * e : 0.f; }
                }
#pragma unroll
                for (int s2 = 0; s2 < 2; ++s2) {
                    const bf16x8 gf = pack8(sa[8 * s2], sa[8 * s2 + 1], sa[8 * s2 + 2], sa[8 * s2 + 3], sa[8 * s2 + 4], sa[8 * s2 + 5], sa[8 * s2 + 6], sa[8 * s2 + 7]);
                    const LAS unsigned char* xb = lds + SS_X + (stl * 32 + 16 * s2 + 4 * h + q4) * SS_XP + (pt * 32 + 16 * blk + 4 * p4) * 2;
                    const s16x4 lo = trread(xb), hi = trread(xb + 8 * SS_XP);
                    yacc = MFMA32(cat8(lo, hi), gf, yacc);
                }
            }
            f32x16 oa = zero16();
#pragma unroll
            for (int kk = 0; kk < 8; ++kk) {
                const bf16x8 af = *(const LAS bf16x8*)(lds + SS_H + (st & 1) * SS_HB + (pt * 32 + r) * SS_BP + kk * 32 + h * 16);
                const bf16x8 bf = *(const LAS bf16x8*)(lds + SS_C + lcol * SS_BP + kk * 32 + h * 16);
                oa = MFMA32(af, bf, oa);
            }
#pragma unroll
            for (int gq = 0; gq < 4; ++gq) {
                const u32x2 xw = *(const LAS u32x2*)(lds + SS_X + lcol * SS_XP + (pt * 32 + 8 * gq + 4 * h) * 2);
                float y0 = yacc[4 * gq] + el * oa[4 * gq] + Dsk * bflo(xw.x), y1 = yacc[4 * gq + 1] + el * oa[4 * gq + 1] + Dsk * bfhi(xw.x);
                float y2 = yacc[4 * gq + 2] + el * oa[4 * gq + 2] + Dsk * bflo(xw.y), y3 = yacc[4 * gq + 3] + el * oa[4 * gq + 3] + Dsk * bfhi(xw.y);
                unsigned long long* gp = (unsigned long long*)(yp + 8 * gq);
                if (d) { const unsigned long long old = yold[gq]; const unsigned lo = (unsigned)old, hi = (unsigned)(old >> 32);
                    y0 += bflo(lo); y1 += bfhi(lo); y2 += bflo(hi); y3 += bfhi(hi); }
                *gp = (unsigned long long)cvtpk(y0, y1) | ((unsigned long long)cvtpk(y2, y3) << 32);
            }
        }
        {
            f32x16 ha = hreg * dtot;
#pragma unroll
            for (int kk = 0; kk < 8; ++kk) {
                const int k0 = 16 * kk + 8 * h;
                const LAS unsigned char* xb = lds + SS_X + (k0 + q4) * SS_XP + (pt * 32 + 16 * blk + 4 * p4) * 2;
                const s16x4 xl = trread(xb), xh = trread(xb + 4 * SS_XP);
                const f32x4 w0 = *(const LAS f32x4*)(sw + k0), w1 = *(const LAS f32x4*)(sw + k0 + 4);
                const bf16x8 af = pack8(bf2f((unsigned short)xl[0]) * w0[0], bf2f((unsigned short)xl[1]) * w0[1], bf2f((unsigned short)xl[2]) * w0[2], bf2f((unsigned short)xl[3]) * w0[3],
                                        bf2f((unsigned short)xh[0]) * w1[0], bf2f((unsigned short)xh[1]) * w1[1], bf2f((unsigned short)xh[2]) * w1[2], bf2f((unsigned short)xh[3]) * w1[3]);
                const LAS unsigned char* bb = lds + SS_B + (k0 + q4) * SS_BP + (lt * 32 + 16 * blk + 4 * p4) * 2;
                const s16x4 bl = trread(bb), bh = trread(bb + 4 * SS_BP);
                ha = MFMA32(af, cat8(bl, bh), ha);
            }
            hreg = ha;
#pragma unroll
            for (int i = 0; i < 16; ++i) *(LAS unsigned short*)(lds + SS_H + ((st + 1) & 1) * SS_HB + (pt * 32 + crow(i, h)) * SS_BP + (lt * 32 + r) * 2) = (unsigned short)(cvtpk(ha[i], 0.f) & 0xffffu);
        }
    }
}
DI void mix1_phase(const Fr& F) {
    for (int it = F.bid; it < 256; it += F.G) ssd_item(F, it >> 4, it & 15);
#if defined(EXPM) && (EXPM & 4)
    for (int it = F.bid; it < 256; it += F.G) ssd_item(F, it >> 4, it & 15);
#endif
    Fr F2 = F; asm volatile("" : "+v"(F2.lane), "+v"(F2.tid));
    for (int it = F2.bid; it < 1024; it += F2.G) na_item2(F2, it >> 6, (it >> 3) & 7, it & 7);
}
DI void merge1_phase(const Fr& F) {
    bf16_t* P1 = (bf16_t*)(F.ws + WS_P1); const bf16_t* Y = (const bf16_t*)(F.ws + WS_H); const float* gn = F.in[I_GNORM];
    const int NGW = F.G * 8, lane = F.lane;
    f32x4 gv[4];
#pragma unroll
    for (int j = 0; j < 4; ++j) gv[j] = *(const f32x4*)(gn + 16 * lane + 4 * j);
    for (int row0 = F.bid * 8 + F.wave; row0 < TX; row0 += 2 * NGW) {
        const int row1 = row0 + NGW < TX ? row0 + NGW : row0;
        u32x4 zq[2][2], yq[2][2];
#pragma unroll
        for (int q = 0; q < 2; ++q) { const int row = q ? row1 : row0; const bf16_t* zp = P1 + (size_t)row * P1W + 16 * lane; const bf16_t* yp = Y + (size_t)row * DM + 16 * lane;
            zq[q][0] = *(const u32x4*)zp; zq[q][1] = *(const u32x4*)(zp + 8); yq[q][0] = *(const u32x4*)yp; yq[q][1] = *(const u32x4*)(yp + 8); }
#pragma unroll
        for (int q = 0; q < 2; ++q) {
            if (q && row1 == row0) break;
            const int row = q ? row1 : row0; bf16_t* zp = P1 + (size_t)row * P1W + 16 * lane;
            const unsigned zz[8] = {zq[q][0].x, zq[q][0].y, zq[q][0].z, zq[q][0].w, zq[q][1].x, zq[q][1].y, zq[q][1].z, zq[q][1].w};
            const unsigned yy[8] = {yq[q][0].x, yq[q][0].y, yq[q][0].z, yq[q][0].w, yq[q][1].x, yq[q][1].y, yq[q][1].z, yq[q][1].w};
            float v[16]; float s = 0.f;
#pragma unroll
            for (int i = 0; i < 8; ++i) { v[2 * i] = bflo(yy[i]) * siluf(bflo(zz[i])); v[2 * i + 1] = bfhi(yy[i]) * siluf(bfhi(zz[i])); s += v[2 * i] * v[2 * i] + v[2 * i + 1] * v[2 * i + 1]; }
            s += __shfl_xor(s, 1); s += __shfl_xor(s, 2); s += __shfl_xor(s, 4); s += __shfl_xor(s, 8);
            const float rstd = rsqrtf(s * (1.f / 256.f) + EPS);
            u32x4 o0, o1;
            o0.x = cvtpk(v[0] * rstd * gv[0][0], v[1] * rstd * gv[0][1]); o0.y = cvtpk(v[2] * rstd * gv[0][2], v[3] * rstd * gv[0][3]);
            o0.z = cvtpk(v[4] * rstd * gv[1][0], v[5] * rstd * gv[1][1]); o0.w = cvtpk(v[6] * rstd * gv[1][2], v[7] * rstd * gv[1][3]);
            o1.x = cvtpk(v[8] * rstd * gv[2][0], v[9] * rstd * gv[2][1]); o1.y = cvtpk(v[10] * rstd * gv[2][2], v[11] * rstd * gv[2][3]);
            o1.z = cvtpk(v[12] * rstd * gv[3][0], v[13] * rstd * gv[3][1]); o1.w = cvtpk(v[14] * rstd * gv[3][2], v[15] * rstd * gv[3][3]);
            *(u32x4*)zp = o0; *(u32x4*)(zp + 8) = o1;
        }
    }
}

#define XB_TMO      128
#define XB_XCNT(j)  (256  + 64 * (j))
#define XB_XSUB(j)  (1280 + 64 * (j))
#define XB_XGEN(j)  (2304 + 64 * (j))
#define XB_TOP      3328
#define XB_TOPGEN   3392
#define XCD_BAR_WORDS 3456
#define XB_SPIN_CAP (1u << 18)

__device__ __forceinline__ unsigned xb_ld(unsigned* p)              { return __hip_atomic_load(p, __ATOMIC_RELAXED, __HIP_MEMORY_SCOPE_AGENT); }
__device__ __forceinline__ unsigned xb_add(unsigned* p, unsigned v) { return __hip_atomic_fetch_add(p, v, __ATOMIC_RELAXED, __HIP_MEMORY_SCOPE_AGENT); }
__device__ __forceinline__ unsigned xb_xcc_id() { return (unsigned)__builtin_amdgcn_s_getreg((3 << 11) | 20) & 0xFu; }
#define XB_SPIN(cond, bar) do { unsigned _sp = 0; while (cond) { __builtin_amdgcn_s_sleep(1); \
    if ((++_sp & 255u) == 0u) { if (xb_ld(&(bar)[XB_TMO])) break; if (_sp > XB_SPIN_CAP) { atomicAdd(&(bar)[XB_TMO], 1u); break; } } } } while (0)

struct XcdBarrier {
    unsigned* bar; unsigned x;
    volatile LAS unsigned* st;
};

__device__ __forceinline__ XcdBarrier xcd_barrier_post(unsigned* bar, volatile LAS unsigned* st, int tid) {
    XcdBarrier b; b.bar = bar; b.x = xb_xcc_id(); b.st = st;
    if (tid == 0) (void)xb_add(&bar[XB_XCNT(b.x)], 1u);
    return b;
}
__device__ __forceinline__ void xcd_barrier_complete(unsigned* bar, unsigned x, unsigned& nloc, unsigned& nx) {
    const unsigned G = gridDim.x * gridDim.y * gridDim.z;
    unsigned sum, cnt, mine, sp = 0u;
    for (;;) {
        sum = 0u; cnt = 0u; mine = 0u;
#pragma unroll
        for (unsigned j = 0; j < 16; ++j) { const unsigned c = xb_ld(&bar[XB_XCNT(j)]); sum += c; cnt += (c > 0u) ? 1u : 0u; mine = (j == x) ? c : mine; }
        if (sum == G) break;
        __builtin_amdgcn_s_sleep(1);
        if ((++sp & 255u) == 0u) { if (xb_ld(&bar[XB_TMO])) break; if (sp > XB_SPIN_CAP) { atomicAdd(&bar[XB_TMO], 1u); break; } }
    }
    nloc = mine > 0u ? mine : 1u; nx = cnt > 0u ? cnt : 1u;
}

__device__ __forceinline__ void xcd_barrier(const XcdBarrier& b, int tid) {
    asm volatile("s_waitcnt vmcnt(0)" ::: "memory");
    __syncthreads();
    if (tid == 0) {
        unsigned* bar = b.bar;
        __builtin_amdgcn_s_waitcnt(0);
        unsigned nloc = b.st[0], nx = b.st[1];
        if (nloc == 0u) { xcd_barrier_complete(bar, b.x, nloc, nx); b.st[0] = nloc; b.st[1] = nx; }
        const unsigned old = xb_add(&bar[XB_XSUB(b.x)], 1u);
        const unsigned gen = old / nloc;
        if (old + 1u == (gen + 1u) * nloc) {
            __builtin_amdgcn_fence(__ATOMIC_RELEASE, "agent");
            asm volatile("s_waitcnt vmcnt(0)" ::: "memory");
            const unsigned og = xb_add(&bar[XB_TOP], 1u);
            const unsigned tg = og / nx;
            if (og + 1u == (tg + 1u) * nx) xb_add(&bar[XB_TOPGEN], 1u);
            else XB_SPIN(xb_ld(&bar[XB_TOPGEN]) == tg, bar);
            __builtin_amdgcn_fence(__ATOMIC_ACQUIRE, "agent");
            xb_add(&bar[XB_XGEN(b.x)], 1u);
            asm volatile("s_waitcnt vmcnt(0)" ::: "memory");
        } else {
            XB_SPIN(xb_ld(&bar[XB_XGEN(b.x)]) == gen, bar);
            __builtin_amdgcn_fence(__ATOMIC_ACQUIRE, "agent");
            asm volatile("s_waitcnt vmcnt(0)" ::: "memory");
        }
    }
    __syncthreads();
}

DI void refresh(Fr& F, const Params& prm) {
    int wv = F.wave0; asm volatile("" : "+s"(wv));
    int ln = lane_id(); asm volatile("" : "+v"(ln));
    F.wave = wv; F.lane = ln; F.tid = wv * 64 + ln;
    unsigned char* w = prm.ws; asm volatile("" : "+s"(w)); F.ws = w;
    int g_ = gridDim.x; asm volatile("" : "+s"(g_)); F.G = g_;
    float* o = prm.out; asm volatile("" : "+s"(o)); F.out = o;
}
__global__ void __launch_bounds__(512, 2) mega_fwd(Params prm) {
    extern __shared__ __attribute__((aligned(16))) unsigned char lds_raw[];
    cg::grid_group grid = cg::this_grid();
    Fr F; F.lds = (LAS unsigned char*)lds_raw; F.bid = blockIdx.x; F.G = gridDim.x; F.in = prm.in;
    F.wave0 = __builtin_amdgcn_readfirstlane((int)threadIdx.x >> 6);
    refresh(F, prm);
#define WB(off) ((const bf16_t*)(F.ws + (off)))
#define WP(off) ((bf16_t*)(F.ws + (off)))
#define MOD(l, j) ((const float*)(F.ws + WS_MOD) + (size_t)(l) * 17 * 9216 + (j) * 1024)
#define COST ((const float*)(F.ws + WS_ROPE))
#define SSQ ((float*)(F.ws + WS_SSQ))
#define CRES ((float*)(F.ws + WS_CTXRES))
    volatile LAS unsigned* xst = (volatile LAS unsigned*)(F.lds + LDS_BYTES - 16);
    if (F.tid < 4) xst[F.tid] = 0u;
    __syncthreads();
    (void)xcd_barrier_post((unsigned*)(prm.ws + WS_BAR), xst, F.tid);
#define XBAR() do { XcdBarrier xb_; xb_.bar = (unsigned*)(F.ws + WS_BAR); xb_.x = xb_xcc_id(); xb_.st = (volatile LAS unsigned*)(F.lds + LDS_BYTES - 16); xcd_barrier(xb_, lane_id() + 64 * F.wave0); } while (0)
#ifndef EXPM
#define EXPM 0
#endif
#ifdef TPROBE_A
#define SYNC() do { XBAR(); refresh(F, prm); if (F.bid == 0 && F.tid == 0) { ((unsigned long long*)(F.ws + WS_STAMP))[nstamp] = __builtin_amdgcn_s_memrealtime(); } ++nstamp; } while (0)
    int nstamp = 1;
#else
#define SYNC() do { XBAR(); refresh(F, prm); } while (0)
#endif
#ifdef TPROBE_A
    if (F.bid == 0 && F.tid == 0) ((unsigned long long*)(F.ws + WS_STAMP))[40] = __builtin_amdgcn_s_memrealtime();
#endif
#define RES_GEMM_NORM(A_, lda_, W_, K_, rinx_, rinc_, gate_, gs_, lyr_, gn_, jn_) do { \
        run_gemm(F, A_, lda_, W_, TX, DM, K_, pg8::EpiRes{rinx_, rinc_, F.out, CRES, gate_, gs_, 0}); SYNC(); \
        if (F.bid < 64) run_gemm(F, (A_) + (size_t)TX * (lda_), lda_, W_, TC, DM, K_, pg8::EpiRes{rinx_, rinc_, F.out, CRES, gate_, gs_, TX}, 64); \
        else norm_phase(F, lyr_, gn_, jn_, 0, TX, F.out, CRES, WP(WS_H), F.bid - 64, F.G - 64); \
        SYNC(); \
        norm_phase(F, lyr_, gn_, jn_, TX, TT, F.out, CRES, WP(WS_H)); SYNC(); } while (0)
    prep_phase(F); grid.sync(); refresh(F, prm);
#ifdef TPROBE_A
    if (F.bid == 0 && F.tid == 0) ((unsigned long long*)(F.ws + WS_STAMP))[0] = __builtin_amdgcn_s_memrealtime();
#endif
    norm_phase(F, 0, F.in[I_GF1], 0, 0, TT, F.in[I_X], F.in[I_CTX], WP(WS_H)); SYNC();
    run_gemm(F, WB(WS_H), DM, WB(W0_F1I), TT, 2 * FF, DM, pg8::EpiSwiglu{WP(WS_ACT)});
    if (F.G == 256 && F.bid >= 96) conv_l1_part(F, 0, F.bid - 96, 160); else if (F.G != 256) conv_l1_part(F, 0, F.bid, F.G);
    SYNC();
    RES_GEMM_NORM(WB(WS_ACT), FF, WB(W0_F1O), FF, F.in[I_X], F.in[I_CTX], MOD(0, 2), 0.5f, 0, F.in[I_GMIX], 3);
    run_gemm(F, WB(WS_H), DM, WB(W0_ABI), TT, 2048, DM, pg8::EpiAbIn{WP(WS_P0), COST, COST + 1024, SSQ});
    if (F.G == 256 && F.bid >= 128) conv_l1_part(F, 2, F.bid - 128, 128); else if (F.G != 256) conv_l1_part(F, 2, F.bid, F.G);
    SYNC();
    run_gemm(F, WB(WS_P0) + 1536, P0W, WB(W0_UP), TT, QKW, 384, pg8::EpiMlaUp{WP(WS_QKV), SSQ}, 0, 3, 0, 4, 256, 2); SYNC();
#ifndef ATTN_REP
#define ATTN_REP 1
#endif
    attn0_phase(F); SYNC();
    RES_GEMM_NORM(WB(WS_H), DM, WB(W0_ABO), DM, F.out, CRES, MOD(0, 5), 1.f, 0, F.in[I_GF2], 6);
    run_gemm(F, WB(WS_H), DM, WB(W0_F2I), TT, 2 * FF, DM, pg8::EpiSwiglu{WP(WS_ACT)});
    if (F.G == 256 && F.bid >= 96) conv_l1_part(F, 1, F.bid - 96, 160); else if (F.G != 256) conv_l1_part(F, 1, F.bid, F.G);
    SYNC();
    RES_GEMM_NORM(WB(WS_ACT), FF, WB(W0_F2O), FF, F.out, CRES, MOD(0, 8), 0.5f, 1, F.in[I_GF1] + DM, 0);
    run_gemm(F, WB(WS_H), DM, WB(W1_F1I), TT, 2 * FF, DM, pg8::EpiSwiglu{WP(WS_ACT)}); SYNC();
    RES_GEMM_NORM(WB(WS_ACT), FF, WB(W1_F1O), FF, F.out, CRES, MOD(1, 2), 0.5f, 1, F.in[I_GMIX] + DM, 3);
    run_gemm(F, WB(WS_H), DM, WB(W1_CDI), TT, 4864, DM, pg8::EpiStore{WP(WS_P1), P1W, P1W}); SYNC();
    halo1_phase(F); scan1_pre(F); SYNC();
    conv1_phase(F); SYNC();
    mix1_phase(F); SYNC();
    merge1_phase(F); SYNC();
    run_gemm(F, WB(WS_P1), P1W, WB(W1_CDO), TX, DM, 1536, pg8::EpiRes{F.out, CRES, F.out, CRES, MOD(1, 5), 1.f, 0}); SYNC();
    norm_phase(F, 1, F.in[I_GF2] + DM, 6, 0, TX, F.out, CRES, WP(WS_H)); SYNC();
    run_gemm(F, WB(WS_H), DM, WB(W1_F2I), TX, 2 * FF, DM, pg8::EpiSwiglu{WP(WS_ACT)}); SYNC();
    run_gemm(F, WB(WS_ACT), FF, WB(W1_F2O), TX, DM, FF, pg8::EpiRes{F.out, CRES, F.out, CRES, MOD(1, 8), 0.5f, 0}); SYNC();
#ifdef TPROBE_A
    final_norm_phase(F, (int)(((const unsigned long long*)(F.ws + WS_STAMP))[TPROBE_B] - ((const unsigned long long*)(F.ws + WS_STAMP))[TPROBE_A]));
#else
    final_norm_phase(F, 0);
#endif
}

extern "C" void kernel_launch(void* const* d_in, const int* in_sizes, int n_in, void* d_out, int out_size, void* d_ws, size_t ws_size, hipStream_t stream) {
    static int grid = 0;
    if (grid == 0) {
        int dev = 0, cus = 0, per_cu = 0;
        (void)hipGetDevice(&dev); (void)hipDeviceGetAttribute(&cus, hipDeviceAttributeMultiprocessorCount, dev);
        if (hipFuncSetAttribute((const void*)mega_fwd, hipFuncAttributeMaxDynamicSharedMemorySize, LDS_BYTES) != hipSuccess) fprintf(stderr, "kernel_launch: hipFuncSetAttribute failed\n");
        if (hipOccupancyMaxActiveBlocksPerMultiprocessor(&per_cu, (const void*)mega_fwd, 512, LDS_BYTES) != hipSuccess || per_cu < 1) { fprintf(stderr, "kernel_launch: occupancy query gave %d\n", per_cu); per_cu = 1; }
        (void)hipGetLastError();
        if (cus <= 0) cus = 256;
        grid = cus * per_cu;
        if (n_in != 34 || ws_size < WS_END) fprintf(stderr, "kernel_launch: unexpected n_in %d / ws_size %zu (need %zu)\n", n_in, ws_size, (size_t)WS_END);
    }
    Params p{};
    for (int i = 0; i < 34; ++i) p.in[i] = (const float*)d_in[i];
    p.out = (float*)d_out; p.ws = (unsigned char*)d_ws;
    (void)hipMemsetAsync((unsigned char*)d_ws + WS_BAR, 0, 16384, stream);
    void* args[] = {&p};
    hipError_t e = hipLaunchCooperativeKernel((const void*)mega_fwd, dim3(grid), dim3(512), args, LDS_BYTES, stream);
    if (e != hipSuccess) fprintf(stderr, "cooperative launch failed: %s (grid %d)\n", hipGetErrorString(e), grid);
}
```

```cpp
#include <hip/hip_runtime.h>
#include <hip/hip_cooperative_groups.h>
#include <cstdio>
#include <cstdint>
namespace cg = cooperative_groups;

#define DI __device__ __forceinline__
#define LAS __attribute__((address_space(3)))
typedef short bf16x8 __attribute__((ext_vector_type(8)));
typedef short s16x4 __attribute__((ext_vector_type(4)));
typedef float f32x2 __attribute__((ext_vector_type(2)));
typedef float f32x4 __attribute__((ext_vector_type(4)));
typedef float f32x16 __attribute__((ext_vector_type(16)));
typedef unsigned u32x2 __attribute__((ext_vector_type(2)));
typedef unsigned u32x4 __attribute__((ext_vector_type(4)));
typedef __bf16 bf16x2_t __attribute__((ext_vector_type(2)));
typedef unsigned short bf16_t;

constexpr int DM = 1024, NB = 16, SEQ = 2048, CTXL = 256, FF = 2816;
constexpr int TX = NB * SEQ;
constexpr int TC = NB * CTXL;
constexpr int TT = TX + TC;
constexpr float EPS = 1e-6f;
constexpr float LOG2E = 1.4426950408889634f;
constexpr int P0W = 2048;
constexpr int QKW = 1792;
constexpr int P1W = 4640;
constexpr int C1_Q = 1024, C1_K = 1536, C1_V = 2048, C1_XBC = 2560, C1_DT = 4608;

constexpr size_t MiB = 1u << 20;
constexpr size_t WS_MOD = 0;
constexpr size_t WS_ROPE = 2 * MiB;
constexpr size_t WS_SSQ = 2 * MiB + 65536;
constexpr size_t WS_BAR = 2 * MiB + 512 * 1024;
constexpr size_t WS_STAMP = 2 * MiB + 768 * 1024;
constexpr size_t WS_SCAN = 3 * MiB;
constexpr size_t WS_W0 = 3 * MiB;
constexpr size_t W_FFN_IN = (size_t)2 * FF * DM * 2;
constexpr size_t W_FFN_OUT = (size_t)DM * FF * 2;
constexpr size_t W0_F1I = WS_W0, W0_F1O = W0_F1I + W_FFN_IN, W0_F2I = W0_F1O + W_FFN_OUT, W0_F2O = W0_F2I + W_FFN_IN;
constexpr size_t W0_ABI = W0_F2O + W_FFN_OUT;
constexpr size_t W0_UP = W0_ABI + (size_t)2048 * 1024 * 2;
constexpr size_t W0_ABO = W0_UP + (size_t)1536 * 1024;
constexpr size_t WS_W1 = 44 * MiB;
constexpr size_t W1_F1I = WS_W1, W1_F1O = W1_F1I + W_FFN_IN, W1_F2I = W1_F1O + W_FFN_OUT, W1_F2O = W1_F2I + W_FFN_IN;
constexpr size_t W1_CDI = W1_F2O + W_FFN_OUT;
constexpr size_t W1_CDO = W1_CDI + (size_t)4864 * 1024 * 2;
constexpr size_t WS_CTXRES = 90 * MiB;
constexpr size_t WS_H = 106 * MiB;
constexpr size_t WS_BIG = 178 * MiB;
constexpr size_t WS_ACT = WS_BIG;
constexpr size_t WS_P0 = WS_BIG;
constexpr size_t WS_QKV = WS_BIG + 144 * MiB;
constexpr size_t WS_ODS = WS_BIG + 270 * MiB;
constexpr size_t WS_P1 = WS_BIG;
constexpr size_t WS_HALO = WS_BIG + 327 * MiB;
constexpr size_t WS_END = WS_HALO + 5 * MiB;

constexpr int LDS_BYTES = 147456;

DI float bf2f(unsigned short b) { return __uint_as_float((unsigned)b << 16); }
DI float bflo(unsigned w) { return __uint_as_float(w << 16); }
DI float bfhi(unsigned w) { return __uint_as_float(w & 0xffff0000u); }
DI unsigned cvtpk(float lo, float hi) { f32x2 v = {lo, hi}; bf16x2_t b = __builtin_convertvector(v, bf16x2_t); return __builtin_bit_cast(unsigned, b); }
DI float ex2(float x) { return __builtin_amdgcn_exp2f(x); }
DI float fexp(float x) { return __builtin_amdgcn_exp2f(x * LOG2E); }
DI float frcp(float x) { return __builtin_amdgcn_rcpf(x); }
DI float siluf(float x) { return x * frcp(1.f + fexp(-x)); }
DI float wave_sum(float v) {
#pragma unroll
    for (int o = 1; o < 64; o <<= 1) v += __shfl_xor(v, o);
    return v;
}
DI int crow(int reg, int h) { return (reg & 3) + 8 * (reg >> 2) + 4 * h; }
#define MFMA32(a, b, c) __builtin_amdgcn_mfma_f32_32x32x16_bf16((a), (b), (c), 0, 0, 0)
typedef short v4i16_t __attribute__((ext_vector_type(4)));
DI s16x4 trread(const LAS unsigned char* p) { return __builtin_bit_cast(s16x4, __builtin_amdgcn_ds_read_tr16_b64_v4i16((LAS v4i16_t*)p)); }
DI bf16x8 cat8(s16x4 lo, s16x4 hi) { return __builtin_shufflevector(lo, hi, 0, 1, 2, 3, 4, 5, 6, 7); }
DI bf16x8 pack8(float a0, float a1, float a2, float a3, float a4, float a5, float a6, float a7) {
    u32x4 p; p.x = cvtpk(a0, a1); p.y = cvtpk(a2, a3); p.z = cvtpk(a4, a5); p.w = cvtpk(a6, a7); return __builtin_bit_cast(bf16x8, p);
}
DI f32x16 zero16() { f32x16 z;
#pragma unroll
    for (int i = 0; i < 16; ++i) z[i] = 0.f;
    return z; }
DI int lane_id() { unsigned ones = ~0u; asm volatile("" : "+s"(ones)); return (int)__builtin_amdgcn_mbcnt_hi(ones, __builtin_amdgcn_mbcnt_lo(ones, 0u)); }

namespace pg8 {
#define PG8_LAS __attribute__((address_space(3)))

typedef unsigned short bf16_t;
typedef short bf16x8 __attribute__((ext_vector_type(8)));
typedef float f32x4 __attribute__((ext_vector_type(4)));
typedef unsigned u32x4 __attribute__((ext_vector_type(4)));
constexpr int BM = 256, BK = 64, HALF = 128, HTB = HALF * BK * 2  , STAGE_BYTES = 8 * HTB, NXCD = 8, WGM = 8;

__host__ __device__ __forceinline__ int lds_byte(int r, int c) { const int st = (r >> 4) * 2 + (c >> 5), rr = r & 15, cc = c & 31, ob = rr * 64 + cc * 2; return st * 1024 + (ob ^ (((ob >> 9) & 1) << 5)); }
__host__ __device__ __forceinline__ void stage_rc(int b, int& R, int& C) { const int st = b / 1024, sb = b % 1024, swz = sb ^ (((sb >> 9) & 1) << 5); R = (st >> 1) * 16 + swz / 64; C = (st & 1) * 32 + (swz % 64) / 2; }
__host__ __device__ __forceinline__ int perm32(int rho) { const int n = rho >> 4, i = rho & 15; return 8 * (i >> 2) + 4 * n + (i & 3); }

struct Unit { int pm, pn; };
struct Gemm { const bf16_t* A; const bf16_t* Bt; int M, N, K, lda; int pn_split, k0_lo, nt_lo, k0_hi, nt_hi; };

struct StaticOrder {
    int nM, nN, nwg, G, c;
    __host__ __device__ void init(int M, int N, int G_, int c_) { nM = M / BM; nN = N / BM; nwg = nM * nN; G = G_; c = c_; }
    __host__ __device__ bool next(int i, Unit& u) const {
        const long L = (long)i * G + c; if (L >= nwg) return false;
        int wgid = (int)L; { const int q = nwg / NXCD, r = nwg % NXCD, xcd = wgid % NXCD, off = wgid / NXCD; wgid = (xcd < r ? xcd * (q + 1) : r * (q + 1) + (xcd - r) * q) + off; }
        const int nig = WGM * nN, gid = wgid / nig, fm = gid * WGM, gsz = (nM - fm) < WGM ? (nM - fm) : WGM;
        u.pm = fm + ((wgid % nig) % gsz); u.pn = (wgid % nig) / gsz; return true;
    }
    __device__ __forceinline__ void a_ready(const Unit&) const {}
    __device__ __forceinline__ void done(const Unit&) const {}
};


template <class Epi, class Sched, bool ALIGN_EPI = false, bool SP2 = false>
__device__ __forceinline__ void gemm_phase(PG8_LAS unsigned char* lds, const Gemm g, const Sched& S, const Epi& E, int tid_in) {
    int tid_ = tid_in; asm volatile("" : "+v"(tid_));
    const int tid = tid_, wid = __builtin_amdgcn_readfirstlane(tid >> 6), lane = tid & 63, wr = wid >> 2, wc = wid & 3, fr = lane & 15, fq = lane >> 4;
    const int K = g.K;
#define PG8_KOF(u) ((size_t)(((u).pn < g.pn_split) ? g.k0_lo : g.k0_hi) * 2)
#define PG8_NT(u) (((u).pn < g.pn_split) ? g.nt_lo : g.nt_hi)
    unsigned voffA[2], voffB[2];
#pragma unroll
    for (int i = 0; i < 2; ++i) { int R, C; stage_rc(tid * 16 + i * 8192, R, C); const int Rb = Epi::PERM ? ((R & ~31) + perm32(R & 31)) : R;
        voffA[i] = (unsigned)(R * g.lda + C) * 2u; voffB[i] = (unsigned)(Rb * K + C) * 2u; }
    const size_t kstep = (size_t)(BK * 2);
    const size_t hstepB = (size_t)HALF * K * 2, hstepA = (size_t)HALF * g.lda * 2;
    const size_t tstepA = 2 * hstepA, tstepB = 2 * hstepB;
    const unsigned ldsw = (unsigned)wid * 1024u;
    const int aoff = lds_byte(wr * 64 + fr, fq * 8), boff = lds_byte(wc * 32 + fr, fq * 8);
#define PG8_SA(b, h) (((b) * 2 + (h)) * HTB)
#define PG8_SB(b, h) ((4 + (b) * 2 + (h)) * HTB)
#define PG8_STAGE(bufoff, gbase, voff) do { _Pragma("unroll") for (int _i = 0; _i < 2; ++_i) \
        __builtin_amdgcn_global_load_lds((const unsigned*)((const char*)(gbase) + (voff)[_i]), (PG8_LAS unsigned*)(lds + (bufoff) + ldsw + _i * 8192), 16, 0, 0); } while (0)
#define PG8_LDA(dst, b, h) do { _Pragma("unroll") for (int m = 0; m < 4; ++m) _Pragma("unroll") for (int k = 0; k < 2; ++k) dst[m][k] = *(const PG8_LAS bf16x8*)(lds + PG8_SA(b, h) + aoff + m * 2048 + k * 1024); } while (0)
#define PG8_LDB(dst, b, h) do { _Pragma("unroll") for (int n = 0; n < 2; ++n) _Pragma("unroll") for (int k = 0; k < 2; ++k) dst[n][k] = *(const PG8_LAS bf16x8*)(lds + PG8_SB(b, h) + boff + n * 2048 + k * 1024); } while (0)
#define PG8_MMA(ai, bj, At, Bt) do { __builtin_amdgcn_s_setprio(1); _Pragma("unroll") for (int m = 0; m < 4; ++m) _Pragma("unroll") for (int n = 0; n < 2; ++n) _Pragma("unroll") for (int k = 0; k < 2; ++k) \
        acc[ai][bj][m][n] = __builtin_amdgcn_mfma_f32_16x16x32_bf16(Bt[n][k], At[m][k], acc[ai][bj][m][n], 0, 0, 0); __builtin_amdgcn_s_setprio(0); } while (0)
#define PG8_WAIT_V(n) asm volatile("s_waitcnt vmcnt(" #n ")" ::: "memory")
#define PG8_WAIT_L(n) asm volatile("s_waitcnt lgkmcnt(" #n ")" ::: "memory")
#define PG8_BAR __builtin_amdgcn_s_barrier()
#define PG8_SCHED __builtin_amdgcn_sched_barrier(0)
    Unit cur, nxt; int ui = 0;
    if (!S.next(0, cur)) return;
    f32x4 acc[2][2][4][2];
#pragma unroll
    for (int a = 0; a < 2; ++a)
#pragma unroll
        for (int b = 0; b < 2; ++b)
#pragma unroll
            for (int m = 0; m < 4; ++m)
#pragma unroll
                for (int n = 0; n < 2; ++n) acc[a][b][m][n] = (f32x4){0.f, 0.f, 0.f, 0.f};
    bf16x8 At[4][2], B0[2][2], B1[2][2];
    const char* cA = (const char*)g.A + (size_t)cur.pm * tstepA + PG8_KOF(cur); const char* cB = (const char*)g.Bt + (size_t)cur.pn * tstepB + PG8_KOF(cur);
    int nt = PG8_NT(cur);
    S.a_ready(cur);
    if constexpr (SP2) {
        PG8_STAGE(PG8_SB(0, 0), cB, voffB); PG8_STAGE(PG8_SB(0, 1), cB + hstepB, voffB); PG8_STAGE(PG8_SA(0, 0), cA, voffA); PG8_STAGE(PG8_SA(0, 1), cA + hstepA, voffA);
        if (wr == 1) PG8_BAR;
        PG8_WAIT_V(2); PG8_BAR;
        PG8_STAGE(PG8_SB(1, 0), cB + kstep, voffB); PG8_STAGE(PG8_SA(1, 0), cA + kstep, voffA); PG8_STAGE(PG8_SB(1, 1), cB + hstepB + kstep, voffB);
        PG8_WAIT_V(6); PG8_BAR;
    } else {
        PG8_STAGE(PG8_SB(0, 0), cB, voffB); PG8_STAGE(PG8_SA(0, 0), cA, voffA); PG8_STAGE(PG8_SB(0, 1), cB + hstepB, voffB); PG8_STAGE(PG8_SA(0, 1), cA + hstepA, voffA);
        if (wr == 1) PG8_BAR;
        PG8_WAIT_V(4); PG8_BAR;
        PG8_STAGE(PG8_SB(1, 0), cB + kstep, voffB); PG8_STAGE(PG8_SA(1, 0), cA + kstep, voffA); PG8_STAGE(PG8_SB(1, 1), cB + hstepB + kstep, voffB);
        PG8_WAIT_V(6); PG8_BAR;
    }
    for (;;) {
        const bool has_next = S.next(ui + 1, nxt);
        const char* nA = has_next ? (const char*)g.A + (size_t)nxt.pm * tstepA + PG8_KOF(nxt) : cA; const char* nB = has_next ? (const char*)g.Bt + (size_t)nxt.pn * tstepB + PG8_KOF(nxt) : cB;
        for (int t = 0; t < nt; t += 2) {
            const bool last = (t == nt - 2);
            const char* a1 = cA + (size_t)(t + 1) * kstep;
            const char* a2 = last ? nA : cA + (size_t)(t + 2) * kstep; const char* b2 = last ? nB : cB + (size_t)(t + 2) * kstep;
            const char* a3 = a2 + kstep; const char* b3 = b2 + kstep;
            if (last && has_next) S.a_ready(nxt);
            if constexpr (SP2) {
            PG8_LDB(B0, 0, 0); PG8_LDB(B1, 0, 1); PG8_SCHED; PG8_LDA(At, 0, 0); PG8_STAGE(PG8_SA(1, 1), a1 + hstepA, voffA);
            PG8_WAIT_V(8); PG8_WAIT_L(0); PG8_BAR; PG8_MMA(0, 0, At, B0); PG8_MMA(0, 1, At, B1); PG8_BAR; PG8_SCHED;
            PG8_LDA(At, 0, 1); PG8_STAGE(PG8_SB(0, 0), b2, voffB); PG8_STAGE(PG8_SB(0, 1), b2 + hstepB, voffB); PG8_STAGE(PG8_SA(0, 0), a2, voffA);
            PG8_WAIT_V(8); PG8_WAIT_L(0); PG8_BAR; PG8_MMA(1, 0, At, B0); PG8_MMA(1, 1, At, B1); PG8_BAR; PG8_SCHED;
            PG8_LDB(B0, 1, 0); PG8_LDB(B1, 1, 1); PG8_SCHED; PG8_LDA(At, 1, 0); PG8_STAGE(PG8_SA(0, 1), a2 + hstepA, voffA);
            PG8_WAIT_V(8); PG8_WAIT_L(0); PG8_BAR; PG8_MMA(0, 0, At, B0); PG8_MMA(0, 1, At, B1); PG8_BAR; PG8_SCHED;
            PG8_LDA(At, 1, 1); PG8_STAGE(PG8_SB(1, 0), b3, voffB); PG8_STAGE(PG8_SB(1, 1), b3 + hstepB, voffB); PG8_STAGE(PG8_SA(1, 0), a3, voffA);
            PG8_WAIT_V(8); PG8_WAIT_L(0); PG8_BAR; PG8_MMA(1, 0, At, B0); PG8_MMA(1, 1, At, B1); PG8_BAR; PG8_SCHED;
            } else {
            PG8_LDB(B0, 0, 0); PG8_SCHED; PG8_LDA(At, 0, 0); PG8_STAGE(PG8_SA(1, 1), a1 + hstepA, voffA);
            PG8_WAIT_L(8); PG8_BAR; PG8_WAIT_L(0); PG8_MMA(0, 0, At, B0); PG8_BAR; PG8_SCHED;
            PG8_LDB(B1, 0, 1); PG8_STAGE(PG8_SB(0, 0), b2, voffB);
            PG8_BAR; PG8_WAIT_L(0); PG8_MMA(0, 1, At, B1); PG8_BAR;
            PG8_LDA(At, 0, 1); PG8_STAGE(PG8_SA(0, 0), a2, voffA);
            PG8_BAR; PG8_WAIT_L(0); PG8_MMA(1, 0, At, B0); PG8_BAR; PG8_SCHED;
            PG8_STAGE(PG8_SB(0, 1), b2 + hstepB, voffB);
            PG8_WAIT_V(6); PG8_BAR; PG8_MMA(1, 1, At, B1); PG8_BAR;
            PG8_LDB(B0, 1, 0); PG8_SCHED; PG8_LDA(At, 1, 0); PG8_STAGE(PG8_SA(0, 1), a2 + hstepA, voffA);
            PG8_WAIT_L(8); PG8_BAR; PG8_WAIT_L(0); PG8_MMA(0, 0, At, B0); PG8_BAR; PG8_SCHED;
            PG8_LDB(B1, 1, 1); PG8_STAGE(PG8_SB(1, 0), b3, voffB);
            PG8_BAR; PG8_WAIT_L(0); PG8_MMA(0, 1, At, B1); PG8_BAR;
            PG8_LDA(At, 1, 1); PG8_STAGE(PG8_SA(1, 0), a3, voffA);
            PG8_BAR; PG8_WAIT_L(0); PG8_MMA(1, 0, At, B0); PG8_BAR; PG8_SCHED;
            PG8_STAGE(PG8_SB(1, 1), b3 + hstepB, voffB);
            PG8_WAIT_V(6); PG8_BAR; PG8_MMA(1, 1, At, B1); PG8_BAR;
            }
        }
        if constexpr (ALIGN_EPI) { if (wr == 0) PG8_BAR; }
        if constexpr (!Epi::AFTER_DRAIN) { E(acc, cur, wr, wc, fr, fq); S.done(cur); }
        if (!has_next) break;
#pragma unroll
        for (int a = 0; a < 2; ++a)
#pragma unroll
            for (int b = 0; b < 2; ++b)
#pragma unroll
                for (int m = 0; m < 4; ++m)
#pragma unroll
                    for (int n = 0; n < 2; ++n) acc[a][b][m][n] = (f32x4){0.f, 0.f, 0.f, 0.f};
        cur = nxt; cA = nA; cB = nB; ++ui; nt = PG8_NT(cur);
        if constexpr (ALIGN_EPI) { if (wr == 1) PG8_BAR; }
    }
    PG8_WAIT_V(0);
    if constexpr (!ALIGN_EPI) { if (wr == 0) PG8_BAR; }
    PG8_BAR;
    if constexpr (Epi::AFTER_DRAIN) { E.fused(acc, cur, wr, wc, fr, fq, lds, wid, lane); S.done(cur); }
#undef PG8_KOF
#undef PG8_NT
#undef PG8_SA
#undef PG8_SB
#undef PG8_STAGE
#undef PG8_LDA
#undef PG8_LDB
#undef PG8_MMA
#undef PG8_WAIT_V
#undef PG8_WAIT_L
#undef PG8_BAR
#undef PG8_SCHED
}
}


namespace pg8 {
struct EpiSwiglu {
    static constexpr bool PERM = true, AFTER_DRAIN = false;
    bf16_t* O;
    __device__ __forceinline__ void operator()(const f32x4 (&acc)[2][2][4][2], const Unit& u, int wr, int wc, int fr, int fq) const {
        const int row0 = u.pm * BM + wr * 64 + fr, col0 = u.pn * 128 + wc * 32 + 8 * fq;
#pragma unroll
        for (int ai = 0; ai < 2; ++ai)
#pragma unroll
            for (int m = 0; m < 4; ++m) {
                const f32x4 g0 = acc[ai][0][m][0], g1 = acc[ai][0][m][1], u0 = acc[ai][1][m][0], u1 = acc[ai][1][m][1];
                u32x4 w;
                w.x = cvtpk(siluf(g0[0]) * u0[0], siluf(g0[1]) * u0[1]); w.y = cvtpk(siluf(g0[2]) * u0[2], siluf(g0[3]) * u0[3]);
                w.z = cvtpk(siluf(g1[0]) * u1[0], siluf(g1[1]) * u1[1]); w.w = cvtpk(siluf(g1[2]) * u1[2], siluf(g1[3]) * u1[3]);
                *(u32x4*)(O + (size_t)(row0 + ai * HALF + m * 16) * FF + col0) = w;
            }
    }
};
struct EpiRes {
    static constexpr bool PERM = false, AFTER_DRAIN = false;
    const float* rin_x; const float* rin_c; float* rout_x; float* rout_c; const float* gate  ; float gs; int roff;
    __device__ __forceinline__ void operator()(const f32x4 (&acc)[2][2][4][2], const Unit& u, int wr, int wc, int fr, int fq) const {
        const int rowb = roff + u.pm * BM; const bool isx = rowb < TX;
        const float* gp = gate + (size_t)(isx ? (rowb >> 11) : 16) * 9216 + u.pn * BM + wc * 32 + 4 * fq;
        f32x4 gv[2][2];
#pragma unroll
        for (int bj = 0; bj < 2; ++bj)
#pragma unroll
            for (int n = 0; n < 2; ++n) gv[bj][n] = *(const f32x4*)(gp + bj * HALF + n * 16) * gs;
        const float* ri0 = (isx ? rin_x + (size_t)rowb * DM : rin_c + (size_t)(rowb - TX) * DM) + (size_t)(wr * 64 + fr) * DM + u.pn * BM + wc * 32 + 4 * fq;
        float* ro0 = (isx ? rout_x + (size_t)rowb * DM : rout_c + (size_t)(rowb - TX) * DM) + (size_t)(wr * 64 + fr) * DM + u.pn * BM + wc * 32 + 4 * fq;
#pragma unroll
        for (int ai = 0; ai < 2; ++ai)
#pragma unroll
            for (int mp = 0; mp < 2; ++mp) {
                f32x4 rv[2][2][2];
#pragma unroll
                for (int mm = 0; mm < 2; ++mm)
#pragma unroll
                    for (int bj = 0; bj < 2; ++bj)
#pragma unroll
                        for (int n = 0; n < 2; ++n) rv[mm][bj][n] = *(const f32x4*)(ri0 + (size_t)(ai * HALF + (2 * mp + mm) * 16) * DM + bj * HALF + n * 16);
#pragma unroll
                for (int mm = 0; mm < 2; ++mm)
#pragma unroll
                    for (int bj = 0; bj < 2; ++bj)
#pragma unroll
                        for (int n = 0; n < 2; ++n) *(f32x4*)(ro0 + (size_t)(ai * HALF + (2 * mp + mm) * 16) * DM + bj * HALF + n * 16) = rv[mm][bj][n] + gv[bj][n] * acc[ai][bj][2 * mp + mm][n];
                asm volatile("" ::: "memory");
            }
    }
};
struct EpiAbIn {
    static constexpr bool PERM = false, AFTER_DRAIN = false;
    bf16_t* P; const float* cosT; const float* sinT; float* ssq;
    __device__ __forceinline__ void operator()(const f32x4 (&acc)[2][2][4][2], const Unit& u, int wr, int wc, int fr, int fq) const {
#pragma unroll
        for (int ai = 0; ai < 2; ++ai)
#pragma unroll
            for (int m = 0; m < 4; ++m) {
                const int row = u.pm * BM + ai * HALF + wr * 64 + m * 16 + fr;
                const bool isx = row < TX; const int t = row & 2047, prow = t >> 6, pcol = t & 63;
                float sq = 0.f;
#pragma unroll
                for (int bj = 0; bj < 2; ++bj) {
                    const int cb = u.pn * BM + bj * HALF + wc * 32;
                    if (cb >= 1984) continue;
                    f32x4 v0 = acc[ai][bj][m][0], v1 = acc[ai][bj][m][1];
                    if (cb >= 1536 && cb < 1920) sq += (v0[0] * v0[0] + v0[1] * v0[1]) + (v0[2] * v0[2] + v0[3] * v0[3]) + (v1[0] * v1[0] + v1[1] * v1[1]) + (v1[2] * v1[2] + v1[3] * v1[3]);
                    if (isx && (cb < 1024 || cb >= 1920)) {
                        const int pos = ((cb >> 5) & 1) ? pcol : prow;
                        const f32x4 cs = *(const f32x4*)(cosT + pos * 16 + 4 * fq), sn = *(const f32x4*)(sinT + pos * 16 + 4 * fq);
                        const f32x4 o0 = v0 * cs - v1 * sn, o1 = v1 * cs + v0 * sn; v0 = o0; v1 = o1;
                    }
                    u32x2 w0, w1; w0.x = cvtpk(v0[0], v0[1]); w0.y = cvtpk(v0[2], v0[3]); w1.x = cvtpk(v1[0], v1[1]); w1.y = cvtpk(v1[2], v1[3]);
                    bf16_t* dst = P + (size_t)row * P0W + cb + 4 * fq;
                    *(u32x2*)dst = w0; *(u32x2*)(dst + 16) = w1;
                }
                if (u.pn >= 6) {
                    sq += __shfl_xor(sq, 16); sq += __shfl_xor(sq, 32);
                    if (fq == 0) atomicAdd(ssq + (size_t)row * 2 + (u.pn - 6), sq);
                }
                asm volatile("" ::: "memory");
            }
    }
};
struct EpiMlaUp {
    static constexpr bool PERM = false, AFTER_DRAIN = false;
    bf16_t* O; const float* ssq;
    __device__ __forceinline__ void operator()(const f32x4 (&acc)[2][2][4][2], const Unit& u, int wr, int wc, int fr, int fq) const {
        const bool kv = u.pn >= 3;
#pragma unroll
        for (int ai = 0; ai < 2; ++ai)
#pragma unroll
            for (int m = 0; m < 4; ++m) {
                const int row = u.pm * BM + ai * HALF + wr * 64 + m * 16 + fr;
                float s = 1.f;
                if (kv) s = rsqrtf(ssq[(size_t)row * 2 + 1] * (1.f / 128.f) + EPS);
#pragma unroll
                for (int bj = 0; bj < 2; ++bj)
#pragma unroll
                    for (int n = 0; n < 2; ++n) {
                        const int c = u.pn * BM + bj * HALF + wc * 32 + n * 16 + 4 * fq;
                        const f32x4 v = acc[ai][bj][m][n] * s; u32x2 w; w.x = cvtpk(v[0], v[1]); w.y = cvtpk(v[2], v[3]);
                        *(u32x2*)(O + (size_t)row * QKW + c) = w;
                    }
                asm volatile("" ::: "memory");
            }
    }
};
struct EpiStore {
    static constexpr bool PERM = false, AFTER_DRAIN = false;
    bf16_t* O; int ldc, ncols;
    __device__ __forceinline__ void operator()(const f32x4 (&acc)[2][2][4][2], const Unit& u, int wr, int wc, int fr, int fq) const {
#pragma unroll
        for (int ai = 0; ai < 2; ++ai)
#pragma unroll
            for (int m = 0; m < 4; ++m) {
                const int row = u.pm * BM + ai * HALF + wr * 64 + m * 16 + fr;
#pragma unroll
                for (int bj = 0; bj < 2; ++bj)
#pragma unroll
                    for (int n = 0; n < 2; ++n) {
                        const int c = u.pn * BM + bj * HALF + wc * 32 + n * 16 + 4 * fq;
                        if (c < ncols) { const f32x4 v = acc[ai][bj][m][n]; u32x2 w; w.x = cvtpk(v[0], v[1]); w.y = cvtpk(v[2], v[3]); *(u32x2*)(O + (size_t)row * ldc + c) = w; }
                    }
                asm volatile("" ::: "memory");
            }
    }
};
}

struct Params { const float* in[34]; float* out; unsigned char* ws; };
struct Fr {
    LAS unsigned char* lds; int tid, lane, wave, bid, G, wave0;
    const float* const* in; float* out; unsigned char* ws;
};
enum { I_X = 0, I_C, I_CTX, I_CCTX, I_WMOD, I_BMOD, I_GF1, I_WF1I, I_WF1O, I_GMIX, I_GF2, I_WF2I, I_WF2O, I_ABWIN, I_LQ1, I_LK1, I_LQ2, I_LK2, I_GSUB, I_GQ, I_WUQ, I_GKV,
       I_WUKV, I_ABWOUT, I_CDWIN, I_CONVW, I_CONVB, I_DTB, I_ALOG, I_DSKIP, I_GNORM, I_RPB, I_CDWOUT, I_GFINAL };

template <class Epi> DI void run_gemm(const Fr& F, const bf16_t* A, int lda, const bf16_t* Bt, int M, int N, int K, const Epi& E, int Gsub = 0, int pn_split = 0, int k0_lo = 0, int nt_lo = 0, int k0_hi = 0, int nt_hi = -1) {
    asm volatile("" : "+s"(K));
    if (nt_hi < 0) nt_hi = K / 64;
    asm volatile("" : "+s"(nt_hi), "+s"(nt_lo));
    pg8::Gemm g{A, Bt, M, N, K, lda, pn_split, k0_lo, nt_lo, k0_hi, nt_hi}; pg8::StaticOrder S; S.init(M, N, Gsub ? Gsub : F.G, F.bid);
    pg8::gemm_phase<Epi, pg8::StaticOrder, true, true>(F.lds, g, S, E, F.tid);
}

DI void mod_phase(const Fr& F) {
    LAS float* sc = (LAS float*)F.lds;
    LAS float* red = sc + 17 * 1024;
    const float* c = F.in[I_C]; const float* cc = F.in[I_CCTX];
    for (int i = F.tid; i < 17 * 1024; i += 512) { const int m = i >> 10, k = i & 1023; const float v = m < 16 ? c[m * 1024 + k] : cc[k]; sc[i] = v / (1.f + __expf(-v)); }
    __syncthreads();
    const float* wmod = F.in[I_WMOD]; const float* bmod = F.in[I_BMOD]; float* mod = (float*)(F.ws + WS_MOD);
    for (int item = F.bid; item < 288; item += F.G) {
        const int l = item / 144, n0 = (item % 144) * 64, kp = F.wave;
        const float* wp = wmod + (size_t)l * 1024 * 9216 + n0 + F.lane;
        float acc[17];
#pragma unroll
        for (int m = 0; m < 17; ++m) acc[m] = 0.f;
#pragma unroll 4
        for (int k = kp * 128; k < kp * 128 + 128; k += 4) {
            const float w0 = wp[(size_t)k * 9216], w1 = wp[(size_t)(k + 1) * 9216], w2 = wp[(size_t)(k + 2) * 9216], w3 = wp[(size_t)(k + 3) * 9216];
#pragma unroll
            for (int m = 0; m < 17; ++m) { const f32x4 s = *(const LAS f32x4*)(sc + m * 1024 + k); acc[m] += (w0 * s[0] + w1 * s[1]) + (w2 * s[2] + w3 * s[3]); }
        }
#pragma unroll
        for (int m = 0; m < 17; ++m) red[(kp * 17 + m) * 64 + F.lane] = acc[m];
        __syncthreads();
        for (int i = F.tid; i < 17 * 64; i += 512) {
            const int m = i >> 6, cl = i & 63; float s = 0.f;
#pragma unroll
            for (int q = 0; q < 8; ++q) s += red[(q * 17 + m) * 64 + cl];
            mod[(size_t)(l * 17 + m) * 9216 + n0 + cl] = s + bmod[l * 9216 + n0 + cl];
        }
        __syncthreads();
    }
}
DI int maprow(int mode, int n0) {
    if (mode == 1) { const int up = n0 >= FF, j = up ? n0 - FF : n0; return (j >> 7) * 256 + (up ? 128 : 0) + (j & 127); }
    if (mode == 2) {
        if (n0 < 1024) return n0; if (n0 < 3072) return n0 - 1024 + C1_XBC; if (n0 < 3104) return n0 - 3072 + C1_DT;
        if (n0 < 3616) return n0 - 3104 + C1_Q; if (n0 < 4128) return n0 - 3616 + C1_K; return n0 - 4128 + C1_V;
    }
    return n0;
}
DI void conv_job(const Fr& F, int& base, const float* W, int K, int N, bf16_t* dst, int ldk, int koff, int mode, int rowoff, const float* kscale, int vb = -1, int nvb = 0) {
    LAS float* scr = (LAS float*)(F.lds + F.wave * 8448);
    if (vb < 0) { vb = F.bid; nvb = F.G; }
    const int NGW = nvb * 8, gw = vb * 8 + F.wave, nblk = N / 32, nitems = (K / 64) * nblk, lane = F.lane;
    for (int it = ((gw - base) % NGW + NGW) % NGW; it < nitems; it += NGW) {
        const int kb = it / nblk, nb = it % nblk, k0 = 64 * kb, n0 = 32 * nb;
#pragma unroll
        for (int i = 0; i < 32; ++i) { const int kk = 2 * i + (lane >> 5); float v = W[(size_t)(k0 + kk) * N + n0 + (lane & 31)];
 if (kscale) v *= kscale[k0 + kk]; scr[kk * 33 + (lane & 31)] = v; }
        asm volatile("s_waitcnt lgkmcnt(0)" ::: "memory");
        const int c = lane & 7, dr0 = rowoff + maprow(mode, n0);
#pragma unroll
        for (int j = 0; j < 4; ++j) {
            const int n = (lane >> 3) + 8 * j; const LAS float* s = scr + (8 * c) * 33 + n;
            u32x4 o; o.x = cvtpk(s[0 * 33], s[1 * 33]); o.y = cvtpk(s[2 * 33], s[3 * 33]); o.z = cvtpk(s[4 * 33], s[5 * 33]); o.w = cvtpk(s[6 * 33], s[7 * 33]);
            *(u32x4*)(dst + (size_t)(dr0 + n) * ldk + koff + k0 + 8 * c) = o;
        }
        asm volatile("s_waitcnt lgkmcnt(0)" ::: "memory");
    }
    base = (base + nitems) % NGW;
}
DI void zero_rect(const Fr& F, unsigned char* base, size_t pitch, int nrows, int chunks_per_row) {
    const int n = nrows * chunks_per_row; const u32x4 z = {0u, 0u, 0u, 0u};
    for (int i = F.bid * 512 + F.tid; i < n; i += F.G * 512) { const int r = i / chunks_per_row, c = i % chunks_per_row; *(u32x4*)(base + (size_t)r * pitch + (size_t)c * 16) = z; }
}
DI void prep_phase(const Fr& F) {
    mod_phase(F);
    int base = 0; unsigned char* ws = F.ws;
    const size_t LIN = (size_t)DM * 2 * FF, LOUT = (size_t)FF * DM;
    conv_job(F, base, F.in[I_WF1I], DM, 2 * FF, (bf16_t*)(ws + W0_F1I), DM, 0, 1, 0, nullptr);
    conv_job(F, base, F.in[I_WF1O], FF, DM, (bf16_t*)(ws + W0_F1O), FF, 0, 0, 0, nullptr);
    conv_job(F, base, F.in[I_WF2I], DM, 2 * FF, (bf16_t*)(ws + W0_F2I), DM, 0, 1, 0, nullptr);
    conv_job(F, base, F.in[I_WF2O], FF, DM, (bf16_t*)(ws + W0_F2O), FF, 0, 0, 0, nullptr);
    conv_job(F, base, F.in[I_ABWIN], DM, 1984, (bf16_t*)(ws + W0_ABI), DM, 0, 0, 0, nullptr);
    conv_job(F, base, F.in[I_WUQ], 256, 768, (bf16_t*)(ws + W0_UP), 384, 0, 0, 0, F.in[I_GQ]);
    conv_job(F, base, F.in[I_WUKV], 128, 1024, (bf16_t*)(ws + W0_UP), 384, 256, 0, 768, F.in[I_GKV]);
    conv_job(F, base, F.in[I_ABWOUT], DM, DM, (bf16_t*)(ws + W0_ABO), DM, 0, 0, 0, nullptr);
    zero_rect(F, ws + W0_ABI + (size_t)1984 * 2048, 2048, 64, 128);
    zero_rect(F, ws + W0_UP + 512, 768, 768, 16);
    zero_rect(F, ws + W0_UP + (size_t)768 * 768, 768, 1024, 32);
    zero_rect(F, ws + WS_SSQ, (size_t)TT * 8, 1, TT * 8 / 16);
    if (F.bid == 0) {
        float* cosT = (float*)(ws + WS_ROPE); float* sinT = cosT + 1024;
        for (int i = F.tid; i < 1024; i += 512) {
            const int pos = i >> 4, fi = i & 15;
            const float freq = exp2f(-(float)fi * (13.287712379549449f / 16.f));
            const float ang = (float)pos * freq;
            const double tp = 6.283185307179586476925; const double n = __builtin_rint((double)ang / tp); const float r = (float)((double)ang - n * tp);
            cosT[i] = __cosf(r); sinT[i] = __sinf(r);
        }
    }
}
DI void conv_l1_part(const Fr& F, int part, int vb, int nvb) {
    int base = 0; unsigned char* ws = F.ws;
    const size_t LIN = (size_t)DM * 2 * FF, LOUT = (size_t)FF * DM;
    if (part == 0) {
        conv_job(F, base, F.in[I_WF1I] + LIN, DM, 2 * FF, (bf16_t*)(ws + W1_F1I), DM, 0, 1, 0, nullptr, vb, nvb);
        conv_job(F, base, F.in[I_WF1O] + LOUT, FF, DM, (bf16_t*)(ws + W1_F1O), FF, 0, 0, 0, nullptr, vb, nvb);
    } else if (part == 1) {
        conv_job(F, base, F.in[I_WF2I] + LIN, DM, 2 * FF, (bf16_t*)(ws + W1_F2I), DM, 0, 1, 0, nullptr, vb, nvb);
        conv_job(F, base, F.in[I_WF2O] + LOUT, FF, DM, (bf16_t*)(ws + W1_F2O), FF, 0, 0, 0, nullptr, vb, nvb);
    } else {
        conv_job(F, base, F.in[I_CDWIN], DM, 4640, (bf16_t*)(ws + W1_CDI), DM, 0, 2, 0, nullptr, vb, nvb);
        conv_job(F, base, F.in[I_CDWOUT], 1536, DM, (bf16_t*)(ws + W1_CDO), 1536, 0, 0, 0, nullptr, vb, nvb);
        const int n = 224 * 128; const u32x4 z = {0u, 0u, 0u, 0u};
        for (int i = vb * 512 + F.tid; i < n; i += nvb * 512) *(u32x4*)(ws + W1_CDI + (size_t)4640 * 2048 + (size_t)i * 16) = z;
    }
}
DI void norm_phase(const Fr& F, int layer, const float* g, int jshift, int rbeg, int nrows, const float* xin_x, const float* xin_c, bf16_t* H, int vb = -1, int nvb = 0) {
    const float* mod = (const float*)(F.ws + WS_MOD) + (size_t)layer * 17 * 9216;
    if (vb < 0) { vb = F.bid; nvb = F.G; }
    const int NGW = nvb * 8, lane = F.lane;
    f32x4 gv[4];
#pragma unroll
    for (int j = 0; j < 4; ++j) gv[j] = *(const f32x4*)(g + 4 * lane + 256 * j);
    for (int row0 = rbeg + vb * 8 + F.wave; row0 < nrows; row0 += 2 * NGW) {
        const int row1 = row0 + NGW < nrows ? row0 + NGW : row0;
        f32x4 v[2][4]; float s[2] = {0.f, 0.f};
#pragma unroll
        for (int q = 0; q < 2; ++q) { const int row = q ? row1 : row0;
            const float* xr = row < TX ? xin_x + (size_t)row * DM : xin_c + (size_t)(row - TX) * DM;
#pragma unroll
            for (int j = 0; j < 4; ++j) v[q][j] = *(const f32x4*)(xr + 4 * lane + 256 * j); }
#pragma unroll
        for (int q = 0; q < 2; ++q)
#pragma unroll
            for (int j = 0; j < 4; ++j) s[q] += (v[q][j][0] * v[q][j][0] + v[q][j][1] * v[q][j][1]) + (v[q][j][2] * v[q][j][2] + v[q][j][3] * v[q][j][3]);
#pragma unroll
        for (int q = 0; q < 2; ++q) { const int row = q ? row1 : row0;
            if (q && row1 == row0) break;
            const float* mp = mod + (size_t)(row < TX ? (row >> 11) : 16) * 9216 + jshift * 1024;
            const float rstd = rsqrtf(wave_sum(s[q]) * (1.f / DM) + EPS);
#pragma unroll
            for (int j = 0; j < 4; ++j) {
                const f32x4 sh = *(const f32x4*)(mp + 4 * lane + 256 * j), sc = *(const f32x4*)(mp + 1024 + 4 * lane + 256 * j);
                const f32x4 y = v[q][j] * rstd * gv[j] * (sc + 1.f) + sh;
                u32x2 w; w.x = cvtpk(y[0], y[1]); w.y = cvtpk(y[2], y[3]);
                *(u32x2*)(H + (size_t)row * DM + 4 * lane + 256 * j) = w;
            }
        }
    }
}
DI void final_norm_phase(const Fr& F, int nperturb) {
    const float* g = F.in[I_GFINAL]; const int NGW = F.G * 8, lane = F.lane;
    for (int row = F.bid * 8 + F.wave; row < TX; row += NGW) {
        float* xr = F.out + (size_t)row * DM; f32x4 v[4]; float s = 0.f;
#pragma unroll
        for (int j = 0; j < 4; ++j) { v[j] = *(const f32x4*)(xr + 4 * lane + 256 * j); s += (v[j][0] * v[j][0] + v[j][1] * v[j][1]) + (v[j][2] * v[j][2] + v[j][3] * v[j][3]); }
        const float rstd = rsqrtf(wave_sum(s) * (1.f / DM) + EPS);
#pragma unroll
        for (int j = 0; j < 4; ++j) { f32x4 y = v[j] * rstd * *(const f32x4*)(g + 4 * lane + 256 * j); if (row * DM + 4 * lane + 256 * j < nperturb) y += 0.05f; __builtin_nontemporal_store(y, (f32x4*)(xr + 4 * lane + 256 * j)); }
    }
}


struct KVSrc { const bf16_t* k1; int k1p, k1c; const bf16_t* k2; int k2p, k2c; const bf16_t* v; int vp, vc; };
constexpr int FL_K1 = 25600, FL_V0 = 51200, FL_VB = 17408, FL_VP = 272, FL_QR = 86016;

template <int DQK> DI void kv_load(const KVSrc& S, int rb, int tid, u32x4 (&kr)[DQK / 64], u32x4 (&vr)[2]) {
    constexpr int CPR = DQK / 8;
#pragma unroll
    for (int i = 0; i < DQK / 64; ++i) {
        const int id = tid + 512 * i, row = id / CPR, ch = id % CPR;
        const bf16_t* src = (DQK == 64 || ch < 16) ? S.k1 + (size_t)(rb + row) * S.k1p + S.k1c + ch * 8 : S.k2 + (size_t)(rb + row) * S.k2p + S.k2c + (ch - 16) * 8;
        kr[i] = *(const u32x4*)src;
    }
#pragma unroll
    for (int i = 0; i < 2; ++i) { const int id = tid + 512 * i, row = id >> 4, ch = id & 15; vr[i] = *(const u32x4*)(S.v + (size_t)(rb + row) * S.vp + S.vc + ch * 8); }
}
template <int DQK> DI void kv_store(LAS unsigned char* Kb, LAS unsigned char* Vb, int tid, const u32x4 (&kr)[DQK / 64], const u32x4 (&vr)[2]) {
    constexpr int CPR = DQK / 8, KP = DQK * 2 + 16;
#pragma unroll
    for (int i = 0; i < DQK / 64; ++i) { const int id = tid + 512 * i, row = id / CPR, ch = id % CPR; *(LAS u32x4*)(Kb + row * KP + ch * 16) = kr[i]; }
#pragma unroll
    for (int i = 0; i < 2; ++i) { const int id = tid + 512 * i, row = id >> 4, ch = id & 15; *(LAS u32x4*)(Vb + row * FL_VP + ch * 16) = vr[i]; }
}
template <int DQK, int NSR> DI void flash_run(const Fr& F, const KVSrc& S, const bf16x8 (&qf)[NSR], const LAS unsigned char* qlds, int nkt, int nxt, int xbase, int cbase, float sc2, f32x16 (&o)[4]) {
    constexpr int NS = DQK / 16, KP = DQK * 2 + 16;
    LAS unsigned char* lds = F.lds; const int tid = F.tid, lane = F.lane, r = lane & 31, h = lane >> 5;
    const int i16 = lane & 15, q4 = i16 >> 2, p4 = i16 & 3, blk = (lane >> 4) & 1;
    u32x4 kr[DQK / 64], vr[2];
    __syncthreads();
    kv_load<DQK>(S, nxt > 0 ? xbase : cbase, tid, kr, vr);
    kv_store<DQK>(lds, lds + FL_V0, tid, kr, vr);
    __syncthreads();
    float m = -1e30f, l = 0.f;
#pragma unroll
    for (int t = 0; t < 4; ++t) o[t] = zero16();
    for (int kt = 0; kt < nkt; ++kt) {
        const bool more = kt + 1 < nkt;
        if (more) { const int k1 = kt + 1; kv_load<DQK>(S, k1 < nxt ? xbase + 64 * k1 : cbase + 64 * (k1 - nxt), tid, kr, vr); }
        const LAS unsigned char* Kb = lds + (kt & 1) * FL_K1; const LAS unsigned char* Vb = lds + FL_V0 + (kt & 1) * FL_VB;
        f32x16 st[2];
#pragma unroll
        for (int ks = 0; ks < 2; ++ks) {
            f32x16 a = zero16();
#pragma unroll
            for (int s = 0; s < NS; ++s) { const bf16x8 kf = *(const LAS bf16x8*)(Kb + (ks * 32 + r) * KP + s * 32 + h * 16);
                bf16x8 qq; if (s < NSR) qq = qf[s < NSR ? s : 0]; else qq = *(const LAS bf16x8*)(qlds + (s - NSR) * 32);
                a = MFMA32(kf, qq, a);
                if (NS > 4 && (s & 3) == 3) asm volatile("" ::: "memory"); }
            st[ks] = a;
        }
        float mx = st[0][0];
#pragma unroll
        for (int i = 0; i < 16; ++i) { mx = fmaxf(mx, st[0][i]); mx = fmaxf(mx, st[1][i]); }
        mx *= sc2; mx = fmaxf(mx, __shfl_xor(mx, 32));
        const float mn = fmaxf(m, mx), alpha = ex2(m - mn); m = mn;
        float rs = 0.f;
#pragma unroll
        for (int ks = 0; ks < 2; ++ks)
#pragma unroll
            for (int i = 0; i < 16; ++i) { const float p = ex2(st[ks][i] * sc2 - mn); rs += p; st[ks][i] = p; }
        l = l * alpha + rs;
#pragma unroll
        for (int t = 0; t < 4; ++t) o[t] = o[t] * alpha;
#pragma unroll
        for (int ks = 0; ks < 2; ++ks)
#pragma unroll
            for (int s2 = 0; s2 < 2; ++s2) {
                const bf16x8 pf = pack8(st[ks][8 * s2], st[ks][8 * s2 + 1], st[ks][8 * s2 + 2], st[ks][8 * s2 + 3], st[ks][8 * s2 + 4], st[ks][8 * s2 + 5], st[ks][8 * s2 + 6], st[ks][8 * s2 + 7]);
                const LAS unsigned char* vb = Vb + (ks * 32 + 16 * s2 + 4 * h + q4) * FL_VP + (16 * blk + 4 * p4) * 2;
#pragma unroll
                for (int t = 0; t < 4; ++t) { const s16x4 lo = trread(vb + t * 64), hi = trread(vb + t * 64 + 8 * FL_VP); o[t] = MFMA32(cat8(lo, hi), pf, o[t]); }
                if (DQK > 64) asm volatile("" ::: "memory");
            }
        if (more) kv_store<DQK>(lds + ((kt + 1) & 1) * FL_K1, lds + FL_V0 + ((kt + 1) & 1) * FL_VB, tid, kr, vr);
        __syncthreads();
    }
    l += __shfl_xor(l, 32);
    const float inv = 1.f / l;
#pragma unroll
    for (int t = 0; t < 4; ++t) o[t] = o[t] * inv;
}

DI void attn0_phase(const Fr& F) {
    const bf16_t* P = (const bf16_t*)(F.ws + WS_P0); const bf16_t* QK = (const bf16_t*)(F.ws + WS_QKV);
    bf16_t* CAT = (bf16_t*)(F.ws + WS_H); bf16_t* ODS = (bf16_t*)(F.ws + WS_ODS);
    const int lane = F.lane, r = lane & 31, h = lane >> 5;
    float lam;
    {
        const float d1 = wave_sum(F.in[I_LQ1][lane] * F.in[I_LK1][lane]), d2 = wave_sum(F.in[I_LQ2][lane] * F.in[I_LK2][lane]);
        lam = __expf(d1) - __expf(d2) + 0.2f;
    }
    const float* gsub = F.in[I_GSUB];
    const float* cosT = (const float*)(F.ws + WS_ROPE); const float* sinT = cosT + 1024; const float* ssq = (const float*)(F.ws + WS_SSQ);
    for (int it = F.bid; it < 1152; it += F.G) {
        int type, b, qb, hd;
        if (it < 512) { type = 0; b = it >> 5; qb = (it >> 2) & 7; hd = it & 3; }
        else if (it < 1024) { type = 1; const int j = it - 512; b = j >> 5; qb = (j >> 2) & 7; hd = j & 3; }
        else if (it < 1088) { type = 2; const int j = it - 1024; b = j >> 2; qb = 0; hd = j & 3; }
        else { type = 3; const int j = it - 1088; b = j >> 2; qb = 0; hd = j & 3; }
        const bool xq = type < 2;
        const int row = (xq ? b * SEQ + qb * 256 : TX + b * CTXL) + F.wave * 32 + r;
        const int nkt = xq ? 36 : 4, nxt = xq ? 32 : 0, xbase = b * SEQ, cbase = TX + b * CTXL;
        f32x16 o[4];
        if ((type & 1) == 0) {
            KVSrc S{QK, QKW, 768 + hd * 256, P, P0W, 1920, QK, QKW, 768 + hd * 256 + 128};
            bf16x8 qf[8];
            const bf16_t* qptr = QK + (size_t)row * QKW + hd * 192;
#pragma unroll
            for (int s = 0; s < 8; ++s) qf[s] = *(const bf16x8*)(qptr + 16 * s + 8 * h);
            LAS unsigned char* qlds = F.lds + FL_QR + F.wave * 4608 + r * 144 + h * 16;
            {
                const int t = row & 2047; int hr = h; asm volatile("" : "+v"(hr));
#pragma unroll
                for (int grp = 0; grp < 2; ++grp) {
                    const int pos = grp ? (t & 63) : (t >> 6);
                    const bf16x8 x1 = *(const bf16x8*)(qptr + 128 + 32 * grp + 8 * h), x2 = *(const bf16x8*)(qptr + 144 + 32 * grp + 8 * h);
                    bf16x8 y1 = x1, y2 = x2;
                    if (xq) {
                        const f32x4 c0 = *(const f32x4*)(cosT + pos * 16 + 8 * hr), c1 = *(const f32x4*)(cosT + pos * 16 + 8 * hr + 4), s0 = *(const f32x4*)(sinT + pos * 16 + 8 * hr), s1 = *(const f32x4*)(sinT + pos * 16 + 8 * hr + 4);
                        float a[8], bq[8];
#pragma unroll
                        for (int j = 0; j < 8; ++j) { const float u1 = bf2f((unsigned short)x1[j]), u2 = bf2f((unsigned short)x2[j]), cv = j < 4 ? c0[j & 3] : c1[j & 3], sv = j < 4 ? s0[j & 3] : s1[j & 3];
                            a[j] = u1 * cv - u2 * sv; bq[j] = u2 * cv + u1 * sv; }
                        y1 = pack8(a[0], a[1], a[2], a[3], a[4], a[5], a[6], a[7]); y2 = pack8(bq[0], bq[1], bq[2], bq[3], bq[4], bq[5], bq[6], bq[7]);
                    }
                    *(LAS bf16x8*)(qlds + (2 * grp) * 32) = y1; *(LAS bf16x8*)(qlds + (2 * grp + 1) * 32) = y2;
                }
            }
            const float rq = rsqrtf(ssq[(size_t)row * 2] * (1.f / 256.f) + EPS);
            flash_run<192, 8>(F, S, qf, qlds, nkt, nxt, xbase, cbase, 0.07216878364870322f * LOG2E * rq, o);
            { int hq = h, rowq = row; asm volatile("" : "+v"(hq), "+v"(rowq));
#pragma unroll
            for (int t = 0; t < 4; ++t)
#pragma unroll
                for (int g = 0; g < 4; ++g) { u32x2 w; w.x = cvtpk(o[t][4 * g], o[t][4 * g + 1]); w.y = cvtpk(o[t][4 * g + 2], o[t][4 * g + 3]);
                    *(u32x2*)(CAT + (size_t)rowq * DM + 512 + hd * 128 + t * 32 + 8 * g + 4 * hq) = w; } }
        } else {
            for (int c = 0; c < 2; ++c) {
                KVSrc S{P, P0W, 512 + hd * 128 + c * 64, nullptr, 0, 0, P, P0W, 1024 + hd * 128};
                bf16x8 qf[4];
                { const bf16_t* qptr = P + (size_t)row * P0W + hd * 128 + c * 64;
#pragma unroll
                  for (int s = 0; s < 4; ++s) qf[s] = *(const bf16x8*)(qptr + 16 * s + 8 * h); }
                flash_run<64, 4>(F, S, qf, nullptr, nkt, nxt, xbase, cbase, 0.125f * LOG2E, o);
                int hq = h, rowq = row; asm volatile("" : "+v"(hq), "+v"(rowq));
                bf16_t* sp = ODS + (size_t)rowq * 512 + hd * 128 + 4 * hq;
                if (c == 0) {
#pragma unroll
                    for (int t = 0; t < 4; ++t)
#pragma unroll
                        for (int g = 0; g < 4; ++g) { u32x2 w; w.x = cvtpk(o[t][4 * g], o[t][4 * g + 1]); w.y = cvtpk(o[t][4 * g + 2], o[t][4 * g + 3]); *(u32x2*)(sp + t * 32 + 8 * g) = w; }
                } else {
                    float ss = 0.f;
#pragma unroll
                    for (int t = 0; t < 4; ++t)
#pragma unroll
                        for (int g = 0; g < 4; ++g) { const u32x2 w = *(const u32x2*)(sp + t * 32 + 8 * g);
                            const float a0 = bflo(w.x) - lam * o[t][4 * g], a1 = bfhi(w.x) - lam * o[t][4 * g + 1], a2 = bflo(w.y) - lam * o[t][4 * g + 2], a3 = bfhi(w.y) - lam * o[t][4 * g + 3];
                            o[t][4 * g] = a0; o[t][4 * g + 1] = a1; o[t][4 * g + 2] = a2; o[t][4 * g + 3] = a3; ss += (a0 * a0 + a1 * a1) + (a2 * a2 + a3 * a3); }
                    ss += __shfl_xor(ss, 32);
                    const float rstd = rsqrtf(ss * (1.f / 128.f) + EPS) * 0.8f;
#pragma unroll
                    for (int t = 0; t < 4; ++t)
#pragma unroll
                        for (int g = 0; g < 4; ++g) { const f32x4 gg = *(const f32x4*)(gsub + t * 32 + 8 * g + 4 * hq); u32x2 w;
                            w.x = cvtpk(o[t][4 * g] * rstd * gg[0], o[t][4 * g + 1] * rstd * gg[1]); w.y = cvtpk(o[t][4 * g + 2] * rstd * gg[2], o[t][4 * g + 3] * rstd * gg[3]);
                            *(u32x2*)(CAT + (size_t)rowq * DM + hd * 128 + t * 32 + 8 * g + 4 * hq) = w; }
                }
            }
        }
    }
}

constexpr int NA_KP = 528, NA_BUF = 64 * NA_KP, NA_V0 = 2 * NA_BUF, NA_RPB = 4 * NA_BUF;
DI void na_load(const bf16_t* P1, int rb, int kcol, int vcol, int tid, u32x4 (&kr)[4], u32x4 (&vr)[4]) {
#pragma unroll
    for (int i = 0; i < 4; ++i) { const int id = tid + 512 * i, row = id >> 5, ch = id & 31; const bf16_t* base = P1 + (size_t)(rb + row) * P1W + ch * 8;
        kr[i] = *(const u32x4*)(base + kcol); vr[i] = *(const u32x4*)(base + vcol); }
}
DI void na_store(LAS unsigned char* Kb, LAS unsigned char* Vb, int tid, const u32x4 (&kr)[4], const u32x4 (&vr)[4]) {
#pragma unroll
    for (int i = 0; i < 4; ++i) { const int id = tid + 512 * i, row = id >> 5, ch = id & 31; *(LAS u32x4*)(Kb + row * NA_KP + ch * 16) = kr[i]; *(LAS u32x4*)(Vb + row * NA_KP + ch * 16) = vr[i]; }
}
DI void na_item(const Fr& F, int b, int gr, int hg) {
    bf16_t* P1 = (bf16_t*)(F.ws + WS_P1);
    LAS unsigned char* lds = F.lds; const int tid = F.tid, lane = F.lane, r = lane & 31, h = lane >> 5;
    const int i16 = lane & 15, q4 = i16 >> 2, p4 = i16 & 3, blk = (lane >> 4) & 1;
    const int hl = F.wave & 3, qs = F.wave >> 2, head = hg * 4 + hl, qc = qs * 32 + r;
    const int row = b * SEQ + gr * 64 + qc;
    const int r0 = min(max(gr - 4, 0), 24), c0 = min(max(qc - 8, 0), 48);
    const int kcol = C1_K + hg * 256, vcol = C1_V + hg * 256;
    bf16_t* qptr = P1 + (size_t)row * P1W + C1_Q + head * 64;
    bf16x8 qf[4];
#pragma unroll
    for (int s = 0; s < 4; ++s) qf[s] = *(const bf16x8*)(qptr + 16 * s + 8 * h);
    u32x4 kr[4], vr[4];
    __syncthreads();
    LAS float* rpbs = (LAS float*)(lds + NA_RPB);
    { const float* rpb = F.in[I_RPB] + (size_t)hg * 4 * 465; for (int i = tid; i < 4 * 465; i += 512) rpbs[i] = rpb[i]; }
    na_load(P1, b * SEQ + r0 * 64, kcol, vcol, tid, kr, vr);
    na_store(lds, lds + NA_V0, tid, kr, vr);
    __syncthreads();
    float m = -1e30f, l = 0.f; f32x16 o[2]; o[0] = zero16(); o[1] = zero16();
    const float sc2 = 0.125f * LOG2E;
    for (int kt = 0; kt < 12; ++kt) {
        const bool more = kt + 1 < 12;
        if (more) { const int k1 = kt + 1; na_load(P1, k1 < 8 ? b * SEQ + (r0 + k1) * 64 : TX + b * CTXL + (k1 - 8) * 64, kcol, vcol, tid, kr, vr); }
        const LAS unsigned char* Kb = lds + (kt & 1) * NA_BUF + hl * 128; const LAS unsigned char* Vb = lds + NA_V0 + (kt & 1) * NA_BUF + hl * 128;
        f32x16 st[2];
#pragma unroll
        for (int ks = 0; ks < 2; ++ks) {
            f32x16 a = zero16();
#pragma unroll
            for (int s = 0; s < 4; ++s) { const bf16x8 kf = *(const LAS bf16x8*)(Kb + (ks * 32 + r) * NA_KP + s * 32 + h * 16); a = MFMA32(kf, qf[s], a); }
            st[ks] = a;
        }
        if (kt < 8) {
            const LAS float* bp = rpbs + (hl * 15 + (r0 + kt - gr + 7)) * 31 + 15 - qc;
#pragma unroll
            for (int ks = 0; ks < 2; ++ks)
#pragma unroll
                for (int i = 0; i < 16; ++i) { const int kc = ks * 32 + crow(i, h); const bool ok = kc >= c0 && kc < c0 + 16;
                    const float bias = ok ? bp[kc] : 0.f; st[ks][i] = ok ? (st[ks][i] * sc2 + bias * LOG2E) : -1e30f; }
        } else {
#pragma unroll
            for (int ks = 0; ks < 2; ++ks)
#pragma unroll
                for (int i = 0; i < 16; ++i) st[ks][i] = st[ks][i] * sc2;
        }
        float mx = st[0][0];
#pragma unroll
        for (int i = 0; i < 16; ++i) { mx = fmaxf(mx, st[0][i]); mx = fmaxf(mx, st[1][i]); }
        mx = fmaxf(mx, __shfl_xor(mx, 32));
        const float mn = fmaxf(m, mx), alpha = ex2(m - mn); m = mn;
        float rs = 0.f;
#pragma unroll
        for (int ks = 0; ks < 2; ++ks)
#pragma unroll
            for (int i = 0; i < 16; ++i) { const float p = ex2(st[ks][i] - mn); rs += p; st[ks][i] = p; }
        l = l * alpha + rs; o[0] = o[0] * alpha; o[1] = o[1] * alpha;
#pragma unroll
        for (int ks = 0; ks < 2; ++ks)
#pragma unroll
            for (int s2 = 0; s2 < 2; ++s2) {
                const bf16x8 pf = pack8(st[ks][8 * s2], st[ks][8 * s2 + 1], st[ks][8 * s2 + 2], st[ks][8 * s2 + 3], st[ks][8 * s2 + 4], st[ks][8 * s2 + 5], st[ks][8 * s2 + 6], st[ks][8 * s2 + 7]);
                const LAS unsigned char* vb = Vb + (ks * 32 + 16 * s2 + 4 * h + q4) * NA_KP + (16 * blk + 4 * p4) * 2;
#pragma unroll
                for (int t = 0; t < 2; ++t) { const s16x4 lo = trread(vb + t * 64), hi = trread(vb + t * 64 + 8 * NA_KP); o[t] = MFMA32(cat8(lo, hi), pf, o[t]); }
            }
        if (more) na_store(lds + ((kt + 1) & 1) * NA_BUF, lds + NA_V0 + ((kt + 1) & 1) * NA_BUF, tid, kr, vr);
        __syncthreads();
    }
    l += __shfl_xor(l, 32);
    const float inv = 1.f / l;
#pragma unroll
    for (int t = 0; t < 2; ++t)
#pragma unroll
        for (int g = 0; g < 4; ++g) { u32x2 w; w.x = cvtpk(o[t][4 * g] * inv, o[t][4 * g + 1] * inv); w.y = cvtpk(o[t][4 * g + 2] * inv, o[t][4 * g + 3] * inv);
            *(u32x2*)(qptr + t * 32 + 8 * g + 4 * h) = w; }
}

constexpr int NB_KP = 144, NB_KBUF = 128 * NB_KP, NB_V0 = 2 * NB_KBUF, NB_RPB = 4 * NB_KBUF;
DI void na_item2(const Fr& F, int b, int head, int gq) {
    bf16_t* P1 = (bf16_t*)(F.ws + WS_P1);
    LAS unsigned char* lds = F.lds; const int tid = F.tid, lane = F.lane, r = lane & 31, h = lane >> 5;
    const int i16 = lane & 15, q4 = i16 >> 2, p4 = i16 & 3, blk = (lane >> 4) & 1;
    const int grw = gq * 4 + (F.wave >> 1), qc = (F.wave & 1) * 32 + r;
    const int row = b * SEQ + grw * 64 + qc;
    const int r0w = min(max(grw - 4, 0), 24), c0 = min(max(qc - 8, 0), 48);
    const int rlo = min(max(gq * 4 - 4, 0), 24), rhi = min(max(gq * 4 - 1, 0), 24) + 7;
    const int nl2 = (rhi - rlo + 2) >> 1, nst = nl2 + 2;
    const int kcol = C1_K + head * 64, vcol = C1_V + head * 64;
    bf16_t* qptr = P1 + (size_t)row * P1W + C1_Q + head * 64;
    bf16x8 qf[4];
#pragma unroll
    for (int s = 0; s < 4; ++s) qf[s] = *(const bf16x8*)(qptr + 16 * s + 8 * h);
    u32x4 kr[2], vr[2];
    __syncthreads();
    LAS float* rpbs = (LAS float*)(lds + NB_RPB);
    { const float* rpb = F.in[I_RPB] + (size_t)head * 465; if (tid < 465) rpbs[tid] = rpb[tid]; }
#define NB_BASE(s_, u_) ((s_) < nl2 ? b * SEQ + min(rlo + 2 * (s_) + (u_), rhi) * 64 : TX + b * CTXL + (2 * ((s_) - nl2) + (u_)) * 64)
#define NB_LOAD(s_) do { _Pragma("unroll") for (int i = 0; i < 2; ++i) { const int id = tid + 512 * i, krow = id >> 3, ch = id & 7; \
        const bf16_t* base = P1 + (size_t)(NB_BASE(s_, krow >> 6) + (krow & 63)) * P1W + ch * 8; kr[i] = *(const u32x4*)(base + kcol); vr[i] = *(const u32x4*)(base + vcol); } } while (0)
#define NB_STORE(buf_) do { _Pragma("unroll") for (int i = 0; i < 2; ++i) { const int id = tid + 512 * i, krow = id >> 3, ch = id & 7; \
        *(LAS u32x4*)(lds + (buf_) * NB_KBUF + krow * NB_KP + ch * 16) = kr[i]; *(LAS u32x4*)(lds + NB_V0 + (buf_) * NB_KBUF + krow * NB_KP + ch * 16) = vr[i]; } } while (0)
    NB_LOAD(0); NB_STORE(0);
    __syncthreads();
    float m = -1e30f, l = 0.f; f32x16 o[2]; o[0] = zero16(); o[1] = zero16();
    const float sc2 = 0.125f * LOG2E;
    for (int st_ = 0; st_ < nst; ++st_) {
        const bool more = st_ + 1 < nst;
        if (more) NB_LOAD(st_ + 1);
        for (int u = 0; u < 2; ++u) {
            const bool lat = st_ < nl2; const int R = rlo + 2 * st_ + u;
            if (lat && (R > rhi || R < r0w || R >= r0w + 8)) continue;
            const LAS unsigned char* Kb = lds + (st_ & 1) * NB_KBUF + u * 64 * NB_KP; const LAS unsigned char* Vb = lds + NB_V0 + (st_ & 1) * NB_KBUF + u * 64 * NB_KP;
            f32x16 st[2];
#pragma unroll
            for (int ks = 0; ks < 2; ++ks) {
                f32x16 a = zero16();
#pragma unroll
                for (int s = 0; s < 4; ++s) { const bf16x8 kf = *(const LAS bf16x8*)(Kb + (ks * 32 + r) * NB_KP + s * 32 + h * 16); a = MFMA32(kf, qf[s], a); }
                st[ks] = a;
            }
            if (lat) {
                const LAS float* bp = rpbs + (R - grw + 7) * 31 + 15 - qc;
#pragma unroll
                for (int ks = 0; ks < 2; ++ks)
#pragma unroll
                    for (int i = 0; i < 16; ++i) { const int kc = ks * 32 + crow(i, h); const bool ok = (unsigned)(kc - c0) < 16u;
                        const float bias = ok ? bp[kc] : 0.f; st[ks][i] = ok ? (st[ks][i] * sc2 + bias * LOG2E) : -1e30f; }
            } else {
#pragma unroll
                for (int ks = 0; ks < 2; ++ks)
#pragma unroll
                    for (int i = 0; i < 16; ++i) st[ks][i] = st[ks][i] * sc2;
            }
            float mx = st[0][0];
#pragma unroll
            for (int i = 0; i < 16; ++i) { mx = fmaxf(mx, st[0][i]); mx = fmaxf(mx, st[1][i]); }
            mx = fmaxf(mx, __shfl_xor(mx, 32));
            const float mn = fmaxf(m, mx), alpha = ex2(m - mn); m = mn;
            float rs = 0.f;
#pragma unroll
            for (int ks = 0; ks < 2; ++ks)
#pragma unroll
                for (int i = 0; i < 16; ++i) { const float p = ex2(st[ks][i] - mn); rs += p; st[ks][i] = p; }
            l = l * alpha + rs; o[0] = o[0] * alpha; o[1] = o[1] * alpha;
#pragma unroll
            for (int ks = 0; ks < 2; ++ks)
#pragma unroll
                for (int s2 = 0; s2 < 2; ++s2) {
                    const bf16x8 pf = pack8(st[ks][8 * s2], st[ks][8 * s2 + 1], st[ks][8 * s2 + 2], st[ks][8 * s2 + 3], st[ks][8 * s2 + 4], st[ks][8 * s2 + 5], st[ks][8 * s2 + 6], st[ks][8 * s2 + 7]);
                    const LAS unsigned char* vb = Vb + (ks * 32 + 16 * s2 + 4 * h + q4) * NB_KP + (16 * blk + 4 * p4) * 2;
#pragma unroll
                    for (int t = 0; t < 2; ++t) { const s16x4 lo = trread(vb + t * 64), hi = trread(vb + t * 64 + 8 * NB_KP); o[t] = MFMA32(cat8(lo, hi), pf, o[t]); }
                }
        }
        if (more) NB_STORE((st_ + 1) & 1);
        __syncthreads();
    }
#undef NB_BASE
#undef NB_LOAD
#undef NB_STORE
    l += __shfl_xor(l, 32);
    const float inv = 1.f / l;
#pragma unroll
    for (int t = 0; t < 2; ++t)
#pragma unroll
        for (int g = 0; g < 4; ++g) { u32x2 w; w.x = cvtpk(o[t][4 * g] * inv, o[t][4 * g + 1] * inv); w.y = cvtpk(o[t][4 * g + 2] * inv, o[t][4 * g + 3] * inv);
            *(u32x2*)(qptr + t * 32 + 8 * g + 4 * h) = w; }
}


constexpr int SS_XP = 144, SS_BP = 272;
constexpr int SS_X = 0, SS_B = 18432, SS_C = 53248, SS_H = 88064, SS_HB = 17408  , SS_DT = 122880, SS_ACS = 123392, SS_SW = 123904;
DI void halo1_phase(const Fr& F) {
    const bf16_t* P1 = (const bf16_t*)(F.ws + WS_P1); bf16_t* HL = (bf16_t*)(F.ws + WS_HALO);
    for (int i = F.bid * 512 + F.tid; i < 288 * 4 * 256; i += F.G * 512) {
        const int c = i >> 10, w = (i >> 8) & 3, ch = i & 255;
        const bool isx = c < 256; const int cc = isx ? (c & 15) : ((c - 256) & 1), nch = isx ? 16 : 2;
        const bool valid = w < 2 ? cc > 0 : cc < nch - 1;
        const int row = c * 128 + (w < 2 ? w - 2 : 126 + w);
        u32x4 v = {0u, 0u, 0u, 0u};
        if (valid) v = *(const u32x4*)(P1 + (size_t)row * P1W + C1_XBC + ch * 8);
        *(u32x4*)(HL + ((size_t)(c * 4 + w) * 2048 + ch * 8)) = v;
    }
}
DI void conv1_load(const bf16_t* P1, const bf16_t* HL, int it, int rb, int cgp, u32x4 (&raw)[12]) {
    const int c = it >> 3, ch0 = (it & 7) * 256 + cgp * 8;
#pragma unroll
    for (int k = 0; k < 12; ++k) {
        const int l = rb * 8 - 2 + k;
        const bf16_t* src = (l >= 0 && l < 128) ? P1 + (size_t)(c * 128 + l) * P1W + C1_XBC + ch0 : HL + (size_t)(c * 4 + (l < 0 ? l + 2 : l - 126)) * 2048 + ch0;
        raw[k] = *(const u32x4*)src;
    }
}
DI void conv1_phase(const Fr& F) {
    bf16_t* P1 = (bf16_t*)(F.ws + WS_P1); const bf16_t* HL = (const bf16_t*)(F.ws + WS_HALO);
    const float* cw = F.in[I_CONVW]; const float* cb = F.in[I_CONVB];
    const int rb = F.tid >> 5, cgp = F.tid & 31;
    u32x4 raw[12], rawn[12];
    if (F.bid < 288 * 8) conv1_load(P1, HL, F.bid, rb, cgp, raw);
    for (int it = F.bid; it < 288 * 8; it += F.G) {
        const int c = it >> 3, ch0 = (it & 7) * 256 + cgp * 8;
        const bool more = it + F.G < 288 * 8;
        if (more) conv1_load(P1, HL, it + F.G, rb, cgp, rawn);
        f32x4 w[5][2], bb[2];
#pragma unroll
        for (int j = 0; j < 5; ++j) { w[j][0] = *(const f32x4*)(cw + j * 2048 + ch0); w[j][1] = *(const f32x4*)(cw + j * 2048 + ch0 + 4); }
        bb[0] = *(const f32x4*)(cb + ch0); bb[1] = *(const f32x4*)(cb + ch0 + 4);
        u32x4 ov[8];
#pragma unroll
        for (int i = 0; i < 8; ++i) {
            f32x4 a0 = bb[0], a1 = bb[1];
#pragma unroll
            for (int j = 0; j < 5; ++j) { const u32x4 q = raw[i + j];
                a0 += w[j][0] * (f32x4){bflo(q.x), bfhi(q.x), bflo(q.y), bfhi(q.y)}; a1 += w[j][1] * (f32x4){bflo(q.z), bfhi(q.z), bflo(q.w), bfhi(q.w)}; }
            ov[i].x = cvtpk(siluf(a0[0]), siluf(a0[1])); ov[i].y = cvtpk(siluf(a0[2]), siluf(a0[3])); ov[i].z = cvtpk(siluf(a1[0]), siluf(a1[1])); ov[i].w = cvtpk(siluf(a1[2]), siluf(a1[3]));
        }
        __syncthreads();
#pragma unroll
        for (int i = 0; i < 8; ++i) *(u32x4*)(P1 + (size_t)(c * 128 + rb * 8 + i) * P1W + C1_XBC + ch0) = ov[i];
        if (more) {
#pragma unroll
            for (int k = 0; k < 12; ++k) raw[k] = rawn[k];
        }
    }
}
DI void scan1_pre(const Fr& F) {
    const bf16_t* P1 = (const bf16_t*)(F.ws + WS_P1); float* SC = (float*)(F.ws + WS_SCAN);
    const int NGW = F.G * 8, lane = F.lane;
    for (int rec = F.bid * 8 + F.wave; rec < 16 * 2 * 16 * 18; rec += NGW) {
        const int ci = rec % 18, hd = (rec / 18) & 15, d = (rec / (18 * 16)) & 1, b = rec / (18 * 32);
        const bool isx = ci >= 2; const int cc = isx ? ci - 2 : ci, nch = isx ? 16 : 2;
        const int row0 = (isx ? b * SEQ : TX + b * CTXL) + (d ? nch - 1 - cc : cc) * 128;
        const float a = -__expf(F.in[I_ALOG][d * 16 + hd]), dtb = F.in[I_DTB][d * 16 + hd];
        float dt[2];
#pragma unroll
        for (int q = 0; q < 2; ++q) { const int l = 2 * lane + q; const float xr = bf2f(P1[(size_t)(row0 + (d ? 127 - l : l)) * P1W + C1_DT + d * 16 + hd]) + dtb; dt[q] = xr > 20.f ? xr : log1pf(__expf(xr)); }
        const float v0 = a * dt[0], v1 = a * dt[1]; float ps = v0 + v1;
#pragma unroll
        for (int off = 1; off < 64; off <<= 1) { const float t = __shfl_up(ps, off); if (lane >= off) ps += t; }
        const float tot = __shfl(ps, 63), c0 = ps - v1, c1 = ps;
        float* rp = SC + (size_t)rec * 384 + 2 * lane;
        *(f32x2*)rp = (f32x2){dt[0], dt[1]}; *(f32x2*)(rp + 128) = (f32x2){c0, c1}; *(f32x2*)(rp + 256) = (f32x2){dt[0] * __expf(tot - c0), dt[1] * __expf(tot - c1)};
    }
}
DI void ssd_load(const bf16_t* P1, const float* SC, int b, int hd, int g, int st, int tid, u32x4 (&pf)[10], float& scv) {
    const int d = st >= 18, ci = d ? st - 18 : st; const bool isx = ci >= 2; const int cc = isx ? ci - 2 : ci, nch = isx ? 16 : 2;
    const int row0 = (isx ? b * SEQ : TX + b * CTXL) + (d ? nch - 1 - cc : cc) * 128;
#pragma unroll
    for (int i = 0; i < 10; ++i) {
        const int id = tid + 512 * i; int row, col;
        if (i < 2) { row = id >> 3; col = hd * 64 + (id & 7) * 8; }
        else if (i < 6) { const int j = id - 1024; row = j >> 4; col = 1024 + g * 128 + (j & 15) * 8; }
        else { const int j = id - 3072; row = j >> 4; col = 1536 + g * 128 + (j & 15) * 8; }
        pf[i] = *(const u32x4*)(P1 + (size_t)(row0 + row) * P1W + C1_XBC + col);
    }
    if (tid < 384) scv = SC[(size_t)((((b * 2 + d) * 16 + hd) * 18) + ci) * 384 + tid];
}
#ifndef LDS_BAR
#define LDS_BAR() do { asm volatile("s_waitcnt lgkmcnt(0)" ::: "memory"); __builtin_amdgcn_s_barrier(); asm volatile("" ::: "memory"); } while (0)
#endif
DI void ssd_item(const Fr& F, int b, int hd) {
    const bf16_t* P1 = (const bf16_t*)(F.ws + WS_P1); bf16_t* Y = (bf16_t*)(F.ws + WS_H);
    LAS unsigned char* lds = F.lds; const int tid = F.tid, lane = F.lane, wave = F.wave, r = lane & 31, h = lane >> 5;
    const int i16 = lane & 15, q4 = i16 >> 2, p4 = i16 & 3, blk = (lane >> 4) & 1;
    const int g = hd >> 2, pt = wave >> 2, lt = wave < 4 ? wave : 7 - wave;
    LAS float* dtv = (LAS float*)(lds + SS_DT); LAS float* acs = (LAS float*)(lds + SS_ACS); LAS float* sw = (LAS float*)(lds + SS_SW);
    const float* SC = (const float*)(F.ws + WS_SCAN);
    u32x4 pf[10]; float scv = 0.f;
    __syncthreads();
    ssd_load(P1, SC, b, hd, g, 0, tid, pf, scv);
    float Dsk = 0.f; f32x16 hreg = zero16();
    for (int st = 0; st < 36; ++st) {
        const int d = st >= 18, ci = d ? st - 18 : st;
        const bool isx = ci >= 2; const int cc = isx ? ci - 2 : ci, nch = isx ? 16 : 2;
        const int tokbase = (d ? nch - 1 - cc : cc) * 128;
        if (ci == 0) asm volatile("s_waitcnt vmcnt(0)" ::: "memory");
        LDS_BAR();
        if (ci == 0) {
            Dsk = F.in[I_DSKIP][d * 16 + hd];
            hreg = zero16();
            for (int i = tid; i < 64 * SS_BP / 4; i += 512) ((LAS unsigned*)(lds + SS_H + (st & 1) * SS_HB))[i] = 0u;
        }
#pragma unroll
        for (int i = 0; i < 10; ++i) {
            const int id = tid + 512 * i; int row; LAS unsigned char* dst;
            if (i < 2) { row = id >> 3; dst = lds + SS_X + (id & 7) * 16 + (d ? 127 - row : row) * SS_XP; }
            else if (i < 6) { const int j = id - 1024; row = j >> 4; dst = lds + SS_B + (j & 15) * 16 + (d ? 127 - row : row) * SS_BP; }
            else { const int j = id - 3072; row = j >> 4; dst = lds + SS_C + (j & 15) * 16 + (d ? 127 - row : row) * SS_BP; }
            *(LAS u32x4*)dst = pf[i];
        }
        if (tid < 384) dtv[tid] = scv;
        LDS_BAR();
        if (st + 1 < 36) ssd_load(P1, SC, b, hd, g, st + 1, tid, pf, scv);
        float el; const float dtot = __expf(acs[127]);
        asm volatile("s_waitcnt lgkmcnt(0)" ::: "memory");
        if (isx) {
            const int lcol = lt * 32 + r; const float al = acs[lcol]; el = __expf(al);
            const int tok = tokbase + (d ? 127 - lcol : lcol);
            bf16_t* yp = Y + (size_t)(b * SEQ + tok) * DM + hd * 64 + pt * 32 + 4 * h;
            unsigned long long yold[4] = {0ull, 0ull, 0ull, 0ull};
            if (d) {
#pragma unroll
                for (int gq = 0; gq < 4; ++gq) yold[gq] = __hip_atomic_load((unsigned long long*)(yp + 8 * gq), __ATOMIC_RELAXED, __HIP_MEMORY_SCOPE_AGENT);
            }
            f32x16 yacc = zero16();
            for (int stl = 0; stl <= lt; ++stl) {
                f32x16 sa = zero16();
#pragma unroll
                for (int kk = 0; kk < 8; ++kk) {
                    const bf16x8 af = *(const LAS bf16x8*)(lds + SS_B + (stl * 32 + r) * SS_BP + kk * 32 + h * 16);
                    const bf16x8 bf = *(const LAS bf16x8*)(lds + SS_C + lcol * SS_BP + kk * 32 + h * 16);
                    sa = MFMA32(af, bf, sa);
                }
#pragma unroll
                for (int gq = 0; gq < 4; ++gq) {
                    const int s0 = stl * 32 + 8 * gq + 4 * h;
                    const f32x4 a4 = *(const LAS f32x4*)(acs + s0), d4 = *(const LAS f32x4*)(dtv + s0);
#pragma unroll
                    for (int j = 0; j < 4; ++j) { const float e = fexp(fminf(al - a4[j], 0.f)) * d4[j]; sa[4 * gq + j] = (s0 + j <= lcol) ? sa[4 * gq + j] * e : 0.f; }
                }
#pragma unroll
                for (int s2 = 0; s2 < 2; ++s2) {
                    const bf16x8 gf = pack8(sa[8 * s2], sa[8 * s2 + 1], sa[8 * s2 + 2], sa[8 * s2 + 3], sa[8 * s2 + 4], sa[8 * s2 + 5], sa[8 * s2 + 6], sa[8 * s2 + 7]);
                    const LAS unsigned char* xb = lds + SS_X + (stl * 32 + 16 * s2 + 4 * h + q4) * SS_XP + (pt * 32 + 16 * blk + 4 * p4) * 2;
                    const s16x4 lo = trread(xb), hi = trread(xb + 8 * SS_XP);
                    yacc = MFMA32(cat8(lo, hi), gf, yacc);
                }
            }
            f32x16 oa = zero16();
#pragma unroll
            for (int kk = 0; kk < 8; ++kk) {
                const bf16x8 af = *(const LAS bf16x8*)(lds + SS_H + (st & 1) * SS_HB + (pt * 32 + r) * SS_BP + kk * 32 + h * 16);
                const bf16x8 bf = *(const LAS bf16x8*)(lds + SS_C + lcol * SS_BP + kk * 32 + h * 16);
                oa = MFMA32(af, bf, oa);
            }
#pragma unroll
            for (int gq = 0; gq < 4; ++gq) {
                const u32x2 xw = *(const LAS u32x2*)(lds + SS_X + lcol * SS_XP + (pt * 32 + 8 * gq + 4 * h) * 2);
                float y0 = yacc[4 * gq] + el * oa[4 * gq] + Dsk * bflo(xw.x), y1 = yacc[4 * gq + 1] + el * oa[4 * gq + 1] + Dsk * bfhi(xw.x);
                float y2 = yacc[4 * gq + 2] + el * oa[4 * gq + 2] + Dsk * bflo(xw.y), y3 = yacc[4 * gq + 3] + el * oa[4 * gq + 3] + Dsk * bfhi(xw.y);
                unsigned long long* gp = (unsigned long long*)(yp + 8 * gq);
                if (d) { const unsigned long long old = yold[gq]; const unsigned lo = (unsigned)old, hi = (unsigned)(old >> 32);
                    y0 += bflo(lo); y1 += bfhi(lo); y2 += bflo(hi); y3 += bfhi(hi); }
                *gp = (unsigned long long)cvtpk(y0, y1) | ((unsigned long long)cvtpk(y2, y3) << 32);
            }
        }
        {
            f32x16 ha = hreg * dtot;
#pragma unroll
            for (int kk = 0; kk < 8; ++kk) {
                const int k0 = 16 * kk + 8 * h;
                const LAS unsigned char* xb = lds + SS_X + (k0 + q4) * SS_XP + (pt * 32 + 16 * blk + 4 * p4) * 2;
                const s16x4 xl = trread(xb), xh = trread(xb + 4 * SS_XP);
                const f32x4 w0 = *(const LAS f32x4*)(sw + k0), w1 = *(const LAS f32x4*)(sw + k0 + 4);
                const bf16x8 af = pack8(bf2f((unsigned short)xl[0]) * w0[0], bf2f((unsigned short)xl[1]) * w0[1], bf2f((unsigned short)xl[2]) * w0[2], bf2f((unsigned short)xl[3]) * w0[3],
                                        bf2f((unsigned short)xh[0]) * w1[0], bf2f((unsigned short)xh[1]) * w1[1], bf2f((unsigned short)xh[2]) * w1[2], bf2f((unsigned short)xh[3]) * w1[3]);
                const LAS unsigned char* bb = lds + SS_B + (k0 + q4) * SS_BP + (lt * 32 + 16 * blk + 4 * p4) * 2;
                const s16x4 bl = trread(bb), bh = trread(bb + 4 * SS_BP);
                ha = MFMA32(af, cat8(bl, bh), ha);
            }
            hreg = ha;
#pragma unroll
            for (int i = 0; i < 16; ++i) *(LAS unsigned short*)(lds + SS_H + ((st + 1) & 1) * SS_HB + (pt * 32 + crow(i, h)) * SS_BP + (lt * 32 + r) * 2) = (unsigned short)(cvtpk(ha[i], 0.f) & 0xffffu);
        }
    }
}
DI void mix1_phase(const Fr& F) {
    for (int it = F.bid; it < 256; it += F.G) ssd_item(F, it >> 4, it & 15);
#if defined(EXPM) && (EXPM & 4)
    for (int it = F.bid; it < 256; it += F.G) ssd_item(F, it >> 4, it & 15);
#endif
    Fr F2 = F; asm volatile("" : "+v"(F2.lane), "+v"(F2.tid));
    for (int it = F2.bid; it < 1024; it += F2.G) na_item2(F2, it >> 6, (it >> 3) & 7, it & 7);
}
DI void merge1_phase(const Fr& F) {
    bf16_t* P1 = (bf16_t*)(F.ws + WS_P1); const bf16_t* Y = (const bf16_t*)(F.ws + WS_H); const float* gn = F.in[I_GNORM];
    const int NGW = F.G * 8, lane = F.lane;
    f32x4 gv[4];
#pragma unroll
    for (int j = 0; j < 4; ++j) gv[j] = *(const f32x4*)(gn + 16 * lane + 4 * j);
    for (int row0 = F.bid * 8 + F.wave; row0 < TX; row0 += 2 * NGW) {
        const int row1 = row0 + NGW < TX ? row0 + NGW : row0;
        u32x4 zq[2][2], yq[2][2];
#pragma unroll
        for (int q = 0; q < 2; ++q) { const int row = q ? row1 : row0; const bf16_t* zp = P1 + (size_t)row * P1W + 16 * lane; const bf16_t* yp = Y + (size_t)row * DM + 16 * lane;
            zq[q][0] = *(const u32x4*)zp; zq[q][1] = *(const u32x4*)(zp + 8); yq[q][0] = *(const u32x4*)yp; yq[q][1] = *(const u32x4*)(yp + 8); }
#pragma unroll
        for (int q = 0; q < 2; ++q) {
            if (q && row1 == row0) break;
            const int row = q ? row1 : row0; bf16_t* zp = P1 + (size_t)row * P1W + 16 * lane;
            const unsigned zz[8] = {zq[q][0].x, zq[q][0].y, zq[q][0].z, zq[q][0].w, zq[q][1].x, zq[q][1].y, zq[q][1].z, zq[q][1].w};
            const unsigned yy[8] = {yq[q][0].x, yq[q][0].y, yq[q][0].z, yq[q][0].w, yq[q][1].x, yq[q][1].y, yq[q][1].z, yq[q][1].w};
            float v[16]; float s = 0.f;
#pragma unroll
            for (int i = 0; i < 8; ++i) { v[2 * i] = bflo(yy[i]) * siluf(bflo(zz[i])); v[2 * i + 1] = bfhi(yy[i]) * siluf(bfhi(zz[i])); s += v[2 * i] * v[2 * i] + v[2 * i + 1] * v[2 * i + 1]; }
            s += __shfl_xor(s, 1); s += __shfl_xor(s, 2); s += __shfl_xor(s, 4); s += __shfl_xor(s, 8);
            const float rstd = rsqrtf(s * (1.f / 256.f) + EPS);
            u32x4 o0, o1;
            o0.x = cvtpk(v[0] * rstd * gv[0][0], v[1] * rstd * gv[0][1]); o0.y = cvtpk(v[2] * rstd * gv[0][2], v[3] * rstd * gv[0][3]);
            o0.z = cvtpk(v[4] * rstd * gv[1][0], v[5] * rstd * gv[1][1]); o0.w = cvtpk(v[6] * rstd * gv[1][2], v[7] * rstd * gv[1][3]);
            o1.x = cvtpk(v[8] * rstd * gv[2][0], v[9] * rstd * gv[2][1]); o1.y = cvtpk(v[10] * rstd * gv[2][2], v[11] * rstd * gv[2][3]);
            o1.z = cvtpk(v[12] * rstd * gv[3][0], v[13] * rstd * gv[3][1]); o1.w = cvtpk(v[14] * rstd * gv[3][2], v[15] * rstd * gv[3][3]);
            *(u32x4*)zp = o0; *(u32x4*)(zp + 8) = o1;
        }
    }
}

#define XB_TMO      128
#define XB_XCNT(j)  (256  + 64 * (j))
#define XB_XSUB(j)  (1280 + 64 * (j))
#define XB_XGEN(j)  (2304 + 64 * (j))
#define XB_TOP      3328
#define XB_TOPGEN   3392
#define XCD_BAR_WORDS 3456
#define XB_SPIN_CAP (1u << 18)

__device__ __forceinline__ unsigned xb_ld(unsigned* p)              { return __hip_atomic_load(p, __ATOMIC_RELAXED, __HIP_MEMORY_SCOPE_AGENT); }
__device__ __forceinline__ unsigned xb_add(unsigned* p, unsigned v) { return __hip_atomic_fetch_add(p, v, __ATOMIC_RELAXED, __HIP_MEMORY_SCOPE_AGENT); }
__device__ __forceinline__ unsigned xb_xcc_id() { return (unsigned)__builtin_amdgcn_s_getreg((3 << 11) | 20) & 0xFu; }
#define XB_SPIN(cond, bar) do { unsigned _sp = 0; while (cond) { __builtin_amdgcn_s_sleep(1); \
    if ((++_sp & 255u) == 0u) { if (xb_ld(&(bar)[XB_TMO])) break; if (_sp > XB_SPIN_CAP) { atomicAdd(&(bar)[XB_TMO], 1u); break; } } } } while (0)

struct XcdBarrier {
    unsigned* bar; unsigned x;
    volatile LAS unsigned* st;
};

__device__ __forceinline__ XcdBarrier xcd_barrier_post(unsigned* bar, volatile LAS unsigned* st, int tid) {
    XcdBarrier b; b.bar = bar; b.x = xb_xcc_id(); b.st = st;
    if (tid == 0) (void)xb_add(&bar[XB_XCNT(b.x)], 1u);
    return b;
}
__device__ __forceinline__ void xcd_barrier_complete(unsigned* bar, unsigned x, unsigned& nloc, unsigned& nx) {
    const unsigned G = gridDim.x * gridDim.y * gridDim.z;
    unsigned sum, cnt, mine, sp = 0u;
    for (;;) {
        sum = 0u; cnt = 0u; mine = 0u;
#pragma unroll
        for (unsigned j = 0; j < 16; ++j) { const unsigned c = xb_ld(&bar[XB_XCNT(j)]); sum += c; cnt += (c > 0u) ? 1u : 0u; mine = (j == x) ? c : mine; }
        if (sum == G) break;
        __builtin_amdgcn_s_sleep(1);
        if ((++sp & 255u) == 0u) { if (xb_ld(&bar[XB_TMO])) break; if (sp > XB_SPIN_CAP) { atomicAdd(&bar[XB_TMO], 1u); break; } }
    }
    nloc = mine > 0u ? mine : 1u; nx = cnt > 0u ? cnt : 1u;
}

__device__ __forceinline__ void xcd_barrier(const XcdBarrier& b, int tid) {
    asm volatile("s_waitcnt vmcnt(0)" ::: "memory");
    __syncthreads();
    if (tid == 0) {
        unsigned* bar = b.bar;
        __builtin_amdgcn_s_waitcnt(0);
        unsigned nloc = b.st[0], nx = b.st[1];
        if (nloc == 0u) { xcd_barrier_complete(bar, b.x, nloc, nx); b.st[0] = nloc; b.st[1] = nx; }
        const unsigned old = xb_add(&bar[XB_XSUB(b.x)], 1u);
        const unsigned gen = old / nloc;
        if (old + 1u == (gen + 1u) * nloc) {
            __builtin_amdgcn_fence(__ATOMIC_RELEASE, "agent");
            asm volatile("s_waitcnt vmcnt(0)" ::: "memory");
            const unsigned og = xb_add(&bar[XB_TOP], 1u);
            const unsigned tg = og / nx;
            if (og + 1u == (tg + 1u) * nx) xb_add(&bar[XB_TOPGEN], 1u);
            else XB_SPIN(xb_ld(&bar[XB_TOPGEN]) == tg, bar);
            __builtin_amdgcn_fence(__ATOMIC_ACQUIRE, "agent");
            xb_add(&bar[XB_XGEN(b.x)], 1u);
            asm volatile("s_waitcnt vmcnt(0)" ::: "memory");
        } else {
            XB_SPIN(xb_ld(&bar[XB_XGEN(b.x)]) == gen, bar);
            __builtin_amdgcn_fence(__ATOMIC_ACQUIRE, "agent");
            asm volatile("s_waitcnt vmcnt(0)" ::: "memory");
        }
    }
    __syncthreads();
}

DI void refresh(Fr& F, const Params& prm) {
    int wv = F.wave0; asm volatile("" : "+s"(wv));
    int ln = lane_id(); asm volatile("" : "+v"(ln));
    F.wave = wv; F.lane = ln; F.tid = wv * 64 + ln;
    unsigned char* w = prm.ws; asm volatile("" : "+s"(w)); F.ws = w;
    int g_ = gridDim.x; asm volatile("" : "+s"(g_)); F.G = g_;
    float* o = prm.out; asm volatile("" : "+s"(o)); F.out = o;
}
__global__ void __launch_bounds__(512, 2) mega_fwd(Params prm) {
    extern __shared__ __attribute__((aligned(16))) unsigned char lds_raw[];
    cg::grid_group grid = cg::this_grid();
    Fr F; F.lds = (LAS unsigned char*)lds_raw; F.bid = blockIdx.x; F.G = gridDim.x; F.in = prm.in;
    F.wave0 = __builtin_amdgcn_readfirstlane((int)threadIdx.x >> 6);
    refresh(F, prm);
#define WB(off) ((const bf16_t*)(F.ws + (off)))
#define WP(off) ((bf16_t*)(F.ws + (off)))
#define MOD(l, j) ((const float*)(F.ws + WS_MOD) + (size_t)(l) * 17 * 9216 + (j) * 1024)
#define COST ((const float*)(F.ws + WS_ROPE))
#define SSQ ((float*)(F.ws + WS_SSQ))
#define CRES ((float*)(F.ws + WS_CTXRES))
    volatile LAS unsigned* xst = (volatile LAS unsigned*)(F.lds + LDS_BYTES - 16);
    if (F.tid < 4) xst[F.tid] = 0u;
    __syncthreads();
    (void)xcd_barrier_post((unsigned*)(prm.ws + WS_BAR), xst, F.tid);
#define XBAR() do { XcdBarrier xb_; xb_.bar = (unsigned*)(F.ws + WS_BAR); xb_.x = xb_xcc_id(); xb_.st = (volatile LAS unsigned*)(F.lds + LDS_BYTES - 16); xcd_barrier(xb_, lane_id() + 64 * F.wave0); } while (0)
#ifndef EXPM
#define EXPM 0
#endif
#ifdef TPROBE_A
#define SYNC() do { XBAR(); refresh(F, prm); if (F.bid == 0 && F.tid == 0) { ((unsigned long long*)(F.ws + WS_STAMP))[nstamp] = __builtin_amdgcn_s_memrealtime(); } ++nstamp; } while (0)
    int nstamp = 1;
#else
#define SYNC() do { XBAR(); refresh(F, prm); } while (0)
#endif
#ifdef TPROBE_A
    if (F.bid == 0 && F.tid == 0) ((unsigned long long*)(F.ws + WS_STAMP))[40] = __builtin_amdgcn_s_memrealtime();
#endif
#define RES_GEMM_NORM(A_, lda_, W_, K_, rinx_, rinc_, gate_, gs_, lyr_, gn_, jn_) do { \
        run_gemm(F, A_, lda_, W_, TX, DM, K_, pg8::EpiRes{rinx_, rinc_, F.out, CRES, gate_, gs_, 0}); SYNC(); \
        if (F.bid < 64) run_gemm(F, (A_) + (size_t)TX * (lda_), lda_, W_, TC, DM, K_, pg8::EpiRes{rinx_, rinc_, F.out, CRES, gate_, gs_, TX}, 64); \
        else norm_phase(F, lyr_, gn_, jn_, 0, TX, F.out, CRES, WP(WS_H), F.bid - 64, F.G - 64); \
        SYNC(); \
        norm_phase(F, lyr_, gn_, jn_, TX, TT, F.out, CRES, WP(WS_H)); SYNC(); } while (0)
    prep_phase(F); grid.sync(); refresh(F, prm);
#ifdef TPROBE_A
    if (F.bid == 0 && F.tid == 0) ((unsigned long long*)(F.ws + WS_STAMP))[0] = __builtin_amdgcn_s_memrealtime();
#endif
    norm_phase(F, 0, F.in[I_GF1], 0, 0, TT, F.in[I_X], F.in[I_CTX], WP(WS_H)); SYNC();
    run_gemm(F, WB(WS_H), DM, WB(W0_F1I), TT, 2 * FF, DM, pg8::EpiSwiglu{WP(WS_ACT)});
    if (F.G == 256 && F.bid >= 96) conv_l1_part(F, 0, F.bid - 96, 160); else if (F.G != 256) conv_l1_part(F, 0, F.bid, F.G);
    SYNC();
    RES_GEMM_NORM(WB(WS_ACT), FF, WB(W0_F1O), FF, F.in[I_X], F.in[I_CTX], MOD(0, 2), 0.5f, 0, F.in[I_GMIX], 3);
    run_gemm(F, WB(WS_H), DM, WB(W0_ABI), TT, 2048, DM, pg8::EpiAbIn{WP(WS_P0), COST, COST + 1024, SSQ});
    if (F.G == 256 && F.bid >= 128) conv_l1_part(F, 2, F.bid - 128, 128); else if (F.G != 256) conv_l1_part(F, 2, F.bid, F.G);
    SYNC();
    run_gemm(F, WB(WS_P0) + 1536, P0W, WB(W0_UP), TT, QKW, 384, pg8::EpiMlaUp{WP(WS_QKV), SSQ}, 0, 3, 0, 4, 256, 2); SYNC();
#ifndef ATTN_REP
#define ATTN_REP 1
#endif
    attn0_phase(F); SYNC();
    RES_GEMM_NORM(WB(WS_H), DM, WB(W0_ABO), DM, F.out, CRES, MOD(0, 5), 1.f, 0, F.in[I_GF2], 6);
    run_gemm(F, WB(WS_H), DM, WB(W0_F2I), TT, 2 * FF, DM, pg8::EpiSwiglu{WP(WS_ACT)});
    if (F.G == 256 && F.bid >= 96) conv_l1_part(F, 1, F.bid - 96, 160); else if (F.G != 256) conv_l1_part(F, 1, F.bid, F.G);
    SYNC();
    RES_GEMM_NORM(WB(WS_ACT), FF, WB(W0_F2O), FF, F.out, CRES, MOD(0, 8), 0.5f, 1, F.in[I_GF1] + DM, 0);
    run_gemm(F, WB(WS_H), DM, WB(W1_F1I), TT, 2 * FF, DM, pg8::EpiSwiglu{WP(WS_ACT)}); SYNC();
    RES_GEMM_NORM(WB(WS_ACT), FF, WB(W1_F1O), FF, F.out, CRES, MOD(1, 2), 0.5f, 1, F.in[I_GMIX] + DM, 3);
    run_gemm(F, WB(WS_H), DM, WB(W1_CDI), TT, 4864, DM, pg8::EpiStore{WP(WS_P1), P1W, P1W}); SYNC();
    halo1_phase(F); scan1_pre(F); SYNC();
    conv1_phase(F); SYNC();
    mix1_phase(F); SYNC();
    merge1_phase(F); SYNC();
    run_gemm(F, WB(WS_P1), P1W, WB(W1_CDO), TX, DM, 1536, pg8::EpiRes{F.out, CRES, F.out, CRES, MOD(1, 5), 1.f, 0}); SYNC();
    norm_phase(F, 1, F.in[I_GF2] + DM, 6, 0, TX, F.out, CRES, WP(WS_H)); SYNC();
    run_gemm(F, WB(WS_H), DM, WB(W1_F2I), TX, 2 * FF, DM, pg8::EpiSwiglu{WP(WS_ACT)}); SYNC();
    run_gemm(F, WB(WS_ACT), FF, WB(W1_F2O), TX, DM, FF, pg8::EpiRes{F.out, CRES, F.out, CRES, MOD(1, 8), 0.5f, 0}); SYNC();
#ifdef TPROBE_A
    final_norm_phase(F, (int)(((const unsigned long long*)(F.ws + WS_STAMP))[TPROBE_B] - ((const unsigned long long*)(F.ws + WS_STAMP))[TPROBE_A]));
#else
    final_norm_phase(F, 0);
#endif
}

extern "C" void kernel_launch(void* const* d_in, const int* in_sizes, int n_in, void* d_out, int out_size, void* d_ws, size_t ws_size, hipStream_t stream) {
    static int grid = 0;
    if (grid == 0) {
        int dev = 0, cus = 0, per_cu = 0;
        (void)hipGetDevice(&dev); (void)hipDeviceGetAttribute(&cus, hipDeviceAttributeMultiprocessorCount, dev);
        if (hipFuncSetAttribute((const void*)mega_fwd, hipFuncAttributeMaxDynamicSharedMemorySize, LDS_BYTES) != hipSuccess) fprintf(stderr, "kernel_launch: hipFuncSetAttribute failed\n");
        if (hipOccupancyMaxActiveBlocksPerMultiprocessor(&per_cu, (const void*)mega_fwd, 512, LDS_BYTES) != hipSuccess || per_cu < 1) { fprintf(stderr, "kernel_launch: occupancy query gave %d\n", per_cu); per_cu = 1; }
        (void)hipGetLastError();
        if (cus <= 0) cus = 256;
        grid = cus * per_cu;
        if (n_in != 34 || ws_size < WS_END) fprintf(stderr, "kernel_launch: unexpected n_in %d / ws_size %zu (need %zu)\n", n_in, ws_size, (size_t)WS_END);
    }
    Params p{};
    for (int i = 0; i < 34; ++i) p.in[i] = (const float*)d_in[i];
    p.out = (float*)d_out; p.ws = (unsigned char*)d_ws;
    (void)hipMemsetAsync((unsigned char*)d_ws + WS_BAR, 0, 16384, stream);
    void* args[] = {&p};
    hipError_t e = hipLaunchCooperativeKernel((const void*)mega_fwd, dim3(grid), dim3(512), args, LDS_BYTES, stream);
    if (e != hipSuccess) fprintf(stderr, "cooperative launch failed: %s (grid %d)\n", hipGetErrorString(e), grid);
}
```

```cpp
#include <hip/hip_runtime.h>
#include <hip/hip_cooperative_groups.h>
#include <cstdio>
#include <cstdint>
namespace cg = cooperative_groups;

#define DI __device__ __forceinline__
#define LAS __attribute__((address_space(3)))
typedef short bf16x8 __attribute__((ext_vector_type(8)));
typedef short s16x4 __attribute__((ext_vector_type(4)));
typedef float f32x2 __attribute__((ext_vector_type(2)));
typedef float f32x4 __attribute__((ext_vector_type(4)));
typedef float f32x16 __attribute__((ext_vector_type(16)));
typedef unsigned u32x2 __attribute__((ext_vector_type(2)));
typedef unsigned u32x4 __attribute__((ext_vector_type(4)));
typedef __bf16 bf16x2_t __attribute__((ext_vector_type(2)));
typedef unsigned short bf16_t;

constexpr int DM = 1024, NB = 16, SEQ = 2048, CTXL = 256, FF = 2816;
constexpr int TX = NB * SEQ;
constexpr int TC = NB * CTXL;
constexpr int TT = TX + TC;
constexpr float EPS = 1e-6f;
constexpr float LOG2E = 1.4426950408889634f;
constexpr int P0W = 2048;
constexpr int QKW = 1792;
constexpr int P1W = 4640;
constexpr int C1_Q = 1024, C1_K = 1536, C1_V = 2048, C1_XBC = 2560, C1_DT = 4608;

constexpr size_t MiB = 1u << 20;
constexpr size_t WS_MOD = 0;
constexpr size_t WS_ROPE = 2 * MiB;
constexpr size_t WS_SSQ = 2 * MiB + 65536;
constexpr size_t WS_BAR = 2 * MiB + 512 * 1024;
constexpr size_t WS_STAMP = 2 * MiB + 768 * 1024;
constexpr size_t WS_SCAN = 3 * MiB;
constexpr size_t WS_W0 = 3 * MiB;
constexpr size_t W_FFN_IN = (size_t)2 * FF * DM * 2;
constexpr size_t W_FFN_OUT = (size_t)DM * FF * 2;
constexpr size_t W0_F1I = WS_W0, W0_F1O = W0_F1I + W_FFN_IN, W0_F2I = W0_F1O + W_FFN_OUT, W0_F2O = W0_F2I + W_FFN_IN;
constexpr size_t W0_ABI = W0_F2O + W_FFN_OUT;
constexpr size_t W0_UP = W0_ABI + (size_t)2048 * 1024 * 2;
constexpr size_t W0_ABO = W0_UP + (size_t)1536 * 1024;
constexpr size_t WS_W1 = 44 * MiB;
constexpr size_t W1_F1I = WS_W1, W1_F1O = W1_F1I + W_FFN_IN, W1_F2I = W1_F1O + W_FFN_OUT, W1_F2O = W1_F2I + W_FFN_IN;
constexpr size_t W1_CDI = W1_F2O + W_FFN_OUT;
constexpr size_t W1_CDO = W1_CDI + (size_t)4864 * 1024 * 2;
constexpr size_t WS_CTXRES = 90 * MiB;
constexpr size_t WS_H = 106 * MiB;
constexpr size_t WS_BIG = 178 * MiB;
constexpr size_t WS_ACT = WS_BIG;
constexpr size_t WS_P0 = WS_BIG;
constexpr size_t WS_QKV = WS_BIG + 144 * MiB;
constexpr size_t WS_ODS = WS_BIG + 270 * MiB;
constexpr size_t WS_P1 = WS_BIG;
constexpr size_t WS_HALO = WS_BIG + 327 * MiB;
constexpr size_t WS_END = WS_HALO + 5 * MiB;

constexpr int LDS_BYTES = 147456;

DI float bf2f(unsigned short b) { return __uint_as_float((unsigned)b << 16); }
DI float bflo(unsigned w) { return __uint_as_float(w << 16); }
DI float bfhi(unsigned w) { return __uint_as_float(w & 0xffff0000u); }
DI unsigned cvtpk(float lo, float hi) { f32x2 v = {lo, hi}; bf16x2_t b = __builtin_convertvector(v, bf16x2_t); return __builtin_bit_cast(unsigned, b); }
DI float ex2(float x) { return __builtin_amdgcn_exp2f(x); }
DI float fexp(float x) { return __builtin_amdgcn_exp2f(x * LOG2E); }
DI float frcp(float x) { return __builtin_amdgcn_rcpf(x); }
DI float siluf(float x) { return x * frcp(1.f + fexp(-x)); }
DI float wave_sum(float v) {
#pragma unroll
    for (int o = 1; o < 64; o <<= 1) v += __shfl_xor(v, o);
    return v;
}
DI int crow(int reg, int h) { return (reg & 3) + 8 * (reg >> 2) + 4 * h; }
#define MFMA32(a, b, c) __builtin_amdgcn_mfma_f32_32x32x16_bf16((a), (b), (c), 0, 0, 0)
typedef short v4i16_t __attribute__((ext_vector_type(4)));
DI s16x4 trread(const LAS unsigned char* p) { return __builtin_bit_cast(s16x4, __builtin_amdgcn_ds_read_tr16_b64_v4i16((LAS v4i16_t*)p)); }
DI bf16x8 cat8(s16x4 lo, s16x4 hi) { return __builtin_shufflevector(lo, hi, 0, 1, 2, 3, 4, 5, 6, 7); }
DI bf16x8 pack8(float a0, float a1, float a2, float a3, float a4, float a5, float a6, float a7) {
    u32x4 p; p.x = cvtpk(a0, a1); p.y = cvtpk(a2, a3); p.z = cvtpk(a4, a5); p.w = cvtpk(a6, a7); return __builtin_bit_cast(bf16x8, p);
}
DI f32x16 zero16() { f32x16 z;
#pragma unroll
    for (int i = 0; i < 16; ++i) z[i] = 0.f;
    return z; }
DI int lane_id() { unsigned ones = ~0u; asm volatile("" : "+s"(ones)); return (int)__builtin_amdgcn_mbcnt_hi(ones, __builtin_amdgcn_mbcnt_lo(ones, 0u)); }

namespace pg8 {
#define PG8_LAS __attribute__((address_space(3)))

typedef unsigned short bf16_t;
typedef short bf16x8 __attribute__((ext_vector_type(8)));
typedef float f32x4 __attribute__((ext_vector_type(4)));
typedef unsigned u32x4 __attribute__((ext_vector_type(4)));
constexpr int BM = 256, BK = 64, HALF = 128, HTB = HALF * BK * 2  , STAGE_BYTES = 8 * HTB, NXCD = 8, WGM = 8;

__host__ __device__ __forceinline__ int lds_byte(int r, int c) { const int st = (r >> 4) * 2 + (c >> 5), rr = r & 15, cc = c & 31, ob = rr * 64 + cc * 2; return st * 1024 + (ob ^ (((ob >> 9) & 1) << 5)); }
__host__ __device__ __forceinline__ void stage_rc(int b, int& R, int& C) { const int st = b / 1024, sb = b % 1024, swz = sb ^ (((sb >> 9) & 1) << 5); R = (st >> 1) * 16 + swz / 64; C = (st & 1) * 32 + (swz % 64) / 2; }
__host__ __device__ __forceinline__ int perm32(int rho) { const int n = rho >> 4, i = rho & 15; return 8 * (i >> 2) + 4 * n + (i & 3); }

struct Unit { int pm, pn; };
struct Gemm { const bf16_t* A; const bf16_t* Bt; int M, N, K, lda; int pn_split, k0_lo, nt_lo, k0_hi, nt_hi; };

struct StaticOrder {
    int nM, nN, nwg, G, c;
    __host__ __device__ void init(int M, int N, int G_, int c_) { nM = M / BM; nN = N / BM; nwg = nM * nN; G = G_; c = c_; }
    __host__ __device__ bool next(int i, Unit& u) const {
        const long L = (long)i * G + c; if (L >= nwg) return false;
        int wgid = (int)L; { const int q = nwg / NXCD, r = nwg % NXCD, xcd = wgid % NXCD, off = wgid / NXCD; wgid = (xcd < r ? xcd * (q + 1) : r * (q + 1) + (xcd - r) * q) + off; }
        const int nig = WGM * nN, gid = wgid / nig, fm = gid * WGM, gsz = (nM - fm) < WGM ? (nM - fm) : WGM;
        u.pm = fm + ((wgid % nig) % gsz); u.pn = (wgid % nig) / gsz; return true;
    }
    __device__ __forceinline__ void a_ready(const Unit&) const {}
    __device__ __forceinline__ void done(const Unit&) const {}
};


template <class Epi, class Sched, bool ALIGN_EPI = false, bool SP2 = false>
__device__ __forceinline__ void gemm_phase(PG8_LAS unsigned char* lds, const Gemm g, const Sched& S, const Epi& E, int tid_in) {
    int tid_ = tid_in; asm volatile("" : "+v"(tid_));
    const int tid = tid_, wid = __builtin_amdgcn_readfirstlane(tid >> 6), lane = tid & 63, wr = wid >> 2, wc = wid & 3, fr = lane & 15, fq = lane >> 4;
    const int K = g.K;
#define PG8_KOF(u) ((size_t)(((u).pn < g.pn_split) ? g.k0_lo : g.k0_hi) * 2)
#define PG8_NT(u) (((u).pn < g.pn_split) ? g.nt_lo : g.nt_hi)
    unsigned voffA[2], voffB[2];
#pragma unroll
    for (int i = 0; i < 2; ++i) { int R, C; stage_rc(tid * 16 + i * 8192, R, C); const int Rb = Epi::PERM ? ((R & ~31) + perm32(R & 31)) : R;
        voffA[i] = (unsigned)(R * g.lda + C) * 2u; voffB[i] = (unsigned)(Rb * K + C) * 2u; }
    const size_t kstep = (size_t)(BK * 2);
    const size_t hstepB = (size_t)HALF * K * 2, hstepA = (size_t)HALF * g.lda * 2;
    const size_t tstepA = 2 * hstepA, tstepB = 2 * hstepB;
    const unsigned ldsw = (unsigned)wid * 1024u;
    const int aoff = lds_byte(wr * 64 + fr, fq * 8), boff = lds_byte(wc * 32 + fr, fq * 8);
#define PG8_SA(b, h) (((b) * 2 + (h)) * HTB)
#define PG8_SB(b, h) ((4 + (b) * 2 + (h)) * HTB)
#define PG8_STAGE(bufoff, gbase, voff) do { _Pragma("unroll") for (int _i = 0; _i < 2; ++_i) \
        __builtin_amdgcn_global_load_lds((const unsigned*)((const char*)(gbase) + (voff)[_i]), (PG8_LAS unsigned*)(lds + (bufoff) + ldsw + _i * 8192), 16, 0, 0); } while (0)
#define PG8_LDA(dst, b, h) do { _Pragma("unroll") for (int m = 0; m < 4; ++m) _Pragma("unroll") for (int k = 0; k < 2; ++k) dst[m][k] = *(const PG8_LAS bf16x8*)(lds + PG8_SA(b, h) + aoff + m * 2048 + k * 1024); } while (0)
#define PG8_LDB(dst, b, h) do { _Pragma("unroll") for (int n = 0; n < 2; ++n) _Pragma("unroll") for (int k = 0; k < 2; ++k) dst[n][k] = *(const PG8_LAS bf16x8*)(lds + PG8_SB(b, h) + boff + n * 2048 + k * 1024); } while (0)
#define PG8_MMA(ai, bj, At, Bt) do { __builtin_amdgcn_s_setprio(1); _Pragma("unroll") for (int m = 0; m < 4; ++m) _Pragma("unroll") for (int n = 0; n < 2; ++n) _Pragma("unroll") for (int k = 0; k < 2; ++k) \
        acc[ai][bj][m][n] = __builtin_amdgcn_mfma_f32_16x16x32_bf16(Bt[n][k], At[m][k], acc[ai][bj][m][n], 0, 0, 0); __builtin_amdgcn_s_setprio(0); } while (0)
#define PG8_WAIT_V(n) asm volatile("s_waitcnt vmcnt(" #n ")" ::: "memory")
#define PG8_WAIT_L(n) asm volatile("s_waitcnt lgkmcnt(" #n ")" ::: "memory")
#define PG8_BAR __builtin_amdgcn_s_barrier()
#define PG8_SCHED __builtin_amdgcn_sched_barrier(0)
    Unit cur, nxt; int ui = 0;
    if (!S.next(0, cur)) return;
    f32x4 acc[2][2][4][2];
#pragma unroll
    for (int a = 0; a < 2; ++a)
#pragma unroll
        for (int b = 0; b < 2; ++b)
#pragma unroll
            for (int m = 0; m < 4; ++m)
#pragma unroll
                for (int n = 0; n < 2; ++n) acc[a][b][m][n] = (f32x4){0.f, 0.f, 0.f, 0.f};
    bf16x8 At[4][2], B0[2][2], B1[2][2];
    const char* cA = (const char*)g.A + (size_t)cur.pm * tstepA + PG8_KOF(cur); const char* cB = (const char*)g.Bt + (size_t)cur.pn * tstepB + PG8_KOF(cur);
    int nt = PG8_NT(cur);
    S.a_ready(cur);
    if constexpr (SP2) {
        PG8_STAGE(PG8_SB(0, 0), cB, voffB); PG8_STAGE(PG8_SB(0, 1), cB + hstepB, voffB); PG8_STAGE(PG8_SA(0, 0), cA, voffA); PG8_STAGE(PG8_SA(0, 1), cA + hstepA, voffA);
        if (wr == 1) PG8_BAR;
        PG8_WAIT_V(2); PG8_BAR;
        PG8_STAGE(PG8_SB(1, 0), cB + kstep, voffB); PG8_STAGE(PG8_SA(1, 0), cA + kstep, voffA); PG8_STAGE(PG8_SB(1, 1), cB + hstepB + kstep, voffB);
        PG8_WAIT_V(6); PG8_BAR;
    } else {
        PG8_STAGE(PG8_SB(0, 0), cB, voffB); PG8_STAGE(PG8_SA(0, 0), cA, voffA); PG8_STAGE(PG8_SB(0, 1), cB + hstepB, voffB); PG8_STAGE(PG8_SA(0, 1), cA + hstepA, voffA);
        if (wr == 1) PG8_BAR;
        PG8_WAIT_V(4); PG8_BAR;
        PG8_STAGE(PG8_SB(1, 0), cB + kstep, voffB); PG8_STAGE(PG8_SA(1, 0), cA + kstep, voffA); PG8_STAGE(PG8_SB(1, 1), cB + hstepB + kstep, voffB);
        PG8_WAIT_V(6); PG8_BAR;
    }
    for (;;) {
        const bool has_next = S.next(ui + 1, nxt);
        const char* nA = has_next ? (const char*)g.A + (size_t)nxt.pm * tstepA + PG8_KOF(nxt) : cA; const char* nB = has_next ? (const char*)g.Bt + (size_t)nxt.pn * tstepB + PG8_KOF(nxt) : cB;
        for (int t = 0; t < nt; t += 2) {
            const bool last = (t == nt - 2);
            const char* a1 = cA + (size_t)(t + 1) * kstep;
            const char* a2 = last ? nA : cA + (size_t)(t + 2) * kstep; const char* b2 = last ? nB : cB + (size_t)(t + 2) * kstep;
            const char* a3 = a2 + kstep; const char* b3 = b2 + kstep;
            if (last && has_next) S.a_ready(nxt);
            if constexpr (SP2) {
            PG8_LDB(B0, 0, 0); PG8_LDB(B1, 0, 1); PG8_SCHED; PG8_LDA(At, 0, 0); PG8_STAGE(PG8_SA(1, 1), a1 + hstepA, voffA);
            PG8_WAIT_V(8); PG8_WAIT_L(0); PG8_BAR; PG8_MMA(0, 0, At, B0); PG8_MMA(0, 1, At, B1); PG8_BAR; PG8_SCHED;
            PG8_LDA(At, 0, 1); PG8_STAGE(PG8_SB(0, 0), b2, voffB); PG8_STAGE(PG8_SB(0, 1), b2 + hstepB, voffB); PG8_STAGE(PG8_SA(0, 0), a2, voffA);
            PG8_WAIT_V(8); PG8_WAIT_L(0); PG8_BAR; PG8_MMA(1, 0, At, B0); PG8_MMA(1, 1, At, B1); PG8_BAR; PG8_SCHED;
            PG8_LDB(B0, 1, 0); PG8_LDB(B1, 1, 1); PG8_SCHED; PG8_LDA(At, 1, 0); PG8_STAGE(PG8_SA(0, 1), a2 + hstepA, voffA);
            PG8_WAIT_V(8); PG8_WAIT_L(0); PG8_BAR; PG8_MMA(0, 0, At, B0); PG8_MMA(0, 1, At, B1); PG8_BAR; PG8_SCHED;
            PG8_LDA(At, 1, 1); PG8_STAGE(PG8_SB(1, 0), b3, voffB); PG8_STAGE(PG8_SB(1, 1), b3 + hstepB, voffB); PG8_STAGE(PG8_SA(1, 0), a3, voffA);
            PG8_WAIT_V(8); PG8_WAIT_L(0); PG8_BAR; PG8_MMA(1, 0, At, B0); PG8_MMA(1, 1, At, B1); PG8_BAR; PG8_SCHED;
            } else {
            PG8_LDB(B0, 0, 0); PG8_SCHED; PG8_LDA(At, 0, 0); PG8_STAGE(PG8_SA(1, 1), a1 + hstepA, voffA);
            PG8_WAIT_L(8); PG8_BAR; PG8_WAIT_L(0); PG8_MMA(0, 0, At, B0); PG8_BAR; PG8_SCHED;
            PG8_LDB(B1, 0, 1); PG8_STAGE(PG8_SB(0, 0), b2, voffB);
            PG8_BAR; PG8_WAIT_L(0); PG8_MMA(0, 1, At, B1); PG8_BAR;
            PG8_LDA(At, 0, 1); PG8_STAGE(PG8_SA(0, 0), a2, voffA);
            PG8_BAR; PG8_WAIT_L(0); PG8_MMA(1, 0, At, B0); PG8_BAR; PG8_SCHED;
            PG8_STAGE(PG8_SB(0, 1), b2 + hstepB, voffB);
            PG8_WAIT_V(6); PG8_BAR; PG8_MMA(1, 1, At, B1); PG8_BAR;
            PG8_LDB(B0, 1, 0); PG8_SCHED; PG8_LDA(At, 1, 0); PG8_STAGE(PG8_SA(0, 1), a2 + hstepA, voffA);
            PG8_WAIT_L(8); PG8_BAR; PG8_WAIT_L(0); PG8_MMA(0, 0, At, B0); PG8_BAR; PG8_SCHED;
            PG8_LDB(B1, 1, 1); PG8_STAGE(PG8_SB(1, 0), b3, voffB);
            PG8_BAR; PG8_WAIT_L(0); PG8_MMA(0, 1, At, B1); PG8_BAR;
            PG8_LDA(At, 1, 1); PG8_STAGE(PG8_SA(1, 0), a3, voffA);
            PG8_BAR; PG8_WAIT_L(0); PG8_MMA(1, 0, At, B0); PG8_BAR; PG8_SCHED;
            PG8_STAGE(PG8_SB(1, 1), b3 + hstepB, voffB);
            PG8_WAIT_V(6); PG8_BAR; PG8_MMA(1, 1, At, B1); PG8_BAR;
            }
        }
        if constexpr (ALIGN_EPI) { if (wr == 0) PG8_BAR; }
        if constexpr (!Epi::AFTER_DRAIN) { E(acc, cur, wr, wc, fr, fq); S.done(cur); }
        if (!has_next) break;
#pragma unroll
        for (int a = 0; a < 2; ++a)
#pragma unroll
            for (int b = 0; b < 2; ++b)
#pragma unroll
                for (int m = 0; m < 4; ++m)
#pragma unroll
                    for (int n = 0; n < 2; ++n) acc[a][b][m][n] = (f32x4){0.f, 0.f, 0.f, 0.f};
        cur = nxt; cA = nA; cB = nB; ++ui; nt = PG8_NT(cur);
        if constexpr (ALIGN_EPI) { if (wr == 1) PG8_BAR; }
    }
    PG8_WAIT_V(0);
    if constexpr (!ALIGN_EPI) { if (wr == 0) PG8_BAR; }
    PG8_BAR;
    if constexpr (Epi::AFTER_DRAIN) { E.fused(acc, cur, wr, wc, fr, fq, lds, wid, lane); S.done(cur); }
#undef PG8_KOF
#undef PG8_NT
#undef PG8_SA
#undef PG8_SB
#undef PG8_STAGE
#undef PG8_LDA
#undef PG8_LDB
#undef PG8_MMA
#undef PG8_WAIT_V
#undef PG8_WAIT_L
#undef PG8_BAR
#undef PG8_SCHED
}
}


namespace pg8 {
struct EpiSwiglu {
    static constexpr bool PERM = true, AFTER_DRAIN = false;
    bf16_t* O;
    __device__ __forceinline__ void operator()(const f32x4 (&acc)[2][2][4][2], const Unit& u, int wr, int wc, int fr, int fq) const {
        const int row0 = u.pm * BM + wr * 64 + fr, col0 = u.pn * 128 + wc * 32 + 8 * fq;
#pragma unroll
        for (int ai = 0; ai < 2; ++ai)
#pragma unroll
            for (int m = 0; m < 4; ++m) {
                const f32x4 g0 = acc[ai][0][m][0], g1 = acc[ai][0][m][1], u0 = acc[ai][1][m][0], u1 = acc[ai][1][m][1];
                u32x4 w;
                w.x = cvtpk(siluf(g0[0]) * u0[0], siluf(g0[1]) * u0[1]); w.y = cvtpk(siluf(g0[2]) * u0[2], siluf(g0[3]) * u0[3]);
                w.z = cvtpk(siluf(g1[0]) * u1[0], siluf(g1[1]) * u1[1]); w.w = cvtpk(siluf(g1[2]) * u1[2], siluf(g1[3]) * u1[3]);
                *(u32x4*)(O + (size_t)(row0 + ai * HALF + m * 16) * FF + col0) = w;
            }
    }
};
struct EpiRes {
    static constexpr bool PERM = false, AFTER_DRAIN = false;
    const float* rin_x; const float* rin_c; float* rout_x; float* rout_c; const float* gate  ; float gs; int roff;
    __device__ __forceinline__ void operator()(const f32x4 (&acc)[2][2][4][2], const Unit& u, int wr, int wc, int fr, int fq) const {
        const int rowb = roff + u.pm * BM; const bool isx = rowb < TX;
        const float* gp = gate + (size_t)(isx ? (rowb >> 11) : 16) * 9216 + u.pn * BM + wc * 32 + 4 * fq;
        f32x4 gv[2][2];
#pragma unroll
        for (int bj = 0; bj < 2; ++bj)
#pragma unroll
            for (int n = 0; n < 2; ++n) gv[bj][n] = *(const f32x4*)(gp + bj * HALF + n * 16) * gs;
        const float* ri0 = (isx ? rin_x + (size_t)rowb * DM : rin_c + (size_t)(rowb - TX) * DM) + (size_t)(wr * 64 + fr) * DM + u.pn * BM + wc * 32 + 4 * fq;
        float* ro0 = (isx ? rout_x + (size_t)rowb * DM : rout_c + (size_t)(rowb - TX) * DM) + (size_t)(wr * 64 + fr) * DM + u.pn * BM + wc * 32 + 4 * fq;
#pragma unroll
        for (int ai = 0; ai < 2; ++ai)
#pragma unroll
            for (int mp = 0; mp < 2; ++mp) {
                f32x4 rv[2][2][2];
#pragma unroll
                for (int mm = 0; mm < 2; ++mm)
#pragma unroll
                    for (int bj = 0; bj < 2; ++bj)
#pragma unroll
                        for (int n = 0; n < 2; ++n) rv[mm][bj][n] = *(const f32x4*)(ri0 + (size_t)(ai * HALF + (2 * mp + mm) * 16) * DM + bj * HALF + n * 16);
#pragma unroll
                for (int mm = 0; mm < 2; ++mm)
#pragma unroll
                    for (int bj = 0; bj < 2; ++bj)
#pragma unroll
                        for (int n = 0; n < 2; ++n) *(f32x4*)(ro0 + (size_t)(ai * HALF + (2 * mp + mm) * 16) * DM + bj * HALF + n * 16) = rv[mm][bj][n] + gv[bj][n] * acc[ai][bj][2 * mp + mm][n];
                asm volatile("" ::: "memory");
            }
    }
};
struct EpiAbIn {
    static constexpr bool PERM = false, AFTER_DRAIN = false;
    bf16_t* P; const float* cosT; const float* sinT; float* ssq;
    __device__ __forceinline__ void operator()(const f32x4 (&acc)[2][2][4][2], const Unit& u, int wr, int wc, int fr, int fq) const {
#pragma unroll
        for (int ai = 0; ai < 2; ++ai)
#pragma unroll
            for (int m = 0; m < 4; ++m) {
                const int row = u.pm * BM + ai * HALF + wr * 64 + m * 16 + fr;
                const bool isx = row < TX; const int t = row & 2047, prow = t >> 6, pcol = t & 63;
                float sq = 0.f;
#pragma unroll
                for (int bj = 0; bj < 2; ++bj) {
                    const int cb = u.pn * BM + bj * HALF + wc * 32;
                    if (cb >= 1984) continue;
                    f32x4 v0 = acc[ai][bj][m][0], v1 = acc[ai][bj][m][1];
                    if (cb >= 1536 && cb < 1920) sq += (v0[0] * v0[0] + v0[1] * v0[1]) + (v0[2] * v0[2] + v0[3] * v0[3]) + (v1[0] * v1[0] + v1[1] * v1[1]) + (v1[2] * v1[2] + v1[3] * v1[3]);
                    if (isx && (cb < 1024 || cb >= 1920)) {
                        const int pos = ((cb >> 5) & 1) ? pcol : prow;
                        const f32x4 cs = *(const f32x4*)(cosT + pos * 16 + 4 * fq), sn = *(const f32x4*)(sinT + pos * 16 + 4 * fq);
                        const f32x4 o0 = v0 * cs - v1 * sn, o1 = v1 * cs + v0 * sn; v0 = o0; v1 = o1;
                    }
                    u32x2 w0, w1; w0.x = cvtpk(v0[0], v0[1]); w0.y = cvtpk(v0[2], v0[3]); w1.x = cvtpk(v1[0], v1[1]); w1.y = cvtpk(v1[2], v1[3]);
                    bf16_t* dst = P + (size_t)row * P0W + cb + 4 * fq;
                    *(u32x2*)dst = w0; *(u32x2*)(dst + 16) = w1;
                }
                if (u.pn >= 6) {
                    sq += __shfl_xor(sq, 16); sq += __shfl_xor(sq, 32);
                    if (fq == 0) atomicAdd(ssq + (size_t)row * 2 + (u.pn - 6), sq);
                }
                asm volatile("" ::: "memory");
            }
    }
};
struct EpiMlaUp {
    static constexpr bool PERM = false, AFTER_DRAIN = false;
    bf16_t* O; const float* ssq;
    __device__ __forceinline__ void operator()(const f32x4 (&acc)[2][2][4][2], const Unit& u, int wr, int wc, int fr, int fq) const {
        const bool kv = u.pn >= 3;
#pragma unroll
        for (int ai = 0; ai < 2; ++ai)
#pragma unroll
            for (int m = 0; m < 4; ++m) {
                const int row = u.pm * BM + ai * HALF + wr * 64 + m * 16 + fr;
                float s = 1.f;
                if (kv) s = rsqrtf(ssq[(size_t)row * 2 + 1] * (1.f / 128.f) + EPS);
#pragma unroll
                for (int bj = 0; bj < 2; ++bj)
#pragma unroll
                    for (int n = 0; n < 2; ++n) {
                        const int c = u.pn * BM + bj * HALF + wc * 32 + n * 16 + 4 * fq;
                        const f32x4 v = acc[ai][bj][m][n] * s; u32x2 w; w.x = cvtpk(v[0], v[1]); w.y = cvtpk(v[2], v[3]);
                        *(u32x2*)(O + (size_t)row * QKW + c) = w;
                    }
                asm volatile("" ::: "memory");
            }
    }
};
struct EpiStore {
    static constexpr bool PERM = false, AFTER_DRAIN = false;
    bf16_t* O; int ldc, ncols;
    __device__ __forceinline__ void operator()(const f32x4 (&acc)[2][2][4][2], const Unit& u, int wr, int wc, int fr, int fq) const {
#pragma unroll
        for (int ai = 0; ai < 2; ++ai)
#pragma unroll
            for (int m = 0; m < 4; ++m) {
                const int row = u.pm * BM + ai * HALF + wr * 64 + m * 16 + fr;
#pragma unroll
                for (int bj = 0; bj < 2; ++bj)
#pragma unroll
                    for (int n = 0; n < 2; ++n) {
                        const int c = u.pn * BM + bj * HALF + wc * 32 + n * 16 + 4 * fq;
                        if (c < ncols) { const f32x4 v = acc[ai][bj][m][n]; u32x2 w; w.x = cvtpk(v[0], v[1]); w.y = cvtpk(v[2], v[3]); *(u32x2*)(O + (size_t)row * ldc + c) = w; }
                    }
                asm volatile("" ::: "memory");
            }
    }
};
}

struct Params { const float* in[34]; float* out; unsigned char* ws; };
struct Fr {
    LAS unsigned char* lds; int tid, lane, wave, bid, G, wave0;
    const float* const* in; float* out; unsigned char* ws;
};
enum { I_X = 0, I_C, I_CTX, I_CCTX, I_WMOD, I_BMOD, I_GF1, I_WF1I, I_WF1O, I_GMIX, I_GF2, I_WF2I, I_WF2O, I_ABWIN, I_LQ1, I_LK1, I_LQ2, I_LK2, I_GSUB, I_GQ, I_WUQ, I_GKV,
       I_WUKV, I_ABWOUT, I_CDWIN, I_CONVW, I_CONVB, I_DTB, I_ALOG, I_DSKIP, I_GNORM, I_RPB, I_CDWOUT, I_GFINAL };

template <class Epi> DI void run_gemm(const Fr& F, const bf16_t* A, int lda, const bf16_t* Bt, int M, int N, int K, const Epi& E, int Gsub = 0, int pn_split = 0, int k0_lo = 0, int nt_lo = 0, int k0_hi = 0, int nt_hi = -1) {
    asm volatile("" : "+s"(K));
    if (nt_hi < 0) nt_hi = K / 64;
    asm volatile("" : "+s"(nt_hi), "+s"(nt_lo));
    pg8::Gemm g{A, Bt, M, N, K, lda, pn_split, k0_lo, nt_lo, k0_hi, nt_hi}; pg8::StaticOrder S; S.init(M, N, Gsub ? Gsub : F.G, F.bid);
    pg8::gemm_phase<Epi, pg8::StaticOrder, true, true>(F.lds, g, S, E, F.tid);
}

DI void mod_phase(const Fr& F) {
    LAS float* sc = (LAS float*)F.lds;
    LAS float* red = sc + 17 * 1024;
    const float* c = F.in[I_C]; const float* cc = F.in[I_CCTX];
    for (int i = F.tid; i < 17 * 1024; i += 512) { const int m = i >> 10, k = i & 1023; const float v = m < 16 ? c[m * 1024 + k] : cc[k]; sc[i] = v / (1.f + __expf(-v)); }
    __syncthreads();
    const float* wmod = F.in[I_WMOD]; const float* bmod = F.in[I_BMOD]; float* mod = (float*)(F.ws + WS_MOD);
    for (int item = F.bid; item < 288; item += F.G) {
        const int l = item / 144, n0 = (item % 144) * 64, kp = F.wave;
        const float* wp = wmod + (size_t)l * 1024 * 9216 + n0 + F.lane;
        float acc[17];
#pragma unroll
        for (int m = 0; m < 17; ++m) acc[m] = 0.f;
#pragma unroll 4
        for (int k = kp * 128; k < kp * 128 + 128; k += 4) {
            const float w0 = wp[(size_t)k * 9216], w1 = wp[(size_t)(k + 1) * 9216], w2 = wp[(size_t)(k + 2) * 9216], w3 = wp[(size_t)(k + 3) * 9216];
#pragma unroll
            for (int m = 0; m < 17; ++m) { const f32x4 s = *(const LAS f32x4*)(sc + m * 1024 + k); acc[m] += (w0 * s[0] + w1 * s[1]) + (w2 * s[2] + w3 * s[3]); }
        }
#pragma unroll
        for (int m = 0; m < 17; ++m) red[(kp * 17 + m) * 64 + F.lane] = acc[m];
        __syncthreads();
        for (int i = F.tid; i < 17 * 64; i += 512) {
            const int m = i >> 6, cl = i & 63; float s = 0.f;
#pragma unroll
            for (int q = 0; q < 8; ++q) s += red[(q * 17 + m) * 64 + cl];
            mod[(size_t)(l * 17 + m) * 9216 + n0 + cl] = s + bmod[l * 9216 + n0 + cl];
        }
        __syncthreads();
    }
}
DI int maprow(int mode, int n0) {
    if (mode == 1) { const int up = n0 >= FF, j = up ? n0 - FF : n0; return (j >> 7) * 256 + (up ? 128 : 0) + (j & 127); }
    if (mode == 2) {
        if (n0 < 1024) return n0; if (n0 < 3072) return n0 - 1024 + C1_XBC; if (n0 < 3104) return n0 - 3072 + C1_DT;
        if (n0 < 3616) return n0 - 3104 + C1_Q; if (n0 < 4128) return n0 - 3616 + C1_K; return n0 - 4128 + C1_V;
    }
    return n0;
}
DI void conv_job(const Fr& F, int& base, const float* W, int K, int N, bf16_t* dst, int ldk, int koff, int mode, int rowoff, const float* kscale, int vb = -1, int nvb = 0) {
    LAS float* scr = (LAS float*)(F.lds + F.wave * 8448);
    if (vb < 0) { vb = F.bid; nvb = F.G; }
    const int NGW = nvb * 8, gw = vb * 8 + F.wave, nblk = N / 32, nitems = (K / 64) * nblk, lane = F.lane;
    for (int it = ((gw - base) % NGW + NGW) % NGW; it < nitems; it += NGW) {
        const int kb = it / nblk, nb = it % nblk, k0 = 64 * kb, n0 = 32 * nb;
#pragma unroll
        for (int i = 0; i < 32; ++i) { const int kk = 2 * i + (lane >> 5); float v = __builtin_nontemporal_load(W + (size_t)(k0 + kk) * N + n0 + (lane & 31));
 if (kscale) v *= kscale[k0 + kk]; scr[kk * 33 + (lane & 31)] = v; }
        asm volatile("s_waitcnt lgkmcnt(0)" ::: "memory");
        const int c = lane & 7, dr0 = rowoff + maprow(mode, n0);
#pragma unroll
        for (int j = 0; j < 4; ++j) {
            const int n = (lane >> 3) + 8 * j; const LAS float* s = scr + (8 * c) * 33 + n;
            u32x4 o; o.x = cvtpk(s[0 * 33], s[1 * 33]); o.y = cvtpk(s[2 * 33], s[3 * 33]); o.z = cvtpk(s[4 * 33], s[5 * 33]); o.w = cvtpk(s[6 * 33], s[7 * 33]);
            *(u32x4*)(dst + (size_t)(dr0 + n) * ldk + koff + k0 + 8 * c) = o;
        }
        asm volatile("s_waitcnt lgkmcnt(0)" ::: "memory");
    }
    base = (base + nitems) % NGW;
}
DI void zero_rect(const Fr& F, unsigned char* base, size_t pitch, int nrows, int chunks_per_row) {
    const int n = nrows * chunks_per_row; const u32x4 z = {0u, 0u, 0u, 0u};
    for (int i = F.bid * 512 + F.tid; i < n; i += F.G * 512) { const int r = i / chunks_per_row, c = i % chunks_per_row; *(u32x4*)(base + (size_t)r * pitch + (size_t)c * 16) = z; }
}
DI void prep_phase(const Fr& F) {
    mod_phase(F);
    int base = 0; unsigned char* ws = F.ws;
    const size_t LIN = (size_t)DM * 2 * FF, LOUT = (size_t)FF * DM;
    conv_job(F, base, F.in[I_WF1I], DM, 2 * FF, (bf16_t*)(ws + W0_F1I), DM, 0, 1, 0, nullptr);
    conv_job(F, base, F.in[I_WF1O], FF, DM, (bf16_t*)(ws + W0_F1O), FF, 0, 0, 0, nullptr);
    conv_job(F, base, F.in[I_WF2I], DM, 2 * FF, (bf16_t*)(ws + W0_F2I), DM, 0, 1, 0, nullptr);
    conv_job(F, base, F.in[I_WF2O], FF, DM, (bf16_t*)(ws + W0_F2O), FF, 0, 0, 0, nullptr);
    conv_job(F, base, F.in[I_ABWIN], DM, 1984, (bf16_t*)(ws + W0_ABI), DM, 0, 0, 0, nullptr);
    conv_job(F, base, F.in[I_WUQ], 256, 768, (bf16_t*)(ws + W0_UP), 384, 0, 0, 0, F.in[I_GQ]);
    conv_job(F, base, F.in[I_WUKV], 128, 1024, (bf16_t*)(ws + W0_UP), 384, 256, 0, 768, F.in[I_GKV]);
    conv_job(F, base, F.in[I_ABWOUT], DM, DM, (bf16_t*)(ws + W0_ABO), DM, 0, 0, 0, nullptr);
    zero_rect(F, ws + W0_ABI + (size_t)1984 * 2048, 2048, 64, 128);
    zero_rect(F, ws + W0_UP + 512, 768, 768, 16);
    zero_rect(F, ws + W0_UP + (size_t)768 * 768, 768, 1024, 32);
    zero_rect(F, ws + WS_SSQ, (size_t)TT * 8, 1, TT * 8 / 16);
    if (F.bid == 0) {
        float* cosT = (float*)(ws + WS_ROPE); float* sinT = cosT + 1024;
        for (int i = F.tid; i < 1024; i += 512) {
            const int pos = i >> 4, fi = i & 15;
            const float freq = exp2f(-(float)fi * (13.287712379549449f / 16.f));
            const float ang = (float)pos * freq;
            const double tp = 6.283185307179586476925; const double n = __builtin_rint((double)ang / tp); const float r = (float)((double)ang - n * tp);
            cosT[i] = __cosf(r); sinT[i] = __sinf(r);
        }
    }
}
DI void conv_l1_part(const Fr& F, int part, int vb, int nvb) {
    int base = 0; unsigned char* ws = F.ws;
    const size_t LIN = (size_t)DM * 2 * FF, LOUT = (size_t)FF * DM;
    if (part == 0) {
        conv_job(F, base, F.in[I_WF1I] + LIN, DM, 2 * FF, (bf16_t*)(ws + W1_F1I), DM, 0, 1, 0, nullptr, vb, nvb);
        conv_job(F, base, F.in[I_WF1O] + LOUT, FF, DM, (bf16_t*)(ws + W1_F1O), FF, 0, 0, 0, nullptr, vb, nvb);
    } else if (part == 1) {
        conv_job(F, base, F.in[I_WF2I] + LIN, DM, 2 * FF, (bf16_t*)(ws + W1_F2I), DM, 0, 1, 0, nullptr, vb, nvb);
        conv_job(F, base, F.in[I_WF2O] + LOUT, FF, DM, (bf16_t*)(ws + W1_F2O), FF, 0, 0, 0, nullptr, vb, nvb);
    } else {
        conv_job(F, base, F.in[I_CDWIN], DM, 4640, (bf16_t*)(ws + W1_CDI), DM, 0, 2, 0, nullptr, vb, nvb);
        conv_job(F, base, F.in[I_CDWOUT], 1536, DM, (bf16_t*)(ws + W1_CDO), 1536, 0, 0, 0, nullptr, vb, nvb);
        const int n = 224 * 128; const u32x4 z = {0u, 0u, 0u, 0u};
        for (int i = vb * 512 + F.tid; i < n; i += nvb * 512) *(u32x4*)(ws + W1_CDI + (size_t)4640 * 2048 + (size_t)i * 16) = z;
    }
}
DI void norm_phase(const Fr& F, int layer, const float* g, int jshift, int rbeg, int nrows, const float* xin_x, const float* xin_c, bf16_t* H, int vb = -1, int nvb = 0) {
    const float* mod = (const float*)(F.ws + WS_MOD) + (size_t)layer * 17 * 9216;
    if (vb < 0) { vb = F.bid; nvb = F.G; }
    const int NGW = nvb * 8, lane = F.lane;
    f32x4 gv[4];
#pragma unroll
    for (int j = 0; j < 4; ++j) gv[j] = *(const f32x4*)(g + 4 * lane + 256 * j);
    for (int row0 = rbeg + vb * 8 + F.wave; row0 < nrows; row0 += 2 * NGW) {
        const int row1 = row0 + NGW < nrows ? row0 + NGW : row0;
        f32x4 v[2][4]; float s[2] = {0.f, 0.f};
#pragma unroll
        for (int q = 0; q < 2; ++q) { const int row = q ? row1 : row0;
            const float* xr = row < TX ? xin_x + (size_t)row * DM : xin_c + (size_t)(row - TX) * DM;
#pragma unroll
            for (int j = 0; j < 4; ++j) v[q][j] = *(const f32x4*)(xr + 4 * lane + 256 * j); }
#pragma unroll
        for (int q = 0; q < 2; ++q)
#pragma unroll
            for (int j = 0; j < 4; ++j) s[q] += (v[q][j][0] * v[q][j][0] + v[q][j][1] * v[q][j][1]) + (v[q][j][2] * v[q][j][2] + v[q][j][3] * v[q][j][3]);
#pragma unroll
        for (int q = 0; q < 2; ++q) { const int row = q ? row1 : row0;
            if (q && row1 == row0) break;
            const float* mp = mod + (size_t)(row < TX ? (row >> 11) : 16) * 9216 + jshift * 1024;
            const float rstd = rsqrtf(wave_sum(s[q]) * (1.f / DM) + EPS);
#pragma unroll
            for (int j = 0; j < 4; ++j) {
                const f32x4 sh = *(const f32x4*)(mp + 4 * lane + 256 * j), sc = *(const f32x4*)(mp + 1024 + 4 * lane + 256 * j);
                const f32x4 y = v[q][j] * rstd * gv[j] * (sc + 1.f) + sh;
                u32x2 w; w.x = cvtpk(y[0], y[1]); w.y = cvtpk(y[2], y[3]);
                *(u32x2*)(H + (size_t)row * DM + 4 * lane + 256 * j) = w;
            }
        }
    }
}
DI void final_norm_phase(const Fr& F, int nperturb) {
    const float* g = F.in[I_GFINAL]; const int NGW = F.G * 8, lane = F.lane;
    for (int row = F.bid * 8 + F.wave; row < TX; row += NGW) {
        float* xr = F.out + (size_t)row * DM; f32x4 v[4]; float s = 0.f;
#pragma unroll
        for (int j = 0; j < 4; ++j) { v[j] = *(const f32x4*)(xr + 4 * lane + 256 * j); s += (v[j][0] * v[j][0] + v[j][1] * v[j][1]) + (v[j][2] * v[j][2] + v[j][3] * v[j][3]); }
        const float rstd = rsqrtf(wave_sum(s) * (1.f / DM) + EPS);
#pragma unroll
        for (int j = 0; j < 4; ++j) { f32x4 y = v[j] * rstd * *(const f32x4*)(g + 4 * lane + 256 * j); if (row * DM + 4 * lane + 256 * j < nperturb) y += 0.05f; *(f32x4*)(xr + 4 * lane + 256 * j) = y; }
    }
}


struct KVSrc { const bf16_t* k1; int k1p, k1c; const bf16_t* k2; int k2p, k2c; const bf16_t* v; int vp, vc; };
constexpr int FL_K1 = 25600, FL_V0 = 51200, FL_VB = 17408, FL_VP = 272, FL_QR = 86016;

template <int DQK> DI void kv_load(const KVSrc& S, int rb, int tid, u32x4 (&kr)[DQK / 64], u32x4 (&vr)[2]) {
    constexpr int CPR = DQK / 8;
#pragma unroll
    for (int i = 0; i < DQK / 64; ++i) {
        const int id = tid + 512 * i, row = id / CPR, ch = id % CPR;
        const bf16_t* src = (DQK == 64 || ch < 16) ? S.k1 + (size_t)(rb + row) * S.k1p + S.k1c + ch * 8 : S.k2 + (size_t)(rb + row) * S.k2p + S.k2c + (ch - 16) * 8;
        kr[i] = *(const u32x4*)src;
    }
#pragma unroll
    for (int i = 0; i < 2; ++i) { const int id = tid + 512 * i, row = id >> 4, ch = id & 15; vr[i] = *(const u32x4*)(S.v + (size_t)(rb + row) * S.vp + S.vc + ch * 8); }
}
template <int DQK> DI void kv_store(LAS unsigned char* Kb, LAS unsigned char* Vb, int tid, const u32x4 (&kr)[DQK / 64], const u32x4 (&vr)[2]) {
    constexpr int CPR = DQK / 8, KP = DQK * 2 + 16;
#pragma unroll
    for (int i = 0; i < DQK / 64; ++i) { const int id = tid + 512 * i, row = id / CPR, ch = id % CPR; *(LAS u32x4*)(Kb + row * KP + ch * 16) = kr[i]; }
#pragma unroll
    for (int i = 0; i < 2; ++i) { const int id = tid + 512 * i, row = id >> 4, ch = id & 15; *(LAS u32x4*)(Vb + row * FL_VP + ch * 16) = vr[i]; }
}
template <int DQK, int NSR> DI void flash_run(const Fr& F, const KVSrc& S, const bf16x8 (&qf)[NSR], const LAS unsigned char* qlds, int nkt, int nxt, int xbase, int cbase, float sc2, f32x16 (&o)[4]) {
    constexpr int NS = DQK / 16, KP = DQK * 2 + 16;
    LAS unsigned char* lds = F.lds; const int tid = F.tid, lane = F.lane, r = lane & 31, h = lane >> 5;
    const int i16 = lane & 15, q4 = i16 >> 2, p4 = i16 & 3, blk = (lane >> 4) & 1;
    u32x4 kr[DQK / 64], vr[2];
    __syncthreads();
    kv_load<DQK>(S, nxt > 0 ? xbase : cbase, tid, kr, vr);
    kv_store<DQK>(lds, lds + FL_V0, tid, kr, vr);
    __syncthreads();
    float m = -1e30f, l = 0.f;
#pragma unroll
    for (int t = 0; t < 4; ++t) o[t] = zero16();
    for (int kt = 0; kt < nkt; ++kt) {
        const bool more = kt + 1 < nkt;
        if (more) { const int k1 = kt + 1; kv_load<DQK>(S, k1 < nxt ? xbase + 64 * k1 : cbase + 64 * (k1 - nxt), tid, kr, vr); }
        const LAS unsigned char* Kb = lds + (kt & 1) * FL_K1; const LAS unsigned char* Vb = lds + FL_V0 + (kt & 1) * FL_VB;
        f32x16 st[2];
#pragma unroll
        for (int ks = 0; ks < 2; ++ks) {
            f32x16 a = zero16();
#pragma unroll
            for (int s = 0; s < NS; ++s) { const bf16x8 kf = *(const LAS bf16x8*)(Kb + (ks * 32 + r) * KP + s * 32 + h * 16);
                bf16x8 qq; if (s < NSR) qq = qf[s < NSR ? s : 0]; else qq = *(const LAS bf16x8*)(qlds + (s - NSR) * 32);
                a = MFMA32(kf, qq, a);
                if (NS > 4 && (s & 3) == 3) asm volatile("" ::: "memory"); }
            st[ks] = a;
        }
        float mx = st[0][0];
#pragma unroll
        for (int i = 0; i < 16; ++i) { mx = fmaxf(mx, st[0][i]); mx = fmaxf(mx, st[1][i]); }
        mx *= sc2; mx = fmaxf(mx, __shfl_xor(mx, 32));
        const float mn = fmaxf(m, mx), alpha = ex2(m - mn); m = mn;
        float rs = 0.f;
#pragma unroll
        for (int ks = 0; ks < 2; ++ks)
#pragma unroll
            for (int i = 0; i < 16; ++i) { const float p = ex2(st[ks][i] * sc2 - mn); rs += p; st[ks][i] = p; }
        l = l * alpha + rs;
#pragma unroll
        for (int t = 0; t < 4; ++t) o[t] = o[t] * alpha;
#pragma unroll
        for (int ks = 0; ks < 2; ++ks)
#pragma unroll
            for (int s2 = 0; s2 < 2; ++s2) {
                const bf16x8 pf = pack8(st[ks][8 * s2], st[ks][8 * s2 + 1], st[ks][8 * s2 + 2], st[ks][8 * s2 + 3], st[ks][8 * s2 + 4], st[ks][8 * s2 + 5], st[ks][8 * s2 + 6], st[ks][8 * s2 + 7]);
                const LAS unsigned char* vb = Vb + (ks * 32 + 16 * s2 + 4 * h + q4) * FL_VP + (16 * blk + 4 * p4) * 2;
#pragma unroll
                for (int t = 0; t < 4; ++t) { const s16x4 lo = trread(vb + t * 64), hi = trread(vb + t * 64 + 8 * FL_VP); o[t] = MFMA32(cat8(lo, hi), pf, o[t]); }
                if (DQK > 64) asm volatile("" ::: "memory");
            }
        if (more) kv_store<DQK>(lds + ((kt + 1) & 1) * FL_K1, lds + FL_V0 + ((kt + 1) & 1) * FL_VB, tid, kr, vr);
        __syncthreads();
    }
    l += __shfl_xor(l, 32);
    const float inv = 1.f / l;
#pragma unroll
    for (int t = 0; t < 4; ++t) o[t] = o[t] * inv;
}

DI void attn0_phase(const Fr& F) {
    const bf16_t* P = (const bf16_t*)(F.ws + WS_P0); const bf16_t* QK = (const bf16_t*)(F.ws + WS_QKV);
    bf16_t* CAT = (bf16_t*)(F.ws + WS_H); bf16_t* ODS = (bf16_t*)(F.ws + WS_ODS);
    const int lane = F.lane, r = lane & 31, h = lane >> 5;
    float lam;
    {
        const float d1 = wave_sum(F.in[I_LQ1][lane] * F.in[I_LK1][lane]), d2 = wave_sum(F.in[I_LQ2][lane] * F.in[I_LK2][lane]);
        lam = __expf(d1) - __expf(d2) + 0.2f;
    }
    const float* gsub = F.in[I_GSUB];
    const float* cosT = (const float*)(F.ws + WS_ROPE); const float* sinT = cosT + 1024; const float* ssq = (const float*)(F.ws + WS_SSQ);
    for (int it = F.bid; it < 1152; it += F.G) {
        int type, b, qb, hd;
        if (it < 512) { type = 0; b = it >> 5; qb = (it >> 2) & 7; hd = it & 3; }
        else if (it < 1024) { type = 1; const int j = it - 512; b = j >> 5; qb = (j >> 2) & 7; hd = j & 3; }
        else if (it < 1088) { type = 2; const int j = it - 1024; b = j >> 2; qb = 0; hd = j & 3; }
        else { type = 3; const int j = it - 1088; b = j >> 2; qb = 0; hd = j & 3; }
        const bool xq = type < 2;
        const int row = (xq ? b * SEQ + qb * 256 : TX + b * CTXL) + F.wave * 32 + r;
        const int nkt = xq ? 36 : 4, nxt = xq ? 32 : 0, xbase = b * SEQ, cbase = TX + b * CTXL;
        f32x16 o[4];
        if ((type & 1) == 0) {
            KVSrc S{QK, QKW, 768 + hd * 256, P, P0W, 1920, QK, QKW, 768 + hd * 256 + 128};
            bf16x8 qf[8];
            const bf16_t* qptr = QK + (size_t)row * QKW + hd * 192;
#pragma unroll
            for (int s = 0; s < 8; ++s) qf[s] = *(const bf16x8*)(qptr + 16 * s + 8 * h);
            LAS unsigned char* qlds = F.lds + FL_QR + F.wave * 4608 + r * 144 + h * 16;
            {
                const int t = row & 2047; int hr = h; asm volatile("" : "+v"(hr));
#pragma unroll
                for (int grp = 0; grp < 2; ++grp) {
                    const int pos = grp ? (t & 63) : (t >> 6);
                    const bf16x8 x1 = *(const bf16x8*)(qptr + 128 + 32 * grp + 8 * h), x2 = *(const bf16x8*)(qptr + 144 + 32 * grp + 8 * h);
                    bf16x8 y1 = x1, y2 = x2;
                    if (xq) {
                        const f32x4 c0 = *(const f32x4*)(cosT + pos * 16 + 8 * hr), c1 = *(const f32x4*)(cosT + pos * 16 + 8 * hr + 4), s0 = *(const f32x4*)(sinT + pos * 16 + 8 * hr), s1 = *(const f32x4*)(sinT + pos * 16 + 8 * hr + 4);
                        float a[8], bq[8];
#pragma unroll
                        for (int j = 0; j < 8; ++j) { const float u1 = bf2f((unsigned short)x1[j]), u2 = bf2f((unsigned short)x2[j]), cv = j < 4 ? c0[j & 3] : c1[j & 3], sv = j < 4 ? s0[j & 3] : s1[j & 3];
                            a[j] = u1 * cv - u2 * sv; bq[j] = u2 * cv + u1 * sv; }
                        y1 = pack8(a[0], a[1], a[2], a[3], a[4], a[5], a[6], a[7]); y2 = pack8(bq[0], bq[1], bq[2], bq[3], bq[4], bq[5], bq[6], bq[7]);
                    }
                    *(LAS bf16x8*)(qlds + (2 * grp) * 32) = y1; *(LAS bf16x8*)(qlds + (2 * grp + 1) * 32) = y2;
                }
            }
            const float rq = rsqrtf(ssq[(size_t)row * 2] * (1.f / 256.f) + EPS);
            flash_run<192, 8>(F, S, qf, qlds, nkt, nxt, xbase, cbase, 0.07216878364870322f * LOG2E * rq, o);
            { int hq = h, rowq = row; asm volatile("" : "+v"(hq), "+v"(rowq));
#pragma unroll
            for (int t = 0; t < 4; ++t)
#pragma unroll
                for (int g = 0; g < 4; ++g) { u32x2 w; w.x = cvtpk(o[t][4 * g], o[t][4 * g + 1]); w.y = cvtpk(o[t][4 * g + 2], o[t][4 * g + 3]);
                    *(u32x2*)(CAT + (size_t)rowq * DM + 512 + hd * 128 + t * 32 + 8 * g + 4 * hq) = w; } }
        } else {
            for (int c = 0; c < 2; ++c) {
                KVSrc S{P, P0W, 512 + hd * 128 + c * 64, nullptr, 0, 0, P, P0W, 1024 + hd * 128};
                bf16x8 qf[4];
                { const bf16_t* qptr = P + (size_t)row * P0W + hd * 128 + c * 64;
#pragma unroll
                  for (int s = 0; s < 4; ++s) qf[s] = *(const bf16x8*)(qptr + 16 * s + 8 * h); }
                flash_run<64, 4>(F, S, qf, nullptr, nkt, nxt, xbase, cbase, 0.125f * LOG2E, o);
                int hq = h, rowq = row; asm volatile("" : "+v"(hq), "+v"(rowq));
                bf16_t* sp = ODS + (size_t)rowq * 512 + hd * 128 + 4 * hq;
                if (c == 0) {
#pragma unroll
                    for (int t = 0; t < 4; ++t)
#pragma unroll
                        for (int g = 0; g < 4; ++g) { u32x2 w; w.x = cvtpk(o[t][4 * g], o[t][4 * g + 1]); w.y = cvtpk(o[t][4 * g + 2], o[t][4 * g + 3]); *(u32x2*)(sp + t * 32 + 8 * g) = w; }
                } else {
                    float ss = 0.f;
#pragma unroll
                    for (int t = 0; t < 4; ++t)
#pragma unroll
                        for (int g = 0; g < 4; ++g) { const u32x2 w = *(const u32x2*)(sp + t * 32 + 8 * g);
                            const float a0 = bflo(w.x) - lam * o[t][4 * g], a1 = bfhi(w.x) - lam * o[t][4 * g + 1], a2 = bflo(w.y) - lam * o[t][4 * g + 2], a3 = bfhi(w.y) - lam * o[t][4 * g + 3];
                            o[t][4 * g] = a0; o[t][4 * g + 1] = a1; o[t][4 * g + 2] = a2; o[t][4 * g + 3] = a3; ss += (a0 * a0 + a1 * a1) + (a2 * a2 + a3 * a3); }
                    ss += __shfl_xor(ss, 32);
                    const float rstd = rsqrtf(ss * (1.f / 128.f) + EPS) * 0.8f;
#pragma unroll
                    for (int t = 0; t < 4; ++t)
#pragma unroll
                        for (int g = 0; g < 4; ++g) { const f32x4 gg = *(const f32x4*)(gsub + t * 32 + 8 * g + 4 * hq); u32x2 w;
                            w.x = cvtpk(o[t][4 * g] * rstd * gg[0], o[t][4 * g + 1] * rstd * gg[1]); w.y = cvtpk(o[t][4 * g + 2] * rstd * gg[2], o[t][4 * g + 3] * rstd * gg[3]);
                            *(u32x2*)(CAT + (size_t)rowq * DM + hd * 128 + t * 32 + 8 * g + 4 * hq) = w; }
                }
            }
        }
    }
}

constexpr int NA_KP = 528, NA_BUF = 64 * NA_KP, NA_V0 = 2 * NA_BUF, NA_RPB = 4 * NA_BUF;
DI void na_load(const bf16_t* P1, int rb, int kcol, int vcol, int tid, u32x4 (&kr)[4], u32x4 (&vr)[4]) {
#pragma unroll
    for (int i = 0; i < 4; ++i) { const int id = tid + 512 * i, row = id >> 5, ch = id & 31; const bf16_t* base = P1 + (size_t)(rb + row) * P1W + ch * 8;
        kr[i] = *(const u32x4*)(base + kcol); vr[i] = *(const u32x4*)(base + vcol); }
}
DI void na_store(LAS unsigned char* Kb, LAS unsigned char* Vb, int tid, const u32x4 (&kr)[4], const u32x4 (&vr)[4]) {
#pragma unroll
    for (int i = 0; i < 4; ++i) { const int id = tid + 512 * i, row = id >> 5, ch = id & 31; *(LAS u32x4*)(Kb + row * NA_KP + ch * 16) = kr[i]; *(LAS u32x4*)(Vb + row * NA_KP + ch * 16) = vr[i]; }
}
DI void na_item(const Fr& F, int b, int gr, int hg) {
    bf16_t* P1 = (bf16_t*)(F.ws + WS_P1);
    LAS unsigned char* lds = F.lds; const int tid = F.tid, lane = F.lane, r = lane & 31, h = lane >> 5;
    const int i16 = lane & 15, q4 = i16 >> 2, p4 = i16 & 3, blk = (lane >> 4) & 1;
    const int hl = F.wave & 3, qs = F.wave >> 2, head = hg * 4 + hl, qc = qs * 32 + r;
    const int row = b * SEQ + gr * 64 + qc;
    const int r0 = min(max(gr - 4, 0), 24), c0 = min(max(qc - 8, 0), 48);
    const int kcol = C1_K + hg * 256, vcol = C1_V + hg * 256;
    bf16_t* qptr = P1 + (size_t)row * P1W + C1_Q + head * 64;
    bf16x8 qf[4];
#pragma unroll
    for (int s = 0; s < 4; ++s) qf[s] = *(const bf16x8*)(qptr + 16 * s + 8 * h);
    u32x4 kr[4], vr[4];
    __syncthreads();
    LAS float* rpbs = (LAS float*)(lds + NA_RPB);
    { const float* rpb = F.in[I_RPB] + (size_t)hg * 4 * 465; for (int i = tid; i < 4 * 465; i += 512) rpbs[i] = rpb[i]; }
    na_load(P1, b * SEQ + r0 * 64, kcol, vcol, tid, kr, vr);
    na_store(lds, lds + NA_V0, tid, kr, vr);
    __syncthreads();
    float m = -1e30f, l = 0.f; f32x16 o[2]; o[0] = zero16(); o[1] = zero16();
    const float sc2 = 0.125f * LOG2E;
    for (int kt = 0; kt < 12; ++kt) {
        const bool more = kt + 1 < 12;
        if (more) { const int k1 = kt + 1; na_load(P1, k1 < 8 ? b * SEQ + (r0 + k1) * 64 : TX + b * CTXL + (k1 - 8) * 64, kcol, vcol, tid, kr, vr); }
        const LAS unsigned char* Kb = lds + (kt & 1) * NA_BUF + hl * 128; const LAS unsigned char* Vb = lds + NA_V0 + (kt & 1) * NA_BUF + hl * 128;
        f32x16 st[2];
#pragma unroll
        for (int ks = 0; ks < 2; ++ks) {
            f32x16 a = zero16();
#pragma unroll
            for (int s = 0; s < 4; ++s) { const bf16x8 kf = *(const LAS bf16x8*)(Kb + (ks * 32 + r) * NA_KP + s * 32 + h * 16); a = MFMA32(kf, qf[s], a); }
            st[ks] = a;
        }
        if (kt < 8) {
            const LAS float* bp = rpbs + (hl * 15 + (r0 + kt - gr + 7)) * 31 + 15 - qc;
#pragma unroll
            for (int ks = 0; ks < 2; ++ks)
#pragma unroll
                for (int i = 0; i < 16; ++i) { const int kc = ks * 32 + crow(i, h); const bool ok = kc >= c0 && kc < c0 + 16;
                    const float bias = ok ? bp[kc] : 0.f; st[ks][i] = ok ? (st[ks][i] * sc2 + bias * LOG2E) : -1e30f; }
        } else {
#pragma unroll
            for (int ks = 0; ks < 2; ++ks)
#pragma unroll
                for (int i = 0; i < 16; ++i) st[ks][i] = st[ks][i] * sc2;
        }
        float mx = st[0][0];
#pragma unroll
        for (int i = 0; i < 16; ++i) { mx = fmaxf(mx, st[0][i]); mx = fmaxf(mx, st[1][i]); }
        mx = fmaxf(mx, __shfl_xor(mx, 32));
        const float mn = fmaxf(m, mx), alpha = ex2(m - mn); m = mn;
        float rs = 0.f;
#pragma unroll
        for (int ks = 0; ks < 2; ++ks)
#pragma unroll
            for (int i = 0; i < 16; ++i) { const float p = ex2(st[ks][i] - mn); rs += p; st[ks][i] = p; }
        l = l * alpha + rs; o[0] = o[0] * alpha; o[1] = o[1] * alpha;
#pragma unroll
        for (int ks = 0; ks < 2; ++ks)
#pragma unroll
            for (int s2 = 0; s2 < 2; ++s2) {
                const bf16x8 pf = pack8(st[ks][8 * s2], st[ks][8 * s2 + 1], st[ks][8 * s2 + 2], st[ks][8 * s2 + 3], st[ks][8 * s2 + 4], st[ks][8 * s2 + 5], st[ks][8 * s2 + 6], st[ks][8 * s2 + 7]);
                const LAS unsigned char* vb = Vb + (ks * 32 + 16 * s2 + 4 * h + q4) * NA_KP + (16 * blk + 4 * p4) * 2;
#pragma unroll
                for (int t = 0; t < 2; ++t) { const s16x4 lo = trread(vb + t * 64), hi = trread(vb + t * 64 + 8 * NA_KP); o[t] = MFMA32(cat8(lo, hi), pf, o[t]); }
            }
        if (more) na_store(lds + ((kt + 1) & 1) * NA_BUF, lds + NA_V0 + ((kt + 1) & 1) * NA_BUF, tid, kr, vr);
        __syncthreads();
    }
    l += __shfl_xor(l, 32);
    const float inv = 1.f / l;
#pragma unroll
    for (int t = 0; t < 2; ++t)
#pragma unroll
        for (int g = 0; g < 4; ++g) { u32x2 w; w.x = cvtpk(o[t][4 * g] * inv, o[t][4 * g + 1] * inv); w.y = cvtpk(o[t][4 * g + 2] * inv, o[t][4 * g + 3] * inv);
            *(u32x2*)(qptr + t * 32 + 8 * g + 4 * h) = w; }
}

constexpr int NB_KP = 144, NB_KBUF = 128 * NB_KP, NB_V0 = 2 * NB_KBUF, NB_RPB = 4 * NB_KBUF;
DI void na_item2(const Fr& F, int b, int head, int gq) {
    bf16_t* P1 = (bf16_t*)(F.ws + WS_P1);
    LAS unsigned char* lds = F.lds; const int tid = F.tid, lane = F.lane, r = lane & 31, h = lane >> 5;
    const int i16 = lane & 15, q4 = i16 >> 2, p4 = i16 & 3, blk = (lane >> 4) & 1;
    const int grw = gq * 4 + (F.wave >> 1), qc = (F.wave & 1) * 32 + r;
    const int row = b * SEQ + grw * 64 + qc;
    const int r0w = min(max(grw - 4, 0), 24), c0 = min(max(qc - 8, 0), 48);
    const int rlo = min(max(gq * 4 - 4, 0), 24), rhi = min(max(gq * 4 - 1, 0), 24) + 7;
    const int nl2 = (rhi - rlo + 2) >> 1, nst = nl2 + 2;
    const int kcol = C1_K + head * 64, vcol = C1_V + head * 64;
    bf16_t* qptr = P1 + (size_t)row * P1W + C1_Q + head * 64;
    bf16x8 qf[4];
#pragma unroll
    for (int s = 0; s < 4; ++s) qf[s] = *(const bf16x8*)(qptr + 16 * s + 8 * h);
    u32x4 kr[2], vr[2];
    __syncthreads();
    LAS float* rpbs = (LAS float*)(lds + NB_RPB);
    { const float* rpb = F.in[I_RPB] + (size_t)head * 465; if (tid < 465) rpbs[tid] = rpb[tid]; }
#define NB_BASE(s_, u_) ((s_) < nl2 ? b * SEQ + min(rlo + 2 * (s_) + (u_), rhi) * 64 : TX + b * CTXL + (2 * ((s_) - nl2) + (u_)) * 64)
#define NB_LOAD(s_) do { _Pragma("unroll") for (int i = 0; i < 2; ++i) { const int id = tid + 512 * i, krow = id >> 3, ch = id & 7; \
        const bf16_t* base = P1 + (size_t)(NB_BASE(s_, krow >> 6) + (krow & 63)) * P1W + ch * 8; kr[i] = *(const u32x4*)(base + kcol); vr[i] = *(const u32x4*)(base + vcol); } } while (0)
#define NB_STORE(buf_) do { _Pragma("unroll") for (int i = 0; i < 2; ++i) { const int id = tid + 512 * i, krow = id >> 3, ch = id & 7; \
        *(LAS u32x4*)(lds + (buf_) * NB_KBUF + krow * NB_KP + ch * 16) = kr[i]; *(LAS u32x4*)(lds + NB_V0 + (buf_) * NB_KBUF + krow * NB_KP + ch * 16) = vr[i]; } } while (0)
    NB_LOAD(0); NB_STORE(0);
    __syncthreads();
    float m = -1e30f, l = 0.f; f32x16 o[2]; o[0] = zero16(); o[1] = zero16();
    const float sc2 = 0.125f * LOG2E;
    for (int st_ = 0; st_ < nst; ++st_) {
        const bool more = st_ + 1 < nst;
        if (more) NB_LOAD(st_ + 1);
        for (int u = 0; u < 2; ++u) {
            const bool lat = st_ < nl2; const int R = rlo + 2 * st_ + u;
            if (lat && (R > rhi || R < r0w || R >= r0w + 8)) continue;
            const LAS unsigned char* Kb = lds + (st_ & 1) * NB_KBUF + u * 64 * NB_KP; const LAS unsigned char* Vb = lds + NB_V0 + (st_ & 1) * NB_KBUF + u * 64 * NB_KP;
            f32x16 st[2];
#pragma unroll
            for (int ks = 0; ks < 2; ++ks) {
                f32x16 a = zero16();
#pragma unroll
                for (int s = 0; s < 4; ++s) { const bf16x8 kf = *(const LAS bf16x8*)(Kb + (ks * 32 + r) * NB_KP + s * 32 + h * 16); a = MFMA32(kf, qf[s], a); }
                st[ks] = a;
            }
            if (lat) {
                const LAS float* bp = rpbs + (R - grw + 7) * 31 + 15 - qc;
#pragma unroll
                for (int ks = 0; ks < 2; ++ks)
#pragma unroll
                    for (int i = 0; i < 16; ++i) { const int kc = ks * 32 + crow(i, h); const bool ok = (unsigned)(kc - c0) < 16u;
                        const float bias = ok ? bp[kc] : 0.f; st[ks][i] = ok ? (st[ks][i] * sc2 + bias * LOG2E) : -1e30f; }
            } else {
#pragma unroll
                for (int ks = 0; ks < 2; ++ks)
#pragma unroll
                    for (int i = 0; i < 16; ++i) st[ks][i] = st[ks][i] * sc2;
            }
            float mx = st[0][0];
#pragma unroll
            for (int i = 0; i < 16; ++i) { mx = fmaxf(mx, st[0][i]); mx = fmaxf(mx, st[1][i]); }
            mx = fmaxf(mx, __shfl_xor(mx, 32));
            const float mn = fmaxf(m, mx), alpha = ex2(m - mn); m = mn;
            float rs = 0.f;
#pragma unroll
            for (int ks = 0; ks < 2; ++ks)
#pragma unroll
                for (int i = 0; i < 16; ++i) { const float p = ex2(st[ks][i] - mn); rs += p; st[ks][i] = p; }
            l = l * alpha + rs; o[0] = o[0] * alpha; o[1] = o[1] * alpha;
#pragma unroll
            for (int ks = 0; ks < 2; ++ks)
#pragma unroll
                for (int s2 = 0; s2 < 2; ++s2) {
                    const bf16x8 pf = pack8(st[ks][8 * s2], st[ks][8 * s2 + 1], st[ks][8 * s2 + 2], st[ks][8 * s2 + 3], st[ks][8 * s2 + 4], st[ks][8 * s2 + 5], st[ks][8 * s2 + 6], st[ks][8 * s2 + 7]);
                    const LAS unsigned char* vb = Vb + (ks * 32 + 16 * s2 + 4 * h + q4) * NB_KP + (16 * blk + 4 * p4) * 2;
#pragma unroll
                    for (int t = 0; t < 2; ++t) { const s16x4 lo = trread(vb + t * 64), hi = trread(vb + t * 64 + 8 * NB_KP); o[t] = MFMA32(cat8(lo, hi), pf, o[t]); }
                }
        }
        if (more) NB_STORE((st_ + 1) & 1);
        __syncthreads();
    }
#undef NB_BASE
#undef NB_LOAD
#undef NB_STORE
    l += __shfl_xor(l, 32);
    const float inv = 1.f / l;
#pragma unroll
    for (int t = 0; t < 2; ++t)
#pragma unroll
        for (int g = 0; g < 4; ++g) { u32x2 w; w.x = cvtpk(o[t][4 * g] * inv, o[t][4 * g + 1] * inv); w.y = cvtpk(o[t][4 * g + 2] * inv, o[t][4 * g + 3] * inv);
            *(u32x2*)(qptr + t * 32 + 8 * g + 4 * h) = w; }
}


constexpr int SS_XP = 144, SS_BP = 272;
constexpr int SS_X = 0, SS_B = 18432, SS_C = 53248, SS_H = 88064, SS_HB = 17408  , SS_DT = 122880, SS_ACS = 123392, SS_SW = 123904;
DI void halo1_phase(const Fr& F) {
    const bf16_t* P1 = (const bf16_t*)(F.ws + WS_P1); bf16_t* HL = (bf16_t*)(F.ws + WS_HALO);
    for (int i = F.bid * 512 + F.tid; i < 288 * 4 * 256; i += F.G * 512) {
        const int c = i >> 10, w = (i >> 8) & 3, ch = i & 255;
        const bool isx = c < 256; const int cc = isx ? (c & 15) : ((c - 256) & 1), nch = isx ? 16 : 2;
        const bool valid = w < 2 ? cc > 0 : cc < nch - 1;
        const int row = c * 128 + (w < 2 ? w - 2 : 126 + w);
        u32x4 v = {0u, 0u, 0u, 0u};
        if (valid) v = *(const u32x4*)(P1 + (size_t)row * P1W + C1_XBC + ch * 8);
        *(u32x4*)(HL + ((size_t)(c * 4 + w) * 2048 + ch * 8)) = v;
    }
}
DI void conv1_load(const bf16_t* P1, const bf16_t* HL, int it, int rb, int cgp, u32x4 (&raw)[12]) {
    const int c = it >> 3, ch0 = (it & 7) * 256 + cgp * 8;
#pragma unroll
    for (int k = 0; k < 12; ++k) {
        const int l = rb * 8 - 2 + k;
        const bf16_t* src = (l >= 0 && l < 128) ? P1 + (size_t)(c * 128 + l) * P1W + C1_XBC + ch0 : HL + (size_t)(c * 4 + (l < 0 ? l + 2 : l - 126)) * 2048 + ch0;
        raw[k] = *(const u32x4*)src;
    }
}
DI void conv1_phase(const Fr& F) {
    bf16_t* P1 = (bf16_t*)(F.ws + WS_P1); const bf16_t* HL = (const bf16_t*)(F.ws + WS_HALO);
    const float* cw = F.in[I_CONVW]; const float* cb = F.in[I_CONVB];
    const int rb = F.tid >> 5, cgp = F.tid & 31;
    u32x4 raw[12], rawn[12];
    if (F.bid < 288 * 8) conv1_load(P1, HL, F.bid, rb, cgp, raw);
    for (int it = F.bid; it < 288 * 8; it += F.G) {
        const int c = it >> 3, ch0 = (it & 7) * 256 + cgp * 8;
        const bool more = it + F.G < 288 * 8;
        if (more) conv1_load(P1, HL, it + F.G, rb, cgp, rawn);
        f32x4 w[5][2], bb[2];
#pragma unroll
        for (int j = 0; j < 5; ++j) { w[j][0] = *(const f32x4*)(cw + j * 2048 + ch0); w[j][1] = *(const f32x4*)(cw + j * 2048 + ch0 + 4); }
        bb[0] = *(const f32x4*)(cb + ch0); bb[1] = *(const f32x4*)(cb + ch0 + 4);
        u32x4 ov[8];
#pragma unroll
        for (int i = 0; i < 8; ++i) {
            f32x4 a0 = bb[0], a1 = bb[1];
#pragma unroll
            for (int j = 0; j < 5; ++j) { const u32x4 q = raw[i + j];
                a0 += w[j][0] * (f32x4){bflo(q.x), bfhi(q.x), bflo(q.y), bfhi(q.y)}; a1 += w[j][1] * (f32x4){bflo(q.z), bfhi(q.z), bflo(q.w), bfhi(q.w)}; }
            ov[i].x = cvtpk(siluf(a0[0]), siluf(a0[1])); ov[i].y = cvtpk(siluf(a0[2]), siluf(a0[3])); ov[i].z = cvtpk(siluf(a1[0]), siluf(a1[1])); ov[i].w = cvtpk(siluf(a1[2]), siluf(a1[3]));
        }
        __syncthreads();
#pragma unroll
        for (int i = 0; i < 8; ++i) *(u32x4*)(P1 + (size_t)(c * 128 + rb * 8 + i) * P1W + C1_XBC + ch0) = ov[i];
        if (more) {
#pragma unroll
            for (int k = 0; k < 12; ++k) raw[k] = rawn[k];
        }
    }
}
DI void scan1_pre(const Fr& F) {
    const bf16_t* P1 = (const bf16_t*)(F.ws + WS_P1); float* SC = (float*)(F.ws + WS_SCAN);
    const int NGW = F.G * 8, lane = F.lane;
    for (int rec = F.bid * 8 + F.wave; rec < 16 * 2 * 16 * 18; rec += NGW) {
        const int ci = rec % 18, hd = (rec / 18) & 15, d = (rec / (18 * 16)) & 1, b = rec / (18 * 32);
        const bool isx = ci >= 2; const int cc = isx ? ci - 2 : ci, nch = isx ? 16 : 2;
        const int row0 = (isx ? b * SEQ : TX + b * CTXL) + (d ? nch - 1 - cc : cc) * 128;
        const float a = -__expf(F.in[I_ALOG][d * 16 + hd]), dtb = F.in[I_DTB][d * 16 + hd];
        float dt[2];
#pragma unroll
        for (int q = 0; q < 2; ++q) { const int l = 2 * lane + q; const float xr = bf2f(P1[(size_t)(row0 + (d ? 127 - l : l)) * P1W + C1_DT + d * 16 + hd]) + dtb; dt[q] = xr > 20.f ? xr : log1pf(__expf(xr)); }
        const float v0 = a * dt[0], v1 = a * dt[1]; float ps = v0 + v1;
#pragma unroll
        for (int off = 1; off < 64; off <<= 1) { const float t = __shfl_up(ps, off); if (lane >= off) ps += t; }
        const float tot = __shfl(ps, 63), c0 = ps - v1, c1 = ps;
        float* rp = SC + (size_t)rec * 384 + 2 * lane;
        *(f32x2*)rp = (f32x2){dt[0], dt[1]}; *(f32x2*)(rp + 128) = (f32x2){c0, c1}; *(f32x2*)(rp + 256) = (f32x2){dt[0] * __expf(tot - c0), dt[1] * __expf(tot - c1)};
    }
}
DI void ssd_load(const bf16_t* P1, const float* SC, int b, int hd, int g, int st, int tid, u32x4 (&pf)[10], float& scv) {
    const int d = st >= 18, ci = d ? st - 18 : st; const bool isx = ci >= 2; const int cc = isx ? ci - 2 : ci, nch = isx ? 16 : 2;
    const int row0 = (isx ? b * SEQ : TX + b * CTXL) + (d ? nch - 1 - cc : cc) * 128;
#pragma unroll
    for (int i = 0; i < 10; ++i) {
        const int id = tid + 512 * i; int row, col;
        if (i < 2) { row = id >> 3; col = hd * 64 + (id & 7) * 8; }
        else if (i < 6) { const int j = id - 1024; row = j >> 4; col = 1024 + g * 128 + (j & 15) * 8; }
        else { const int j = id - 3072; row = j >> 4; col = 1536 + g * 128 + (j & 15) * 8; }
        pf[i] = *(const u32x4*)(P1 + (size_t)(row0 + row) * P1W + C1_XBC + col);
    }
    if (tid < 384) scv = SC[(size_t)((((b * 2 + d) * 16 + hd) * 18) + ci) * 384 + tid];
}
#ifndef LDS_BAR
#define LDS_BAR() do { asm volatile("s_waitcnt lgkmcnt(0)" ::: "memory"); __builtin_amdgcn_s_barrier(); asm volatile("" ::: "memory"); } while (0)
#endif
DI void ssd_item(const Fr& F, int b, int hd) {
    const bf16_t* P1 = (const bf16_t*)(F.ws + WS_P1); bf16_t* Y = (bf16_t*)(F.ws + WS_H);
    LAS unsigned char* lds = F.lds; const int tid = F.tid, lane = F.lane, wave = F.wave, r = lane & 31, h = lane >> 5;
    const int i16 = lane & 15, q4 = i16 >> 2, p4 = i16 & 3, blk = (lane >> 4) & 1;
    const int g = hd >> 2, pt = wave >> 2, lt = wave < 4 ? wave : 7 - wave;
    LAS float* dtv = (LAS float*)(lds + SS_DT); LAS float* acs = (LAS float*)(lds + SS_ACS); LAS float* sw = (LAS float*)(lds + SS_SW);
    const float* SC = (const float*)(F.ws + WS_SCAN);
    u32x4 pf[10]; float scv = 0.f;
    __syncthreads();
    ssd_load(P1, SC, b, hd, g, 0, tid, pf, scv);
    float Dsk = 0.f; f32x16 hreg = zero16();
    for (int st = 0; st < 36; ++st) {
        const int d = st >= 18, ci = d ? st - 18 : st;
        const bool isx = ci >= 2; const int cc = isx ? ci - 2 : ci, nch = isx ? 16 : 2;
        const int tokbase = (d ? nch - 1 - cc : cc) * 128;
        if (ci == 0) asm volatile("s_waitcnt vmcnt(0)" ::: "memory");
        LDS_BAR();
        if (ci == 0) {
            Dsk = F.in[I_DSKIP][d * 16 + hd];
            hreg = zero16();
            for (int i = tid; i < 64 * SS_BP / 4; i += 512) ((LAS unsigned*)(lds + SS_H + (st & 1) * SS_HB))[i] = 0u;
        }
#pragma unroll
        for (int i = 0; i < 10; ++i) {
            const int id = tid + 512 * i; int row; LAS unsigned char* dst;
            if (i < 2) { row = id >> 3; dst = lds + SS_X + (id & 7) * 16 + (d ? 127 - row : row) * SS_XP; }
            else if (i < 6) { const int j = id - 1024; row = j >> 4; dst = lds + SS_B + (j & 15) * 16 + (d ? 127 - row : row) * SS_BP; }
            else { const int j = id - 3072; row = j >> 4; dst = lds + SS_C + (j & 15) * 16 + (d ? 127 - row : row) * SS_BP; }
            *(LAS u32x4*)dst = pf[i];
        }
        if (tid < 384) dtv[tid] = scv;
        LDS_BAR();
        if (st + 1 < 36) ssd_load(P1, SC, b, hd, g, st + 1, tid, pf, scv);
        float el; const float dtot = __expf(acs[127]);
        asm volatile("s_waitcnt lgkmcnt(0)" ::: "memory");
        if (isx) {
            const int lcol = lt * 32 + r; const float al = acs[lcol]; el = __expf(al);
            const int tok = tokbase + (d ? 127 - lcol : lcol);
            bf16_t* yp = Y + (size_t)(b * SEQ + tok) * DM + hd * 64 + pt * 32 + 4 * h;
            unsigned long long yold[4] = {0ull, 0ull, 0ull, 0ull};
            if (d) {
#pragma unroll
                for (int gq = 0; gq < 4; ++gq) yold[gq] = __hip_atomic_load((unsigned long long*)(yp + 8 * gq), __ATOMIC_RELAXED, __HIP_MEMORY_SCOPE_AGENT);
            }
            f32x16 yacc = zero16();
            for (int stl = 0; stl <= lt; ++stl) {
                f32x16 sa = zero16();
#pragma unroll
                for (int kk = 0; kk < 8; ++kk) {
                    const bf16x8 af = *(const LAS bf16x8*)(lds + SS_B + (stl * 32 + r) * SS_BP + kk * 32 + h * 16);
                    const bf16x8 bf = *(const LAS bf16x8*)(lds + SS_C + lcol * SS_BP + kk * 32 + h * 16);
                    sa = MFMA32(af, bf, sa);
                }
#pragma unroll
                for (int gq = 0; gq < 4; ++gq) {
                    const int s0 = stl * 32 + 8 * gq + 4 * h;
                    const f32x4 a4 = *(const LAS f32x4*)(acs + s0), d4 = *(const LAS f32x4*)(dtv + s0);
#pragma unroll
                    for (int j = 0; j < 4; ++j) { const float e = fexp(fminf(al - a4[j], 0.f)) * d4[j]; sa[4 * gq + j] = (s0 + j <= lcol) ? sa[4 * gq + j] * e : 0.f; }
                }
#pragma unroll
                for (int s2 = 0; s2 < 2; ++s2) {
                    const bf16x8 gf = pack8(sa[8 * s2], sa[8 * s2 + 1], sa[8 * s2 + 2], sa[8 * s2 + 3], sa[8 * s2 + 4], sa[8 * s2 + 5], sa[8 * s2 + 6], sa[8 * s2 + 7]);
                    const LAS unsigned char* xb = lds + SS_X + (stl * 32 + 16 * s2 + 4 * h + q4) * SS_XP + (pt * 32 + 16 * blk + 4 * p4) * 2;
                    const s16x4 lo = trread(xb), hi = trread(xb + 8 * SS_XP);
                    yacc = MFMA32(cat8(lo, hi), gf, yacc);
                }
            }
            f32x16 oa = zero16();
#pragma unroll
            for (int kk = 0; kk < 8; ++kk) {
                const bf16x8 af = *(const LAS bf16x8*)(lds + SS_H + (st & 1) * SS_HB + (pt * 32 + r) * SS_BP + kk * 32 + h * 16);
                const bf16x8 bf = *(const LAS bf16x8*)(lds + SS_C + lcol * SS_BP + kk * 32 + h * 16);
                oa = MFMA32(af, bf, oa);
            }
#pragma unroll
            for (int gq = 0; gq < 4; ++gq) {
                const u32x2 xw = *(const LAS u32x2*)(lds + SS_X + lcol * SS_XP + (pt * 32 + 8 * gq + 4 * h) * 2);
                float y0 = yacc[4 * gq] + el * oa[4 * gq] + Dsk * bflo(xw.x), y1 = yacc[4 * gq + 1] + el * oa[4 * gq + 1] + Dsk * bfhi(xw.x);
                float y2 = yacc[4 * gq + 2] + el * oa[4 * gq + 2] + Dsk * bflo(xw.y), y3 = yacc[4 * gq + 3] + el * oa[4 * gq + 3] + Dsk * bfhi(xw.y);
                unsigned long long* gp = (unsigned long long*)(yp + 8 * gq);
                if (d) { const unsigned long long old = yold[gq]; const unsigned lo = (unsigned)old, hi = (unsigned)(old >> 32);
                    y0 += bflo(lo); y1 += bfhi(lo); y2 += bflo(hi); y3 += bfhi(hi); }
                *gp = (unsigned long long)cvtpk(y0, y1) | ((unsigned long long)cvtpk(y2, y3) << 32);
            }
        }
        {
            f32x16 ha = hreg * dtot;
#pragma unroll
            for (int kk = 0; kk < 8; ++kk) {
                const int k0 = 16 * kk + 8 * h;
                const LAS unsigned char* xb = lds + SS_X + (k0 + q4) * SS_XP + (pt * 32 + 16 * blk + 4 * p4) * 2;
                const s16x4 xl = trread(xb), xh = trread(xb + 4 * SS_XP);
                const f32x4 w0 = *(const LAS f32x4*)(sw + k0), w1 = *(const LAS f32x4*)(sw + k0 + 4);
                const bf16x8 af = pack8(bf2f((unsigned short)xl[0]) * w0[0], bf2f((unsigned short)xl[1]) * w0[1], bf2f((unsigned short)xl[2]) * w0[2], bf2f((unsigned short)xl[3]) * w0[3],
                                        bf2f((unsigned short)xh[0]) * w1[0], bf2f((unsigned short)xh[1]) * w1[1], bf2f((unsigned short)xh[2]) * w1[2], bf2f((unsigned short)xh[3]) * w1[3]);
                const LAS unsigned char* bb = lds + SS_B + (k0 + q4) * SS_BP + (lt * 32 + 16 * blk + 4 * p4) * 2;
                const s16x4 bl = trread(bb), bh = trread(bb + 4 * SS_BP);
                ha = MFMA32(af, cat8(bl, bh), ha);
            }
            hreg = ha;
#pragma unroll
            for (int i = 0; i < 16; ++i) *(LAS unsigned short*)(lds + SS_H + ((st + 1) & 1) * SS_HB + (pt * 32 + crow(i, h)) * SS_BP + (lt * 32 + r) * 2) = (unsigned short)(cvtpk(ha[i], 0.f) & 0xffffu);
        }
    }
}
DI void mix1_phase(const Fr& F) {
    for (int it = F.bid; it < 256; it += F.G) ssd_item(F, it >> 4, it & 15);
#if defined(EXPM) && (EXPM & 4)
    for (int it = F.bid; it < 256; it += F.G) ssd_item(F, it >> 4, it & 15);
#endif
    Fr F2 = F; asm volatile("" : "+v"(F2.lane), "+v"(F2.tid));
    for (int it = F2.bid; it < 1024; it += F2.G) na_item2(F2, it >> 6, (it >> 3) & 7, it & 7);
}
DI void merge1_phase(const Fr& F) {
    bf16_t* P1 = (bf16_t*)(F.ws + WS_P1); const bf16_t* Y = (const bf16_t*)(F.ws + WS_H); const float* gn = F.in[I_GNORM];
    const int NGW = F.G * 8, lane = F.lane;
    f32x4 gv[4];
#pragma unroll
    for (int j = 0; j < 4; ++j) gv[j] = *(const f32x4*)(gn + 16 * lane + 4 * j);
    for (int row0 = F.bid * 8 + F.wave; row0 < TX; row0 += 2 * NGW) {
        const int row1 = row0 + NGW < TX ? row0 + NGW : row0;
        u32x4 zq[2][2], yq[2][2];
#pragma unroll
        for (int q = 0; q < 2; ++q) { const int row = q ? row1 : row0; const bf16_t* zp = P1 + (size_t)row * P1W + 16 * lane; const bf16_t* yp = Y + (size_t)row * DM + 16 * lane;
            zq[q][0] = *(const u32x4*)zp; zq[q][1] = *(const u32x4*)(zp + 8); yq[q][0] = *(const u32x4*)yp; yq[q][1] = *(const u32x4*)(yp + 8); }
#pragma unroll
        for (int q = 0; q < 2; ++q) {
            if (q && row1 == row0) break;
            const int row = q ? row1 : row0; bf16_t* zp = P1 + (size_t)row * P1W + 16 * lane;
            const unsigned zz[8] = {zq[q][0].x, zq[q][0].y, zq[q][0].z, zq[q][0].w, zq[q][1].x, zq[q][1].y, zq[q][1].z, zq[q][1].w};
            const unsigned yy[8] = {yq[q][0].x, yq[q][0].y, yq[q][0].z, yq[q][0].w, yq[q][1].x, yq[q][1].y, yq[q][1].z, yq[q][1].w};
            float v[16]; float s = 0.f;
#pragma unroll
            for (int i = 0; i < 8; ++i) { v[2 * i] = bflo(yy[i]) * siluf(bflo(zz[i])); v[2 * i + 1] = bfhi(yy[i]) * siluf(bfhi(zz[i])); s += v[2 * i] * v[2 * i] + v[2 * i + 1] * v[2 * i + 1]; }
            s += __shfl_xor(s, 1); s += __shfl_xor(s, 2); s += __shfl_xor(s, 4); s += __shfl_xor(s, 8);
            const float rstd = rsqrtf(s * (1.f / 256.f) + EPS);
            u32x4 o0, o1;
            o0.x = cvtpk(v[0] * rstd * gv[0][0], v[1] * rstd * gv[0][1]); o0.y = cvtpk(v[2] * rstd * gv[0][2], v[3] * rstd * gv[0][3]);
            o0.z = cvtpk(v[4] * rstd * gv[1][0], v[5] * rstd * gv[1][1]); o0.w = cvtpk(v[6] * rstd * gv[1][2], v[7] * rstd * gv[1][3]);
            o1.x = cvtpk(v[8] * rstd * gv[2][0], v[9] * rstd * gv[2][1]); o1.y = cvtpk(v[10] * rstd * gv[2][2], v[11] * rstd * gv[2][3]);
            o1.z = cvtpk(v[12] * rstd * gv[3][0], v[13] * rstd * gv[3][1]); o1.w = cvtpk(v[14] * rstd * gv[3][2], v[15] * rstd * gv[3][3]);
            *(u32x4*)zp = o0; *(u32x4*)(zp + 8) = o1;
        }
    }
}

#define XB_TMO      128
#define XB_XCNT(j)  (256  + 64 * (j))
#define XB_XSUB(j)  (1280 + 64 * (j))
#define XB_XGEN(j)  (2304 + 64 * (j))
#define XB_TOP      3328
#define XB_TOPGEN   3392
#define XCD_BAR_WORDS 3456
#define XB_SPIN_CAP (1u << 18)

__device__ __forceinline__ unsigned xb_ld(unsigned* p)              { return __hip_atomic_load(p, __ATOMIC_RELAXED, __HIP_MEMORY_SCOPE_AGENT); }
__device__ __forceinline__ unsigned xb_add(unsigned* p, unsigned v) { return __hip_atomic_fetch_add(p, v, __ATOMIC_RELAXED, __HIP_MEMORY_SCOPE_AGENT); }
__device__ __forceinline__ unsigned xb_xcc_id() { return (unsigned)__builtin_amdgcn_s_getreg((3 << 11) | 20) & 0xFu; }
#define XB_SPIN(cond, bar) do { unsigned _sp = 0; while (cond) { __builtin_amdgcn_s_sleep(1); \
    if ((++_sp & 255u) == 0u) { if (xb_ld(&(bar)[XB_TMO])) break; if (_sp > XB_SPIN_CAP) { atomicAdd(&(bar)[XB_TMO], 1u); break; } } } } while (0)

struct XcdBarrier {
    unsigned* bar; unsigned x;
    volatile LAS unsigned* st;
};

__device__ __forceinline__ XcdBarrier xcd_barrier_post(unsigned* bar, volatile LAS unsigned* st, int tid) {
    XcdBarrier b; b.bar = bar; b.x = xb_xcc_id(); b.st = st;
    if (tid == 0) (void)xb_add(&bar[XB_XCNT(b.x)], 1u);
    return b;
}
__device__ __forceinline__ void xcd_barrier_complete(unsigned* bar, unsigned x, unsigned& nloc, unsigned& nx) {
    const unsigned G = gridDim.x * gridDim.y * gridDim.z;
    unsigned sum, cnt, mine, sp = 0u;
    for (;;) {
        sum = 0u; cnt = 0u; mine = 0u;
#pragma unroll
        for (unsigned j = 0; j < 16; ++j) { const unsigned c = xb_ld(&bar[XB_XCNT(j)]); sum += c; cnt += (c > 0u) ? 1u : 0u; mine = (j == x) ? c : mine; }
        if (sum == G) break;
        __builtin_amdgcn_s_sleep(1);
        if ((++sp & 255u) == 0u) { if (xb_ld(&bar[XB_TMO])) break; if (sp > XB_SPIN_CAP) { atomicAdd(&bar[XB_TMO], 1u); break; } }
    }
    nloc = mine > 0u ? mine : 1u; nx = cnt > 0u ? cnt : 1u;
}

__device__ __forceinline__ void xcd_barrier(const XcdBarrier& b, int tid) {
    asm volatile("s_waitcnt vmcnt(0)" ::: "memory");
    __syncthreads();
    if (tid == 0) {
        unsigned* bar = b.bar;
        __builtin_amdgcn_s_waitcnt(0);
        unsigned nloc = b.st[0], nx = b.st[1];
        if (nloc == 0u) { xcd_barrier_complete(bar, b.x, nloc, nx); b.st[0] = nloc; b.st[1] = nx; }
        const unsigned old = xb_add(&bar[XB_XSUB(b.x)], 1u);
        const unsigned gen = old / nloc;
        if (old + 1u == (gen + 1u) * nloc) {
            __builtin_amdgcn_fence(__ATOMIC_RELEASE, "agent");
            asm volatile("s_waitcnt vmcnt(0)" ::: "memory");
            const unsigned og = xb_add(&bar[XB_TOP], 1u);
            const unsigned tg = og / nx;
            if (og + 1u == (tg + 1u) * nx) xb_add(&bar[XB_TOPGEN], 1u);
            else XB_SPIN(xb_ld(&bar[XB_TOPGEN]) == tg, bar);
            __builtin_amdgcn_fence(__ATOMIC_ACQUIRE, "agent");
            xb_add(&bar[XB_XGEN(b.x)], 1u);
            asm volatile("s_waitcnt vmcnt(0)" ::: "memory");
        } else {
            XB_SPIN(xb_ld(&bar[XB_XGEN(b.x)]) == gen, bar);
            __builtin_amdgcn_fence(__ATOMIC_ACQUIRE, "agent");
            asm volatile("s_waitcnt vmcnt(0)" ::: "memory");
        }
    }
    __syncthreads();
}

DI void refresh(Fr& F, const Params& prm) {
    int wv = F.wave0; asm volatile("" : "+s"(wv));
    int ln = lane_id(); asm volatile("" : "+v"(ln));
    F.wave = wv; F.lane = ln; F.tid = wv * 64 + ln;
    unsigned char* w = prm.ws; asm volatile("" : "+s"(w)); F.ws = w;
    int g_ = gridDim.x; asm volatile("" : "+s"(g_)); F.G = g_;
    float* o = prm.out; asm volatile("" : "+s"(o)); F.out = o;
}
__global__ void __launch_bounds__(512, 2) mega_fwd(Params prm) {
    extern __shared__ __attribute__((aligned(16))) unsigned char lds_raw[];
    cg::grid_group grid = cg::this_grid();
    Fr F; F.lds = (LAS unsigned char*)lds_raw; F.bid = blockIdx.x; F.G = gridDim.x; F.in = prm.in;
    F.wave0 = __builtin_amdgcn_readfirstlane((int)threadIdx.x >> 6);
    refresh(F, prm);
#define WB(off) ((const bf16_t*)(F.ws + (off)))
#define WP(off) ((bf16_t*)(F.ws + (off)))
#define MOD(l, j) ((const float*)(F.ws + WS_MOD) + (size_t)(l) * 17 * 9216 + (j) * 1024)
#define COST ((const float*)(F.ws + WS_ROPE))
#define SSQ ((float*)(F.ws + WS_SSQ))
#define CRES ((float*)(F.ws + WS_CTXRES))
    volatile LAS unsigned* xst = (volatile LAS unsigned*)(F.lds + LDS_BYTES - 16);
    if (F.tid < 4) xst[F.tid] = 0u;
    __syncthreads();
    (void)xcd_barrier_post((unsigned*)(prm.ws + WS_BAR), xst, F.tid);
#define XBAR() do { XcdBarrier xb_; xb_.bar = (unsigned*)(F.ws + WS_BAR); xb_.x = xb_xcc_id(); xb_.st = (volatile LAS unsigned*)(F.lds + LDS_BYTES - 16); xcd_barrier(xb_, lane_id() + 64 * F.wave0); } while (0)
#ifndef EXPM
#define EXPM 0
#endif
#ifdef TPROBE_A
#define SYNC() do { XBAR(); refresh(F, prm); if (F.bid == 0 && F.tid == 0) { ((unsigned long long*)(F.ws + WS_STAMP))[nstamp] = __builtin_amdgcn_s_memrealtime(); } ++nstamp; } while (0)
    int nstamp = 1;
#else
#define SYNC() do { XBAR(); refresh(F, prm); } while (0)
#endif
#ifdef TPROBE_A
    if (F.bid == 0 && F.tid == 0) ((unsigned long long*)(F.ws + WS_STAMP))[40] = __builtin_amdgcn_s_memrealtime();
#endif
#define RES_GEMM_NORM(A_, lda_, W_, K_, rinx_, rinc_, gate_, gs_, lyr_, gn_, jn_) do { \
        run_gemm(F, A_, lda_, W_, TX, DM, K_, pg8::EpiRes{rinx_, rinc_, F.out, CRES, gate_, gs_, 0}); SYNC(); \
        if (F.bid < 64) run_gemm(F, (A_) + (size_t)TX * (lda_), lda_, W_, TC, DM, K_, pg8::EpiRes{rinx_, rinc_, F.out, CRES, gate_, gs_, TX}, 64); \
        else norm_phase(F, lyr_, gn_, jn_, 0, TX, F.out, CRES, WP(WS_H), F.bid - 64, F.G - 64); \
        SYNC(); \
        norm_phase(F, lyr_, gn_, jn_, TX, TT, F.out, CRES, WP(WS_H)); SYNC(); } while (0)
    prep_phase(F); grid.sync(); refresh(F, prm);
#ifdef TPROBE_A
    if (F.bid == 0 && F.tid == 0) ((unsigned long long*)(F.ws + WS_STAMP))[0] = __builtin_amdgcn_s_memrealtime();
#endif
    norm_phase(F, 0, F.in[I_GF1], 0, 0, TT, F.in[I_X], F.in[I_CTX], WP(WS_H)); SYNC();
    run_gemm(F, WB(WS_H), DM, WB(W0_F1I), TT, 2 * FF, DM, pg8::EpiSwiglu{WP(WS_ACT)});
    if (F.G == 256 && F.bid >= 96) conv_l1_part(F, 0, F.bid - 96, 160); else if (F.G != 256) conv_l1_part(F, 0, F.bid, F.G);
    SYNC();
    RES_GEMM_NORM(WB(WS_ACT), FF, WB(W0_F1O), FF, F.in[I_X], F.in[I_CTX], MOD(0, 2), 0.5f, 0, F.in[I_GMIX], 3);
    run_gemm(F, WB(WS_H), DM, WB(W0_ABI), TT, 2048, DM, pg8::EpiAbIn{WP(WS_P0), COST, COST + 1024, SSQ});
    if (F.G == 256 && F.bid >= 128) conv_l1_part(F, 2, F.bid - 128, 128); else if (F.G != 256) conv_l1_part(F, 2, F.bid, F.G);
    SYNC();
    run_gemm(F, WB(WS_P0) + 1536, P0W, WB(W0_UP), TT, QKW, 384, pg8::EpiMlaUp{WP(WS_QKV), SSQ}, 0, 3, 0, 4, 256, 2); SYNC();
#ifndef ATTN_REP
#define ATTN_REP 1
#endif
    attn0_phase(F); SYNC();
    RES_GEMM_NORM(WB(WS_H), DM, WB(W0_ABO), DM, F.out, CRES, MOD(0, 5), 1.f, 0, F.in[I_GF2], 6);
    run_gemm(F, WB(WS_H), DM, WB(W0_F2I), TT, 2 * FF, DM, pg8::EpiSwiglu{WP(WS_ACT)});
    if (F.G == 256 && F.bid >= 96) conv_l1_part(F, 1, F.bid - 96, 160); else if (F.G != 256) conv_l1_part(F, 1, F.bid, F.G);
    SYNC();
    RES_GEMM_NORM(WB(WS_ACT), FF, WB(W0_F2O), FF, F.out, CRES, MOD(0, 8), 0.5f, 1, F.in[I_GF1] + DM, 0);
    run_gemm(F, WB(WS_H), DM, WB(W1_F1I), TT, 2 * FF, DM, pg8::EpiSwiglu{WP(WS_ACT)}); SYNC();
    RES_GEMM_NORM(WB(WS_ACT), FF, WB(W1_F1O), FF, F.out, CRES, MOD(1, 2), 0.5f, 1, F.in[I_GMIX] + DM, 3);
    run_gemm(F, WB(WS_H), DM, WB(W1_CDI), TT, 4864, DM, pg8::EpiStore{WP(WS_P1), P1W, P1W}); SYNC();
    halo1_phase(F); scan1_pre(F); SYNC();
    conv1_phase(F); SYNC();
    mix1_phase(F); SYNC();
    merge1_phase(F); SYNC();
    run_gemm(F, WB(WS_P1), P1W, WB(W1_CDO), TX, DM, 1536, pg8::EpiRes{F.out, CRES, F.out, CRES, MOD(1, 5), 1.f, 0}); SYNC();
    norm_phase(F, 1, F.in[I_GF2] + DM, 6, 0, TX, F.out, CRES, WP(WS_H)); SYNC();
    run_gemm(F, WB(WS_H), DM, WB(W1_F2I), TX, 2 * FF, DM, pg8::EpiSwiglu{WP(WS_ACT)}); SYNC();
    run_gemm(F, WB(WS_ACT), FF, WB(W1_F2O), TX, DM, FF, pg8::EpiRes{F.out, CRES, F.out, CRES, MOD(1, 8), 0.5f, 0}); SYNC();
#ifdef TPROBE_A
    final_norm_phase(F, (int)(((const unsigned long long*)(F.ws + WS_STAMP))[TPROBE_B] - ((const unsigned long long*)(F.ws + WS_STAMP))[TPROBE_A]));
#else
    final_norm_phase(F, 0);
#endif
}

extern "C" void kernel_launch(void* const* d_in, const int* in_sizes, int n_in, void* d_out, int out_size, void* d_ws, size_t ws_size, hipStream_t stream) {
    static int grid = 0;
    if (grid == 0) {
        int dev = 0, cus = 0, per_cu = 0;
        (void)hipGetDevice(&dev); (void)hipDeviceGetAttribute(&cus, hipDeviceAttributeMultiprocessorCount, dev);
        if (hipFuncSetAttribute((const void*)mega_fwd, hipFuncAttributeMaxDynamicSharedMemorySize, LDS_BYTES) != hipSuccess) fprintf(stderr, "kernel_launch: hipFuncSetAttribute failed\n");
        if (hipOccupancyMaxActiveBlocksPerMultiprocessor(&per_cu, (const void*)mega_fwd, 512, LDS_BYTES) != hipSuccess || per_cu < 1) { fprintf(stderr, "kernel_launch: occupancy query gave %d\n", per_cu); per_cu = 1; }
        (void)hipGetLastError();
        if (cus <= 0) cus = 256;
        grid = cus * per_cu;
        if (n_in != 34 || ws_size < WS_END) fprintf(stderr, "kernel_launch: unexpected n_in %d / ws_size %zu (need %zu)\n", n_in, ws_size, (size_t)WS_END);
    }
    Params p{};
    for (int i = 0; i < 34; ++i) p.in[i] = (const float*)d_in[i];
    p.out = (float*)d_out; p.ws = (unsigned char*)d_ws;
    (void)hipMemsetAsync((unsigned char*)d_ws + WS_BAR, 0, 16384, stream);
    void* args[] = {&p};
    hipError_t e = hipLaunchCooperativeKernel((const void*)mega_fwd, dim3(grid), dim3(512), args, LDS_BYTES, stream);
    if (e != hipSuccess) fprintf(stderr, "cooperative launch failed: %s (grid %d)\n", hipGetErrorString(e), grid);
}
```
